# Optimizing an MI355X kernel written in HIP

```python
import jax
import jax.numpy as jnp
from jax import lax
import numpy as np

D_MODEL = 1024
BATCH = 32
SEQ = 2048
DEPTH = 1

HEAD_DIM = 64
RW_HEADS = 8
RW_WIDTH = RW_HEADS * HEAD_DIM
NSA_HEADS = 8
NSA_KV_HEADS = 2
NSA_GROUP = NSA_HEADS // NSA_KV_HEADS
NSA_WIDTH = NSA_HEADS * HEAD_DIM
NSA_KV_WIDTH = NSA_KV_HEADS * HEAD_DIM
MIX_WIDTH = RW_WIDTH + NSA_WIDTH
RW_DECAY_LORA = 64
RW_ICLR_LORA = 64
RW_GATE_LORA = 128
CMP_LEN = 32
CMP_STRIDE = 16
CMP_HIDDEN = 256
SEL_BLOCK = 64
SEL_TOPK = 8
SEL_Q_BLOCK = 64
WINDOW = 256
Q_BLOCK = 128
ROPE_THETA = 10000.0
N_EXPERTS = 32
TOP_K = 4
D_FF = 1024
SWIGLU_LIMIT = 7.0
SWIGLU_ALPHA = 1.702
MOE_ROW_BLOCK = 128
NORM_EPS = 1e-6
LNX_EPS = 64e-5
FORCE_SCORE = 1e6
NEG_INF = -1e30
IN_SPLITS = (RW_WIDTH, RW_WIDTH, RW_WIDTH, NSA_WIDTH, NSA_KV_WIDTH, NSA_KV_WIDTH, NSA_KV_WIDTH, NSA_KV_WIDTH, NSA_KV_WIDTH, NSA_KV_WIDTH, 3 * NSA_HEADS)
N_IN = 3 * RW_WIDTH + NSA_WIDTH + 6 * NSA_KV_WIDTH + 3 * NSA_HEADS

kernel_name = 'hybrid_rwkv7_nsa_moe'


def rmsnorm(x, g, eps=NORM_EPS):
    xf = x.astype(jnp.float32)
    y = xf * lax.rsqrt(jnp.mean(xf * xf, axis=-1, keepdims=True) + eps)
    return (y * g.astype(jnp.float32)).astype(x.dtype)


def token_shift(t):
    return jnp.pad(t, ((0, 0), (1, 0), (0, 0)))[:, :-1]


def rope(t, pos):
    half = t.shape[-1] // 2
    inv = ROPE_THETA ** (-jnp.arange(half, dtype=jnp.float32) / half)
    ang = jnp.asarray(pos, jnp.float32)[:, None] * inv[None, :]
    cos = jnp.cos(ang)[None, :, None, :]
    sin = jnp.sin(ang)[None, :, None, :]
    tf = t.astype(jnp.float32)
    t1, t2 = tf[..., :half], tf[..., half:]
    return jnp.concatenate([t1 * cos - t2 * sin, t2 * cos + t1 * sin], axis=-1).astype(t.dtype)


def masked_softmax(s, mask):
    s = jnp.where(mask, s.astype(jnp.float32), NEG_INF)
    m = jnp.max(s, axis=-1, keepdims=True)
    e = jnp.exp(s - m) * mask
    d = jnp.sum(e, axis=-1, keepdims=True)
    return e / jnp.where(d > 0, d, 1.0)


def rwkv7_mix(xn, r, k, v, mu_rkv, mu_wag, w0, w1, w2, a0, a1, a2, g1, g2, k_k, k_a, r_k, lnx_g, lnx_b):
    B, S, _ = xn.shape
    H, N = RW_HEADS, HEAD_DIM
    f32 = jnp.float32
    r = r + mu_rkv[0] * (token_shift(r) - r)
    k = k + mu_rkv[1] * (token_shift(k) - k)
    v = v + mu_rkv[2] * (token_shift(v) - v)
    dx = token_shift(xn) - xn
    xw = xn + mu_wag[0] * dx
    xa = xn + mu_wag[1] * dx
    xg = xn + mu_wag[2] * dx
    w = -jax.nn.softplus(-(w0 + jnp.tanh(xw @ w1) @ w2)) - 0.5
    a = jax.nn.sigmoid(a0 + (xa @ a1) @ a2)
    g = jax.nn.sigmoid(xg @ g1) @ g2
    kk = (k * k_k).astype(f32).reshape(B, S, H, N)
    kk = kk / jnp.maximum(jnp.sqrt(jnp.sum(kk * kk, axis=-1, keepdims=True)), 1e-12)
    k = k * (1.0 + (a - 1.0) * k_a)
    decay = jnp.exp(-jnp.exp(w.astype(f32))).reshape(B, S, H, N)
    rh = r.astype(f32).reshape(B, S, H, N)
    kh = k.astype(f32).reshape(B, S, H, N)
    vh = v.astype(f32).reshape(B, S, H, N)
    ah = a.astype(f32).reshape(B, S, H, N)
    a_vec = -kk
    b_vec = kk * ah

    def step(state, inp):
        r_t, w_t, k_t, v_t, av_t, bv_t = inp
        sa = jnp.einsum('bhij,bhj->bhi', state, av_t)
        state = state * w_t[:, :, None, :] + sa[..., :, None] * bv_t[..., None, :] + v_t[..., :, None] * k_t[..., None, :]
        y_t = jnp.einsum('bhij,bhj->bhi', state, r_t)
        return state, y_t

    xs = tuple(jnp.swapaxes(t, 0, 1) for t in (rh, decay, kh, vh, a_vec, b_vec))
    _, y = lax.scan(step, jnp.zeros((B, H, N, N), f32), xs)
    y = jnp.swapaxes(y, 0, 1)
    mu = jnp.mean(y, axis=-1, keepdims=True)
    var = jnp.mean(jnp.square(y - mu), axis=-1, keepdims=True)
    y = ((y - mu) * lax.rsqrt(var + LNX_EPS)).reshape(B, S, RW_WIDTH)
    y = y * lnx_g.astype(f32) + lnx_b.astype(f32)
    bonus = jnp.sum(rh * kh * r_k.astype(f32), axis=-1, keepdims=True) * vh
    y = (y + bonus.reshape(B, S, RW_WIDTH)) * g.astype(f32)
    return y.astype(xn.dtype)


def nsa_mix(q, kc, vc, ks, vs, kw, vw, gate_logits, qn_g, kn_g, pe, cmp_w1, cmp_w2):
    B, S, _ = q.shape
    H, Hk, G, d = NSA_HEADS, NSA_KV_HEADS, NSA_GROUP, HEAD_DIM
    f32 = jnp.float32
    scale = HEAD_DIM ** -0.5
    pos = np.arange(S)
    q = rmsnorm(q.reshape(B, S, H, d), qn_g)
    q_rot = rope(q, pos)
    kc, vc, ks, vs, kw, vw = (t.reshape(B, S, Hk, d) for t in (kc, vc, ks, vs, kw, vw))

    n_cmp = (S - CMP_LEN) // CMP_STRIDE + 1
    cmp_start = np.arange(n_cmp) * CMP_STRIDE
    blk_idx = cmp_start[:, None] + np.arange(CMP_LEN)[None, :]

    def compress(t, pe_i, w1_i, w2_i):
        blocks = t[:, blk_idx] + pe_i[None, None, :, None, :]
        hid = jax.nn.gelu(jnp.einsum('bnlkd,ldf->bnkf', blocks, w1_i))
        return jnp.einsum('bnkf,fd->bnkd', hid, w2_i)

    k_cmp = rmsnorm(compress(kc, pe[0], cmp_w1[0], cmp_w2[0]), kn_g[0])
    v_cmp = compress(vc, pe[1], cmp_w1[1], cmp_w2[1])
    qg = q.reshape(B, S, Hk, G, d)
    s_cmp = jnp.einsum('bskgd,bnkd->bkgsn', qg, k_cmp) * scale
    cmp_mask = (cmp_start + CMP_LEN - 1)[None, :] <= pos[:, None]
    p_cmp = masked_softmax(s_cmp, cmp_mask)
    o_cmp = jnp.einsum('bkgsn,bnkd->bskgd', p_cmp, v_cmp.astype(f32)).reshape(B, S, H, d)

    n_sel = S // SEL_BLOCK
    sel_start = np.arange(n_sel) * SEL_BLOCK
    overlap = ((cmp_start[:, None] < sel_start[None, :] + SEL_BLOCK) & (cmp_start[:, None] + CMP_LEN > sel_start[None, :])).astype(np.float32)
    imp = jnp.einsum('bkgsn,nj->bksj', p_cmp, jnp.asarray(overlap))
    cur = pos // SEL_BLOCK
    jj = np.arange(n_sel)
    forced = (jj[None, :] == 0) | (jj[None, :] == cur[:, None]) | (jj[None, :] == cur[:, None] - 1)
    imp = jnp.where(forced, FORCE_SCORE, imp)
    imp = jnp.where(jj[None, :] > cur[:, None], -FORCE_SCORE, imp)
    n_top = min(SEL_TOPK, n_sel)
    _, sel_idx = lax.top_k(imp, n_top)

    ks_r = rope(rmsnorm(ks, kn_g[1]), pos)
    k_blocks = ks_r.reshape(B, n_sel, SEL_BLOCK, Hk, d).transpose(0, 3, 1, 2, 4)
    v_blocks = vs.reshape(B, n_sel, SEL_BLOCK, Hk, d).transpose(0, 3, 1, 2, 4)
    nqs = S // SEL_Q_BLOCK
    q_chunks = q_rot.reshape(B, nqs, SEL_Q_BLOCK, Hk, G, d).transpose(1, 0, 3, 4, 2, 5)
    idx_chunks = sel_idx.reshape(B, Hk, nqs, SEL_Q_BLOCK, n_top).transpose(2, 0, 1, 3, 4)
    qpos_chunks = jnp.asarray(pos.reshape(nqs, SEL_Q_BLOCK))
    bi = jnp.arange(B)[:, None, None, None]
    hi = jnp.arange(Hk)[None, :, None, None]

    def sel_block(args):
        qc, ic, qp = args
        kg = k_blocks[bi, hi, ic]
        vg = v_blocks[bi, hi, ic]
        s = jnp.einsum('bkgqd,bkqnld->bkgqnl', qc, kg) * scale
        kpos = ic[..., None] * SEL_BLOCK + jnp.arange(SEL_BLOCK)
        mask = kpos <= qp[None, None, :, None, None]
        p = masked_softmax(s.reshape(B, Hk, G, SEL_Q_BLOCK, -1), mask.reshape(B, Hk, 1, SEL_Q_BLOCK, -1))
        return jnp.einsum('bkgqm,bkqmd->bkgqd', p, vg.reshape(B, Hk, SEL_Q_BLOCK, -1, d).astype(f32))

    o_sel = lax.map(sel_block, (q_chunks, idx_chunks, qpos_chunks))
    o_sel = o_sel.transpose(1, 0, 4, 2, 3, 5).reshape(B, S, H, d)

    kw_r = rope(rmsnorm(kw, kn_g[2]), pos)
    nb = S // Q_BLOCK
    n_band = WINDOW // Q_BLOCK + 1

    def band(t):
        tb = t.reshape(B, nb, Q_BLOCK, Hk, d).transpose(0, 3, 1, 2, 4)
        tp = jnp.pad(tb, ((0, 0), (0, 0), (n_band - 1, 0), (0, 0), (0, 0)))
        return jnp.concatenate([tp[:, :, i:i + nb] for i in range(n_band)], axis=3)

    k_band = band(kw_r)
    v_band = band(vw)
    qw = q_rot.reshape(B, nb, Q_BLOCK, Hk, G, d).transpose(0, 3, 4, 1, 2, 5)
    s_win = jnp.einsum('bkgiqd,bkird->bkgiqr', qw, k_band) * scale
    qpos = pos.reshape(nb, Q_BLOCK)
    kpos = (np.arange(nb)[:, None] - (n_band - 1)) * Q_BLOCK + np.arange(n_band * Q_BLOCK)[None, :]
    win_mask = (kpos[:, None, :] <= qpos[:, :, None]) & (kpos[:, None, :] > qpos[:, :, None] - WINDOW) & (kpos[:, None, :] >= 0)
    p_win = masked_softmax(s_win, win_mask)
    o_win = jnp.einsum('bkgiqr,bkird->bkgiqd', p_win, v_band.astype(f32))
    o_win = o_win.transpose(0, 3, 4, 1, 2, 5).reshape(B, S, H, d)

    gates = jax.nn.sigmoid(gate_logits.astype(f32)).reshape(B, S, H, 3)
    o = gates[..., 0:1] * o_cmp + gates[..., 1:2] * o_sel + gates[..., 2:3] * o_win
    return o.reshape(B, S, NSA_WIDTH).astype(q.dtype)


def moe_ffn(h, wr, br, w1, b1, w2, b2):
    B, S, D = h.shape
    T = B * S
    M = MOE_ROW_BLOCK
    hf = h.reshape(T, D)
    logits = (hf @ wr + br).astype(jnp.float32)
    top_v, top_e = lax.top_k(logits, TOP_K)
    gate = jax.nn.softmax(top_v, axis=-1)
    flat_e = top_e.reshape(-1)
    flat_t = jnp.arange(T * TOP_K) // TOP_K
    flat_g = gate.reshape(-1)
    order = jnp.argsort(flat_e)
    se, st, sg = flat_e[order], flat_t[order], flat_g[order]
    counts = jnp.bincount(flat_e, length=N_EXPERTS)
    padded = ((counts + M - 1) // M) * M
    pad_end = jnp.cumsum(padded)
    pad_start = pad_end - padded
    sort_start = jnp.cumsum(counts) - counts
    dest = pad_start[se] + jnp.arange(T * TOP_K) - sort_start[se]
    n_rows = T * TOP_K + N_EXPERTS * M
    n_blk = n_rows // M
    row_tok = jnp.full((n_rows,), T, jnp.int32).at[dest].set(st)
    row_gate = jnp.zeros((n_rows,), jnp.float32).at[dest].set(sg)
    blk_e = jnp.minimum(jnp.searchsorted(pad_end, jnp.arange(n_blk) * M, side='right'), N_EXPERTS - 1)
    h_pad = jnp.concatenate([hf, jnp.zeros((1, D), hf.dtype)], axis=0)

    def expert_block(args):
        tok, g, e = args
        u = h_pad[tok] @ w1[e] + b1[e]
        glu = jnp.minimum(u[:, :D_FF], SWIGLU_LIMIT)
        lin = jnp.clip(u[:, D_FF:], -SWIGLU_LIMIT, SWIGLU_LIMIT)
        act = glu * jax.nn.sigmoid(SWIGLU_ALPHA * glu) * (lin + 1.0)
        y = act @ w2[e] + b2[e]
        return y * g[:, None].astype(y.dtype)

    y_rows = lax.map(expert_block, (row_tok.reshape(n_blk, M), row_gate.reshape(n_blk, M), blk_e))
    out = jnp.zeros((T + 1, D), y_rows.dtype).at[row_tok].add(y_rows.reshape(n_rows, D))
    return out[:T].reshape(B, S, D).astype(h.dtype)


def hybrid_layer(x, ln1_g, w_in, rw_mu_rkv, rw_mu_wag, rw_w0, rw_w1, rw_w2, rw_a0, rw_a1, rw_a2, rw_g1, rw_g2, rw_k_k, rw_k_a, rw_r_k, rw_lnx_g, rw_lnx_b, nsa_qn_g, nsa_kn_g, nsa_pe, nsa_cmp_w1, nsa_cmp_w2, w_out, ln2_g, moe_wr, moe_br, moe_w1, moe_b1, moe_w2, moe_b2):
    xn = rmsnorm(x, ln1_g)
    proj = xn @ w_in
    cuts = np.cumsum(np.array(IN_SPLITS))[:-1].tolist()
    r, k, v, q, kc, vc, ks, vs, kw, vw, gl = jnp.split(proj, cuts, axis=-1)
    y_rw = rwkv7_mix(xn, r, k, v, rw_mu_rkv, rw_mu_wag, rw_w0, rw_w1, rw_w2, rw_a0, rw_a1, rw_a2, rw_g1, rw_g2, rw_k_k, rw_k_a, rw_r_k, rw_lnx_g, rw_lnx_b)
    y_nsa = nsa_mix(q, kc, vc, ks, vs, kw, vw, gl, nsa_qn_g, nsa_kn_g, nsa_pe, nsa_cmp_w1, nsa_cmp_w2)
    x = x + jnp.concatenate([y_rw, y_nsa], axis=-1) @ w_out
    x = x + moe_ffn(rmsnorm(x, ln2_g), moe_wr, moe_br, moe_w1, moe_b1, moe_w2, moe_b2)
    return x


def setup_inputs(seed: int = 0) -> dict:
    key = jax.random.key(seed)
    kk = jax.random.split(key, 32)
    f32 = jnp.float32
    L, D = DEPTH, D_MODEL

    def nrm(k, shape, s):
        return jax.random.normal(k, shape, f32) * s

    def uni(k, shape, lo, hi):
        return jax.random.uniform(k, shape, f32, lo, hi)

    return {
        'x': nrm(kk[0], (BATCH, SEQ, D), 1.0),
        'ln1_g': 1.0 + nrm(kk[1], (L, D), 0.02),
        'w_in': nrm(kk[2], (L, D, N_IN), D ** -0.5),
        'rw_mu_rkv': uni(kk[3], (L, 3, RW_WIDTH), 0.0, 1.0),
        'rw_mu_wag': uni(kk[4], (L, 3, D), 0.0, 1.0),
        'rw_w0': uni(kk[5], (L, RW_WIDTH), -4.0, 1.0),
        'rw_w1': nrm(kk[6], (L, D, RW_DECAY_LORA), 0.5 * D ** -0.5),
        'rw_w2': nrm(kk[7], (L, RW_DECAY_LORA, RW_WIDTH), 0.5 * RW_DECAY_LORA ** -0.5),
        'rw_a0': nrm(kk[8], (L, RW_WIDTH), 0.1),
        'rw_a1': nrm(kk[9], (L, D, RW_ICLR_LORA), 0.5 * D ** -0.5),
        'rw_a2': nrm(kk[10], (L, RW_ICLR_LORA, RW_WIDTH), 0.5 * RW_ICLR_LORA ** -0.5),
        'rw_g1': nrm(kk[11], (L, D, RW_GATE_LORA), D ** -0.5),
        'rw_g2': nrm(kk[12], (L, RW_GATE_LORA, RW_WIDTH), RW_GATE_LORA ** -0.5),
        'rw_k_k': 0.85 + nrm(kk[13], (L, RW_WIDTH), 0.05),
        'rw_k_a': 1.0 + nrm(kk[14], (L, RW_WIDTH), 0.05),
        'rw_r_k': nrm(kk[15], (L, RW_HEADS, HEAD_DIM), 0.1),
        'rw_lnx_g': 1.0 + nrm(kk[16], (L, RW_WIDTH), 0.02),
        'rw_lnx_b': nrm(kk[17], (L, RW_WIDTH), 0.01),
        'nsa_qn_g': 1.0 + nrm(kk[18], (L, HEAD_DIM), 0.02),
        'nsa_kn_g': 1.0 + nrm(kk[19], (L, 3, HEAD_DIM), 0.02),
        'nsa_pe': nrm(kk[20], (L, 2, CMP_LEN, HEAD_DIM), 0.02),
        'nsa_cmp_w1': nrm(kk[21], (L, 2, CMP_LEN, HEAD_DIM, CMP_HIDDEN), (CMP_LEN * HEAD_DIM) ** -0.5),
        'nsa_cmp_w2': nrm(kk[22], (L, 2, CMP_HIDDEN, HEAD_DIM), CMP_HIDDEN ** -0.5),
        'w_out': nrm(kk[23], (L, MIX_WIDTH, D), MIX_WIDTH ** -0.5),
        'ln2_g': 1.0 + nrm(kk[24], (L, D), 0.02),
        'moe_wr': nrm(kk[25], (L, D, N_EXPERTS), D ** -0.5),
        'moe_br': nrm(kk[26], (L, N_EXPERTS), 0.01),
        'moe_w1': nrm(kk[27], (L, N_EXPERTS, D, 2 * D_FF), D ** -0.5),
        'moe_b1': nrm(kk[28], (L, N_EXPERTS, 2 * D_FF), 0.01),
        'moe_w2': nrm(kk[29], (L, N_EXPERTS, D_FF, D), D_FF ** -0.5),
        'moe_b2': nrm(kk[30], (L, N_EXPERTS, D), 0.01),
    }


def reference(x, ln1_g, w_in, rw_mu_rkv, rw_mu_wag, rw_w0, rw_w1, rw_w2, rw_a0, rw_a1, rw_a2, rw_g1, rw_g2, rw_k_k, rw_k_a, rw_r_k, rw_lnx_g, rw_lnx_b, nsa_qn_g, nsa_kn_g, nsa_pe, nsa_cmp_w1, nsa_cmp_w2, w_out, ln2_g, moe_wr, moe_br, moe_w1, moe_b1, moe_w2, moe_b2):
    for l in range(DEPTH):
        x = hybrid_layer(x, ln1_g[l], w_in[l], rw_mu_rkv[l], rw_mu_wag[l], rw_w0[l], rw_w1[l], rw_w2[l], rw_a0[l], rw_a1[l], rw_a2[l], rw_g1[l], rw_g2[l], rw_k_k[l], rw_k_a[l], rw_r_k[l], rw_lnx_g[l], rw_lnx_b[l], nsa_qn_g[l], nsa_kn_g[l], nsa_pe[l], nsa_cmp_w1[l], nsa_cmp_w2[l], w_out[l], ln2_g[l], moe_wr[l], moe_br[l], moe_w1[l], moe_b1[l], moe_w2[l], moe_b2[l])
    return x
```

```cpp
#include <hip/hip_runtime.h>
#include <hip/hip_cooperative_groups.h>
#include <cstdio>
#include <cstdint>
namespace cg = cooperative_groups;

#define LAS __attribute__((address_space(3)))
#define DI __device__ __forceinline__
typedef unsigned short bf16_t;
typedef short bf16x8 __attribute__((ext_vector_type(8)));
typedef float f32x4 __attribute__((ext_vector_type(4)));
typedef float f32x2 __attribute__((ext_vector_type(2)));
typedef float f32x16 __attribute__((ext_vector_type(16)));
typedef unsigned u32x4 __attribute__((ext_vector_type(4)));
typedef unsigned u32x2 __attribute__((ext_vector_type(2)));

#ifndef ABL
#define ABL 0
#endif
#ifndef SCAN_V2
#define SCAN_V2 2
#endif
#ifndef REP
#define REP 0
#endif
constexpr int T_TOK = 65536, SEQ = 2048, NBATCH = 32, DM = 1024;
constexpr int NPROJ = 3584;
constexpr int C_R = 0, C_K = 512, C_V = 1024, C_Q = 1536, C_KC = 2048, C_VC = 2176, C_KS = 2304, C_VS = 2432, C_KW = 2560, C_VW = 2688, C_GL = 2816;
constexpr int N_IN_REAL = 2840, C_L1 = 2840, C_L2 = 3096, C_LEND = 3352;
constexpr int NEXP = 32, DFF = 1024;
constexpr int NTHREADS = 512;
constexpr int LDS_BYTES = 160 * 1024;

constexpr size_t MiB = 1ull << 20;
constexpr size_t WS_XN = 0;
constexpr size_t WS_PROJ = 128 * MiB;
constexpr size_t WS_KSR = 576 * MiB;
constexpr size_t WS_KWR = 592 * MiB;
constexpr size_t WS_VST = 608 * MiB;
constexpr size_t WS_VWT = 624 * MiB;
constexpr size_t WS_LOUT = 640 * MiB;
constexpr size_t WS_LACT = 832 * MiB;
constexpr size_t WS_WCAT = 864 * MiB;
constexpr size_t WS_WOUT = 871 * MiB;
constexpr size_t WS_CW1 = 873 * MiB;
constexpr size_t WS_WL2 = 875 * MiB;
constexpr size_t WS_HID = 876 * MiB;
constexpr size_t WS_KCMP = 884 * MiB;
constexpr size_t WS_VCMPT = 885 * MiB;
constexpr size_t WS_ROPE = 886 * MiB;
constexpr size_t WS_BIASC = 887 * MiB;
constexpr size_t WS_RSL = 968 * MiB;
constexpr size_t WS_CTL = 1000 * MiB;
constexpr size_t WS_WRT = 886 * MiB + 524288;
constexpr size_t WS_IDS = 904 * MiB;
constexpr size_t WS_GTS = 936 * MiB;
constexpr size_t WS_W1T = 128 * MiB;
constexpr size_t WS_W2T = 192 * MiB;
constexpr size_t WS_ACT = 320 * MiB;
constexpr size_t WS_TP = 1001 * MiB;
constexpr size_t WS_TG = 1002 * MiB;
constexpr size_t WS_BAR = 1003 * MiB;
constexpr size_t WS_END = 1004 * MiB;
#define DI_EARLY __device__ __forceinline__
DI_EARLY size_t y_row_off(int r) { return r < 98304 ? (size_t)r * 2048 : (r < 147456 ? 224 * MiB + (size_t)(r - 98304) * 2048 : 608 * MiB + (size_t)(r - 147456) * 2048); }

struct Args {
    const float* in[31];
    float* out;
    unsigned char* ws;
    int ph_lo, ph_hi, coop, dry;
};

DI float bf2f(bf16_t b) { return __uint_as_float(((unsigned)b) << 16); }
typedef __bf16 bf16v2_t __attribute__((ext_vector_type(2)));
DI unsigned cvt_pk_bf16(float lo, float hi) { f32x2 v = {lo, hi}; bf16v2_t r = __builtin_convertvector(v, bf16v2_t); return __builtin_bit_cast(unsigned, r); }
DI bf16_t f2bf(float f) { return (bf16_t)(cvt_pk_bf16(f, 0.f) & 0xffffu); }
DI float bflo(unsigned u) { return __uint_as_float(u << 16); }
DI float bfhi(unsigned u) { return __uint_as_float(u & 0xffff0000u); }
DI float wave_sum(float v) { for (int o = 32; o > 0; o >>= 1) v += __shfl_xor(v, o); return v; }
template <int CTRL> DI float dppmov(float x) { return __int_as_float(__builtin_amdgcn_update_dpp(0, __float_as_int(x), CTRL, 0xf, 0xf, true)); }
DI float red8(float x) { x += dppmov<0xB1>(x); x += dppmov<0x4E>(x); x += dppmov<0x141>(x); return x; }
DI float red16(float x) { x = red8(x); x += dppmov<0x140>(x); return x; }
DI float sigmoidf_(float x) { return 1.0f / (1.0f + __expf(-x)); }
DI float tanhf_(float x) { float e = __expf(2.0f * x); return 1.0f - 2.0f / (e + 1.0f); }
DI float gelu_tanh(float x) { float u = 0.7978845608028654f * (x + 0.044715f * x * x * x); return 0.5f * x * (1.0f + tanhf_(u)); }

constexpr int BM = 256, BK = 64, HALF = 128, HTB = HALF * BK * 2, STAGE_BYTES = 8 * HTB;
constexpr int AUX_OFF = STAGE_BYTES + 4096, AUX_SLOT = 3072;
DI int lds_byte(int r, int c) { const int st = (r >> 4) * 2 + (c >> 5), rr = r & 15, cc = c & 31, ob = rr * 64 + cc * 2; return st * 1024 + (ob ^ (((ob >> 9) & 1) << 5)); }
DI void stage_rc(int b, int& R, int& C) { const int st = b / 1024, sb = b % 1024, swz = sb ^ (((sb >> 9) & 1) << 5); R = (st >> 1) * 16 + swz / 64; C = (st & 1) * 32 + (swz % 64) / 2; }
DI int perm32(int rho) { const int n = rho >> 4, i = rho & 15; return 8 * (i >> 2) + 4 * n + (i & 3); }

typedef int v8i_t __attribute__((ext_vector_type(8)));
typedef int v4i_t __attribute__((ext_vector_type(4)));
template <bool FP8> struct FragT;
template <> struct FragT<false> { bf16x8 k[2]; };
template <> struct FragT<true> { v8i_t v; };
DI void ld_frag(FragT<false>& f, const LAS unsigned char* p0, const LAS unsigned char* p1) { f.k[0] = *(const LAS bf16x8*)p0; f.k[1] = *(const LAS bf16x8*)p1; }
DI void ld_frag(FragT<true>& f, const LAS unsigned char* p0, const LAS unsigned char* p1) { const v4i_t lo = *(const LAS v4i_t*)p0, hi = *(const LAS v4i_t*)p1; f.v = __builtin_shufflevector(lo, hi, 0, 1, 2, 3, 4, 5, 6, 7); }
DI f32x4 mma_frag(const FragT<false>& b, const FragT<false>& a, f32x4 cacc) { cacc = __builtin_amdgcn_mfma_f32_16x16x32_bf16(b.k[0], a.k[0], cacc, 0, 0, 0); return __builtin_amdgcn_mfma_f32_16x16x32_bf16(b.k[1], a.k[1], cacc, 0, 0, 0); }
DI f32x4 mma_frag(const FragT<true>& b, const FragT<true>& a, f32x4 cacc) {
    const int sc = 0x7f7f7f7f;
    asm volatile("v_mfma_scale_f32_16x16x128_f8f6f4 %0, %1, %2, %0, %3, %3 op_sel_hi:[0,0,0]" : "+v"(cacc) : "v"(b.v), "v"(a.v), "v"(sc));
    return cacc;
}
DI unsigned cvt4_fp8(float a, float b, float cc, float d) { unsigned w = 0; w = __builtin_amdgcn_cvt_pk_fp8_f32(a, b, w, false); w = __builtin_amdgcn_cvt_pk_fp8_f32(cc, d, w, true); return w; }
struct Unit { int rt, pn, e, rl; };

template <class P>
DI void gemm_phase(LAS unsigned char* lds, const P& S) {
    const int tid = threadIdx.x, wid = __builtin_amdgcn_readfirstlane(tid >> 6), lane = tid & 63, wr = wid >> 2, wc = wid & 3, fr = lane & 15, fq = lane >> 4;
    const int nt = S.nt;
    int R[2], C[2]; unsigned voffB[2];
#pragma unroll
    for (int i = 0; i < 2; ++i) { stage_rc(tid * 16 + i * 8192, R[i], C[i]); const int Rb = P::PERM ? ((R[i] & ~31) + perm32(R[i] & 31)) : R[i]; voffB[i] = (unsigned)(Rb * S.ldb + C[i]) * 2u; }
    const size_t kstepA = (size_t)S.kstepA, kstepB = (size_t)(BK * 2);
    const size_t hstepB = (size_t)HALF * S.ldb * 2;
    const unsigned ldsw = (unsigned)wid * 1024u;
    const int aoff0 = lds_byte(wr * 64 + fr, fq * 8), aoff1 = aoff0 + 1024;
    const int boff0 = lds_byte(wc * 32 + fr, fq * 8), boff1 = boff0 + 1024;
#define G_SA(b, h) (((b) * 2 + (h)) * HTB)
#define G_SB(b, h) ((4 + (b) * 2 + (h)) * HTB)
#define G_STAGE(bufoff, gbase, voff) do { _Pragma("unroll") for (int _i = 0; _i < 2; ++_i) \
        __builtin_amdgcn_global_load_lds((const unsigned*)((const char*)(gbase) + (voff)[_i]), (LAS unsigned*)(lds + (bufoff) + ldsw + _i * 8192), 16, 0, 0); } while (0)
#define G_LDA(dst, b, h) do { _Pragma("unroll") for (int m = 0; m < 4; ++m) ld_frag(dst[m], lds + G_SA(b, h) + aoff0 + m * 2048, lds + G_SA(b, h) + aoff1 + m * 2048); } while (0)
#define G_LDB(dst, b, h) do { _Pragma("unroll") for (int n = 0; n < 2; ++n) ld_frag(dst[n], lds + G_SB(b, h) + boff0 + n * 2048, lds + G_SB(b, h) + boff1 + n * 2048); } while (0)
#define G_MMA(ai, bj, At, Bt) do { __builtin_amdgcn_s_setprio(1); _Pragma("unroll") for (int m = 0; m < 4; ++m) _Pragma("unroll") for (int n = 0; n < 2; ++n) \
        acc[ai][bj][m][n] = mma_frag(Bt[n], At[m], acc[ai][bj][m][n]); __builtin_amdgcn_s_setprio(0); } while (0)
#define G_WAIT_V(n) asm volatile("s_waitcnt vmcnt(" #n ")" ::: "memory")
#define G_WAIT_L(n) asm volatile("s_waitcnt lgkmcnt(" #n ")" ::: "memory")
#define G_BAR __builtin_amdgcn_s_barrier()
#define G_SCHED __builtin_amdgcn_sched_barrier(0)
    Unit cur, nxt; int ui = 0;
    if (!S.next(0, cur)) return;
    f32x4 acc[2][2][4][2];
#pragma unroll
    for (int a = 0; a < 2; ++a)
#pragma unroll
        for (int b = 0; b < 2; ++b)
#pragma unroll
            for (int m = 0; m < 4; ++m)
#pragma unroll
                for (int n = 0; n < 2; ++n) acc[a][b][m][n] = (f32x4){0.f, 0.f, 0.f, 0.f};
    FragT<P::FP8> At[4], B0[2], B1[2];
    const char* cA; unsigned coff[2][2];
    S.a_src(cur, R, C, cA, coff);
    const char* cB = S.b_src(cur);
    if constexpr (P::AUX) S.aux_issue(cur, lds + AUX_OFF, lane);
    G_STAGE(G_SB(0, 0), cB, voffB); G_STAGE(G_SB(0, 1), cB + hstepB, voffB); G_STAGE(G_SA(0, 0), cA, coff[0]); G_STAGE(G_SA(0, 1), cA, coff[1]);
    if (wr == 1) G_BAR;
    G_WAIT_V(2); G_BAR;
    G_STAGE(G_SB(1, 0), cB + kstepB, voffB); G_STAGE(G_SA(1, 0), cA + kstepA, coff[0]); G_STAGE(G_SB(1, 1), cB + hstepB + kstepB, voffB);
    G_WAIT_V(6); G_BAR;
    for (;;) {
        const bool has_next = S.next(ui + 1, nxt);
        const char* nA = cA; unsigned noff[2][2] = {{coff[0][0], coff[0][1]}, {coff[1][0], coff[1][1]}}; const char* nB = cB;
        if (has_next) { S.a_src(nxt, R, C, nA, noff); nB = S.b_src(nxt); }
        for (int t = 0; t < nt; t += 2) {
            const bool last = (t == nt - 2);
            const char* a1 = cA + (size_t)(t + 1) * kstepA;
            const char* a2 = last ? nA : cA + (size_t)(t + 2) * kstepA; const char* b2 = last ? nB : cB + (size_t)(t + 2) * kstepB;
            const char* a3 = a2 + kstepA; const char* b3 = b2 + kstepB;
            unsigned o2[2][2]; const unsigned lmask = last ? 0xffffffffu : 0u;
#pragma unroll
            for (int h = 0; h < 2; ++h)
#pragma unroll
                for (int i = 0; i < 2; ++i) o2[h][i] = coff[h][i] ^ ((coff[h][i] ^ noff[h][i]) & lmask);
            G_LDB(B0, 0, 0); G_LDB(B1, 0, 1); G_SCHED; G_LDA(At, 0, 0); G_STAGE(G_SA(1, 1), a1, coff[1]);
            G_WAIT_V(8); G_WAIT_L(0); G_BAR; G_MMA(0, 0, At, B0); G_MMA(0, 1, At, B1); G_BAR; G_SCHED;
            G_LDA(At, 0, 1); G_STAGE(G_SB(0, 0), b2, voffB); G_STAGE(G_SB(0, 1), b2 + hstepB, voffB); G_STAGE(G_SA(0, 0), a2, o2[0]);
            G_WAIT_V(8); G_WAIT_L(0); G_BAR; G_MMA(1, 0, At, B0); G_MMA(1, 1, At, B1); G_BAR; G_SCHED;
            G_LDB(B0, 1, 0); G_LDB(B1, 1, 1); G_SCHED; G_LDA(At, 1, 0); G_STAGE(G_SA(0, 1), a2, o2[1]);
            G_WAIT_V(8); G_WAIT_L(0); G_BAR; G_MMA(0, 0, At, B0); G_MMA(0, 1, At, B1); G_BAR; G_SCHED;
            G_LDA(At, 1, 1); G_STAGE(G_SB(1, 0), b3, voffB); G_STAGE(G_SB(1, 1), b3 + hstepB, voffB); G_STAGE(G_SA(1, 0), a3, o2[0]);
            G_WAIT_V(8); G_WAIT_L(0); G_BAR; G_MMA(1, 0, At, B0); G_MMA(1, 1, At, B1); G_BAR; G_SCHED;
        }
        if (wr == 0) G_BAR;
        if (P::FP8) asm volatile("s_nop 15\n\ts_nop 15" ::: "memory");
        S.epi(acc, cur, wr, wc, fr, fq, lds + AUX_OFF + (ui & 1) * AUX_SLOT);
        if (!has_next) break;
#pragma unroll
        for (int a = 0; a < 2; ++a)
#pragma unroll
            for (int b = 0; b < 2; ++b)
#pragma unroll
                for (int m = 0; m < 4; ++m)
#pragma unroll
                    for (int n = 0; n < 2; ++n) acc[a][b][m][n] = (f32x4){0.f, 0.f, 0.f, 0.f};
        if (P::FP8) asm volatile("s_nop 7" ::: "memory");
        cur = nxt; cA = nA; cB = nB; ++ui;
        if constexpr (P::AUX) S.aux_issue(cur, lds + AUX_OFF + (ui & 1) * AUX_SLOT, lane);
        if (wr == 1) G_BAR;
#pragma unroll
        for (int h = 0; h < 2; ++h)
#pragma unroll
            for (int i = 0; i < 2; ++i) coff[h][i] = noff[h][i];
    }
    G_WAIT_V(0);
    G_BAR;
#undef G_SA
#undef G_SB
#undef G_STAGE
#undef G_LDA
#undef G_LDB
#undef G_MMA
#undef G_WAIT_V
#undef G_WAIT_L
#undef G_BAR
#undef G_SCHED
}

template <class P>
DI void gemm_phase_gather(LAS unsigned char* lds, const P& S) {
    const int tid = threadIdx.x, wid = __builtin_amdgcn_readfirstlane(tid >> 6), lane = tid & 63, wr = wid >> 2, wc = wid & 3, fr = lane & 15, fq = lane >> 4;
    const int nt = S.nt;
    int R[2], C[2]; unsigned voffB[2];
#pragma unroll
    for (int i = 0; i < 2; ++i) { stage_rc(tid * 16 + i * 8192, R[i], C[i]); const int Rb = P::PERM ? ((R[i] & ~31) + perm32(R[i] & 31)) : R[i]; voffB[i] = (unsigned)(Rb * S.ldb + C[i]) * 2u; }
    const size_t kstepA = (size_t)S.kstepA, kstepB = (size_t)(BK * 2);
    const size_t hstepB = (size_t)HALF * S.ldb * 2;
    const unsigned ldsw = (unsigned)wid * 1024u;
    const int aoff0 = lds_byte(wr * 64 + fr, fq * 8), aoff1 = aoff0 + 1024;
    const int boff0 = lds_byte(wc * 32 + fr, fq * 8), boff1 = boff0 + 1024;
#define G_SA(b, h) (((b) * 2 + (h)) * HTB)
#define G_SB(b, h) ((4 + (b) * 2 + (h)) * HTB)
#define G_STAGE(bufoff, gbase, voff) do { _Pragma("unroll") for (int _i = 0; _i < 2; ++_i) \
        __builtin_amdgcn_global_load_lds((const unsigned*)((const char*)(gbase) + (voff)[_i]), (LAS unsigned*)(lds + (bufoff) + ldsw + _i * 8192), 16, 0, 0); } while (0)
#define G_LDA(dst, b, h) do { _Pragma("unroll") for (int m = 0; m < 4; ++m) ld_frag(dst[m], lds + G_SA(b, h) + aoff0 + m * 2048, lds + G_SA(b, h) + aoff1 + m * 2048); } while (0)
#define G_LDB(dst, b, h) do { _Pragma("unroll") for (int n = 0; n < 2; ++n) ld_frag(dst[n], lds + G_SB(b, h) + boff0 + n * 2048, lds + G_SB(b, h) + boff1 + n * 2048); } while (0)
#define G_MMA(ai, bj, At, Bt) do { __builtin_amdgcn_s_setprio(1); _Pragma("unroll") for (int m = 0; m < 4; ++m) _Pragma("unroll") for (int n = 0; n < 2; ++n) \
        acc[ai][bj][m][n] = mma_frag(Bt[n], At[m], acc[ai][bj][m][n]); __builtin_amdgcn_s_setprio(0); } while (0)
#define G_WAIT_V(n) asm volatile("s_waitcnt vmcnt(" #n ")" ::: "memory")
#define G_WAIT_L(n) asm volatile("s_waitcnt lgkmcnt(" #n ")" ::: "memory")
#define G_BAR __builtin_amdgcn_s_barrier()
#define G_SCHED __builtin_amdgcn_sched_barrier(0)
    Unit cur, nxt; int ui = 0;
    if (!S.next(0, cur)) return;
    f32x4 acc[2][2][4][2];
#pragma unroll
    for (int a = 0; a < 2; ++a)
#pragma unroll
        for (int b = 0; b < 2; ++b)
#pragma unroll
            for (int m = 0; m < 4; ++m)
#pragma unroll
                for (int n = 0; n < 2; ++n) acc[a][b][m][n] = (f32x4){0.f, 0.f, 0.f, 0.f};
    FragT<P::FP8> At[4], B0[2], B1[2];
    const char* cA = S.a_base(cur);
    const char* cB = S.b_src(cur);
    S.ids_issue(cur, lds + AUX_OFF + 2048, lane); S.aux_issue(cur, lds + AUX_OFF, lane);
    G_WAIT_V(0);
    int crl = cur.rl, ccn = S.dir.cnt[cur.e];
#define G_AOFF(dst, slot_, rl_, cn_, h_) do { _Pragma("unroll") for (int _i = 0; _i < 2; ++_i) { const int _r = (h_) * HALF + R[_i]; int _t = ((const LAS int*)(slot_))[_r]; _t = ((rl_) * BM + _r) < (cn_) ? _t : 0; dst[_i] = (unsigned)(_t * DM + C[_i] * 2); } } while (0)
    unsigned ao[2];
    { const LAS unsigned char* s0 = lds + AUX_OFF + 2048; G_STAGE(G_SB(0, 0), cB, voffB); G_STAGE(G_SB(0, 1), cB + hstepB, voffB); G_AOFF(ao, s0, crl, ccn, 0); G_STAGE(G_SA(0, 0), cA, ao); G_AOFF(ao, s0, crl, ccn, 1); G_STAGE(G_SA(0, 1), cA, ao); }
    if (wr == 1) G_BAR;
    G_WAIT_V(2); G_BAR;
    { const LAS unsigned char* s0 = lds + AUX_OFF + 2048; G_STAGE(G_SB(1, 0), cB + kstepB, voffB); G_AOFF(ao, s0, crl, ccn, 0); G_STAGE(G_SA(1, 0), cA + kstepA, ao); G_STAGE(G_SB(1, 1), cB + hstepB + kstepB, voffB); }
    G_WAIT_V(6); G_BAR;
    for (;;) {
        const bool has_next = S.next(ui + 1, nxt);
        const char* nA = cA; const char* nB = cB; int nrl = crl, ncn = ccn;
        const LAS unsigned char* slc = lds + AUX_OFF + (ui & 1) * AUX_SLOT + 2048; const LAS unsigned char* sln = lds + AUX_OFF + ((ui + 1) & 1) * AUX_SLOT + 2048;
        if (has_next) { nA = S.a_base(nxt); nB = S.b_src(nxt); nrl = nxt.rl; ncn = S.dir.cnt[nxt.e]; S.ids_issue(nxt, lds + AUX_OFF + ((ui + 1) & 1) * AUX_SLOT + 2048, lane); }
        for (int t = 0; t < nt; t += 2) {
            const bool last = (t == nt - 2);
            const char* a1 = cA + (size_t)(t + 1) * kstepA;
            const char* a2 = last ? nA : cA + (size_t)(t + 2) * kstepA; const char* b2 = last ? nB : cB + (size_t)(t + 2) * kstepB;
            const char* a3 = a2 + kstepA; const char* b3 = b2 + kstepB;
            const LAS unsigned char* sl2 = (last && has_next) ? sln : slc; const int rl2 = (last && has_next) ? nrl : crl, cn2 = (last && has_next) ? ncn : ccn;
            G_LDB(B0, 0, 0); G_LDB(B1, 0, 1); G_SCHED; G_LDA(At, 0, 0); G_AOFF(ao, slc, crl, ccn, 1); G_STAGE(G_SA(1, 1), a1, ao);
            G_WAIT_V(8); G_WAIT_L(0); G_BAR; G_MMA(0, 0, At, B0); G_MMA(0, 1, At, B1); G_BAR; G_SCHED;
            G_LDA(At, 0, 1); G_STAGE(G_SB(0, 0), b2, voffB); G_STAGE(G_SB(0, 1), b2 + hstepB, voffB); G_AOFF(ao, sl2, rl2, cn2, 0); G_STAGE(G_SA(0, 0), a2, ao);
            G_WAIT_V(8); G_WAIT_L(0); G_BAR; G_MMA(1, 0, At, B0); G_MMA(1, 1, At, B1); G_BAR; G_SCHED;
            G_LDB(B0, 1, 0); G_LDB(B1, 1, 1); G_SCHED; G_LDA(At, 1, 0); G_AOFF(ao, sl2, rl2, cn2, 1); G_STAGE(G_SA(0, 1), a2, ao);
            G_WAIT_V(8); G_WAIT_L(0); G_BAR; G_MMA(0, 0, At, B0); G_MMA(0, 1, At, B1); G_BAR; G_SCHED;
            G_LDA(At, 1, 1); G_STAGE(G_SB(1, 0), b3, voffB); G_STAGE(G_SB(1, 1), b3 + hstepB, voffB); G_AOFF(ao, sl2, rl2, cn2, 0); G_STAGE(G_SA(1, 0), a3, ao);
            G_WAIT_V(8); G_WAIT_L(0); G_BAR; G_MMA(1, 0, At, B0); G_MMA(1, 1, At, B1); G_BAR; G_SCHED;
        }
        if (wr == 0) G_BAR;
        if (P::FP8) asm volatile("s_nop 15\n\ts_nop 15" ::: "memory");
        S.epi(acc, cur, wr, wc, fr, fq, lds + AUX_OFF + (ui & 1) * AUX_SLOT);
        if (!has_next) break;
#pragma unroll
        for (int a = 0; a < 2; ++a)
#pragma unroll
            for (int b = 0; b < 2; ++b)
#pragma unroll
                for (int m = 0; m < 4; ++m)
#pragma unroll
                    for (int n = 0; n < 2; ++n) acc[a][b][m][n] = (f32x4){0.f, 0.f, 0.f, 0.f};
        if (P::FP8) asm volatile("s_nop 7" ::: "memory");
        cur = nxt; cA = nA; cB = nB; ++ui;
        if constexpr (P::AUX) S.aux_issue(cur, lds + AUX_OFF + (ui & 1) * AUX_SLOT, lane);
        if (wr == 1) G_BAR;
        crl = nrl; ccn = ncn;
    }
    G_WAIT_V(0);
    G_BAR;
#undef G_AOFF
#undef G_SA
#undef G_SB
#undef G_STAGE
#undef G_LDA
#undef G_LDB
#undef G_MMA
#undef G_WAIT_V
#undef G_WAIT_L
#undef G_BAR
#undef G_SCHED
}

template <int NPN> DI bool unit_map(int i, int G, int c, int n_rt, Unit& u) {
    const int L = i * G + c, x = L & 7, q = L >> 3;
    u.rt = (q / NPN) * 8 + x; u.pn = q % NPN; u.e = 0; u.rl = 0;
    return u.rt < n_rt;
}

DI void store8_bf16(bf16_t* p, const f32x4& v0, const f32x4& v1) {
    u32x4 w; w.x = cvt_pk_bf16(v0[0], v0[1]); w.y = cvt_pk_bf16(v0[2], v0[3]); w.z = cvt_pk_bf16(v1[0], v1[1]); w.w = cvt_pk_bf16(v1[2], v1[3]);
    __builtin_nontemporal_store(w, (u32x4*)p);
}

template <int NPN, int ACT> struct DenseBf16 {
    static constexpr bool PERM = true, FP8 = false, AUX = false;
    int nt, kstepA, ldb; int G, c, n_rt;
    const bf16_t* A; int lda; const bf16_t* Bt; bf16_t* O; int ldo;
    const float* bias0; const float* bias1; int bsplit, bend;
    DI bool next(int i, Unit& u) const { return unit_map<NPN>(i, G, c, n_rt, u); }
    DI void a_src(const Unit& u, const int (&R)[2], const int (&C)[2], const char*& base, unsigned (&off)[2][2]) const {
        base = (const char*)(A + (size_t)u.rt * BM * lda);
#pragma unroll
        for (int h = 0; h < 2; ++h)
#pragma unroll
            for (int i = 0; i < 2; ++i) off[h][i] = (unsigned)((h * HALF + R[i]) * lda + C[i]) * 2u;
    }
    DI const char* b_src(const Unit& u) const { return (const char*)(Bt + (size_t)u.pn * BM * ldb); }
    DI float bias_at(int col) const { if (col < bsplit) return bias0 ? bias0[col] : 0.f; if (col < bend) return bias1 ? bias1[col - bsplit] : 0.f; return 0.f; }
    DI void epi(const f32x4 (&acc)[2][2][4][2], const Unit& u, int wr, int wc, int fr, int fq, const LAS unsigned char* aux) const {
        const int row0 = u.rt * BM + wr * 64 + fr, col0 = u.pn * BM + wc * 32 + 8 * fq;
#pragma unroll
        for (int bj = 0; bj < 2; ++bj) {
            f32x4 b0, b1;
#pragma unroll
            for (int j = 0; j < 4; ++j) { b0[j] = bias_at(col0 + bj * HALF + j); b1[j] = bias_at(col0 + bj * HALF + 4 + j); }
#pragma unroll
            for (int ai = 0; ai < 2; ++ai)
#pragma unroll
                for (int m = 0; m < 4; ++m) {
                    f32x4 v0 = acc[ai][bj][m][0] + b0, v1 = acc[ai][bj][m][1] + b1;
                    if (ACT == 1) {
#pragma unroll
                        for (int j = 0; j < 4; ++j) { v0[j] = gelu_tanh(v0[j]); v1[j] = gelu_tanh(v1[j]); }
                    }
                    store8_bf16(O + (size_t)(row0 + ai * HALF + m * 16) * ldo + col0 + bj * HALF, v0, v1);
                }
        }
    }
};

struct CmpGemm {
    static constexpr bool PERM = true, FP8 = false, AUX = false;
    int nt, kstepA, ldb; int G, c;
    const bf16_t* proj; const bf16_t* cw1t; bf16_t* hid; const float* biasc;
    DI bool next(int i, Unit& u) const { const int L = i * G + c; u.e = L & 1; u.rt = L >> 1; u.pn = 0; u.rl = 0; return L < 64; }
    DI void a_src(const Unit& u, const int (&R)[2], const int (&C)[2], const char*& base, unsigned (&off)[2][2]) const {
        base = (const char*)proj;
#pragma unroll
        for (int h = 0; h < 2; ++h)
#pragma unroll
            for (int i = 0; i < 2; ++i) {
                const int m = u.rt * BM + h * HALF + R[i], b = m >> 8, kvh = (m >> 7) & 1; int n = m & 127; n = n > 126 ? 126 : n;
                off[h][i] = (unsigned)(((size_t)(b * SEQ + n * 16) * NPROJ + (u.e ? C_VC : C_KC) + kvh * 64 + C[i]) * 2u);
            }
    }
    DI const char* b_src(const Unit& u) const { return (const char*)(cw1t + (size_t)u.e * 256 * 2048); }
    DI void epi(const f32x4 (&acc)[2][2][4][2], const Unit& u, int wr, int wc, int fr, int fq, const LAS unsigned char* aux) const {
        const int row0 = u.rt * BM + wr * 64 + fr, col0 = wc * 32 + 8 * fq;
        bf16_t* O = hid + (size_t)u.e * 8192 * 256; const float* bs = biasc + u.e * 256;
#pragma unroll
        for (int bj = 0; bj < 2; ++bj) {
            f32x4 b0 = *(const f32x4*)(bs + col0 + bj * HALF), b1 = *(const f32x4*)(bs + col0 + bj * HALF + 4);
#pragma unroll
            for (int ai = 0; ai < 2; ++ai)
#pragma unroll
                for (int m = 0; m < 4; ++m) {
                    f32x4 v0 = acc[ai][bj][m][0] + b0, v1 = acc[ai][bj][m][1] + b1;
#pragma unroll
                    for (int j = 0; j < 4; ++j) { v0[j] = gelu_tanh(v0[j]); v1[j] = gelu_tanh(v1[j]); }
                    store8_bf16(O + (size_t)(row0 + ai * HALF + m * 16) * 256 + col0 + bj * HALF, v0, v1);
                }
        }
    }
};

struct OutProj {
    static constexpr bool PERM = false, FP8 = false, AUX = false;
    int nt, kstepA, ldb; int G, c;
    const bf16_t* A; const bf16_t* Bt; const float* x; float* out;
    DI bool next(int i, Unit& u) const { return unit_map<4>(i, G, c, T_TOK / BM, u); }
    DI void a_src(const Unit& u, const int (&R)[2], const int (&C)[2], const char*& base, unsigned (&off)[2][2]) const {
        base = (const char*)(A + (size_t)u.rt * BM * DM);
#pragma unroll
        for (int h = 0; h < 2; ++h)
#pragma unroll
            for (int i = 0; i < 2; ++i) off[h][i] = (unsigned)((h * HALF + R[i]) * DM + C[i]) * 2u;
    }
    DI const char* b_src(const Unit& u) const { return (const char*)(Bt + (size_t)u.pn * BM * DM); }
    DI void epi(const f32x4 (&acc)[2][2][4][2], const Unit& u, int wr, int wc, int fr, int fq, const LAS unsigned char* aux) const {
        const int row0 = u.rt * BM + wr * 64 + fr, col0 = u.pn * BM + wc * 32 + 4 * fq;
#pragma unroll
        for (int ai = 0; ai < 2; ++ai)
#pragma unroll
            for (int m = 0; m < 4; ++m) {
                const size_t ro = (size_t)(row0 + ai * HALF + m * 16) * DM + col0;
#pragma unroll
                for (int bj = 0; bj < 2; ++bj)
#pragma unroll
                    for (int n = 0; n < 2; ++n) { const f32x4 xv = *(const f32x4*)(x + ro + bj * HALF + n * 16); *(f32x4*)(out + ro + bj * HALF + n * 16) = acc[ai][bj][m][n] + xv; }
            }
    }
};

constexpr int NLIST = NEXP;
struct MoeDir { const LAS int* pref; const LAS int* cnt; const LAS int* rpref; };
DI int dir_search(const LAS int* p, int n, int v) { int lo = 0, hi = n;
#pragma unroll 1
    while (hi - lo > 1) { const int mid = (lo + hi) >> 1; if (p[mid] <= v) lo = mid; else hi = mid; }
    return lo; }

struct Moe1 {
    static constexpr bool PERM = true, FP8 = true, AUX = true;
    int nt, kstepA, ldb; int G, c;
    MoeDir dir; const unsigned char* h; const unsigned char* w1t; const float* b1; const int* ids; const float* rsl; unsigned char* act;
    DI bool next(int i, Unit& u) const { if (!unit_map<8>(i, G, c, dir.pref[NLIST], u)) return false; u.e = dir_search(dir.pref, NLIST, u.rt); u.rl = u.rt - dir.pref[u.e]; return true; }
    DI void a_src(const Unit& u, const int (&R)[2], const int (&C)[2], const char*& base, unsigned (&off)[2][2]) const {
        base = (const char*)h; const int cn = dir.cnt[u.e];
#pragma unroll
        for (int hh = 0; hh < 2; ++hh)
#pragma unroll
            for (int i = 0; i < 2; ++i) { const int idx = u.rl * BM + hh * HALF + R[i]; const int tok = idx < cn ? ids[(size_t)u.e * T_TOK + idx] : 0; off[hh][i] = (unsigned)(tok * DM + C[i] * 2); }
    }
    DI const char* b_src(const Unit& u) const { return (const char*)(w1t + ((size_t)u.e * 2048 + (size_t)u.pn * BM) * DM); }
    DI const char* a_base(const Unit&) const { return (const char*)h; }
    DI void ids_issue(const Unit& u, LAS unsigned char* dst, int lane) const {
        __builtin_amdgcn_global_load_lds((const unsigned*)(ids + (size_t)u.e * T_TOK + (size_t)u.rl * BM + lane * 4), (LAS unsigned*)dst, 16, 0, 0);
    }
    DI void aux_issue(const Unit& u, LAS unsigned char* slot, int lane) const {
        const float* rsrc = rsl + (size_t)u.e * T_TOK + (size_t)u.rl * BM + lane * 4;
        const float* bsrc = b1 + (size_t)u.e * 2048 + (lane >> 5) * 1024 + u.pn * 128 + (lane & 31) * 4;
        __builtin_amdgcn_global_load_lds((const unsigned*)rsrc, (LAS unsigned*)slot, 16, 0, 0);
        __builtin_amdgcn_global_load_lds((const unsigned*)bsrc, (LAS unsigned*)(slot + 1024), 16, 0, 0);
    }
    DI void epi(const f32x4 (&acc)[2][2][4][2], const Unit& u, int wr, int wc, int fr, int fq, const LAS unsigned char* aux) const {
        const int row0 = u.rt * BM + wr * 64 + fr, cl = wc * 32 + 8 * fq;
        const LAS float* ars = (const LAS float*)aux; const LAS float* ab = ars + 256 + cl;
        const f32x4 g0 = *(const LAS f32x4*)ab, g1 = *(const LAS f32x4*)(ab + 4), l0 = *(const LAS f32x4*)(ab + 128), l1 = *(const LAS f32x4*)(ab + 132);
#pragma unroll
        for (int ai = 0; ai < 2; ++ai)
#pragma unroll
            for (int m = 0; m < 4; ++m) {
                f32x4 v[2];
                const float rs32 = ars[ai * HALF + wr * 64 + m * 16 + fr] * (1.0f / 32.0f);
#pragma unroll
                for (int n = 0; n < 2; ++n)
#pragma unroll
                    for (int j = 0; j < 4; ++j) {
                        float glu = acc[ai][0][m][n][j] * rs32 + (n ? g1[j] : g0[j]), lin = acc[ai][1][m][n][j] * rs32 + (n ? l1[j] : l0[j]);
                        glu = fminf(glu, 7.0f); lin = fminf(fmaxf(lin, -7.0f), 7.0f);
                        v[n][j] = glu * __builtin_amdgcn_rcpf(1.0f + __builtin_amdgcn_exp2f(-1.702f * 1.4426950408889634f * glu)) * (lin + 1.0f);
                    }
                { u32x2 w8; w8.x = cvt4_fp8(v[0][0], v[0][1], v[0][2], v[0][3]); w8.y = cvt4_fp8(v[1][0], v[1][1], v[1][2], v[1][3]); *(u32x2*)(act + (size_t)(row0 + ai * HALF + m * 16) * DFF + u.pn * 128 + cl) = w8; }
            }
    }
};

struct Moe2 {
    static constexpr bool PERM = true, FP8 = true, AUX = true;
    int nt, kstepA, ldb; int G, c;
    MoeDir dir; const unsigned char* act; const unsigned char* w2t; const float* b2; unsigned char* ws;
    DI bool next(int i, Unit& u) const { if (!unit_map<4>(i, G, c, dir.pref[NLIST], u)) return false; u.e = dir_search(dir.pref, NLIST, u.rt); u.rl = u.rt - dir.pref[u.e]; return true; }
    DI void a_src(const Unit& u, const int (&R)[2], const int (&C)[2], const char*& base, unsigned (&off)[2][2]) const {
        base = (const char*)(act + (size_t)u.rt * BM * DFF);
#pragma unroll
        for (int h = 0; h < 2; ++h)
#pragma unroll
            for (int i = 0; i < 2; ++i) off[h][i] = (unsigned)((h * HALF + R[i]) * DFF + C[i] * 2);
    }
    DI const char* b_src(const Unit& u) const { return (const char*)(w2t + ((size_t)u.e * 1024 + (size_t)u.pn * BM) * DFF); }
    DI void aux_issue(const Unit& u, LAS unsigned char* slot, int lane) const {
        __builtin_amdgcn_global_load_lds((const unsigned*)(b2 + (size_t)u.e * DM + u.pn * BM + lane * 4), (LAS unsigned*)slot, 16, 0, 0);
    }
    DI void epi(const f32x4 (&acc)[2][2][4][2], const Unit& u, int wr, int wc, int fr, int fq, const LAS unsigned char* aux) const {
        const int row0 = u.rt * BM + wr * 64 + fr, col0 = u.pn * BM + wc * 32 + 8 * fq;
#pragma unroll
        for (int bj = 0; bj < 2; ++bj) {
            const LAS float* ab = (const LAS float*)aux + wc * 32 + 8 * fq + bj * HALF; const f32x4 b0 = *(const LAS f32x4*)ab, b1 = *(const LAS f32x4*)(ab + 4);
#pragma unroll
            for (int ai = 0; ai < 2; ++ai)
#pragma unroll
                for (int m = 0; m < 4; ++m) {
                    const f32x4 v0 = acc[ai][bj][m][0] * (1.0f / 32.0f) + b0, v1 = acc[ai][bj][m][1] * (1.0f / 32.0f) + b1;
                    store8_bf16((bf16_t*)(ws + y_row_off(row0 + ai * HALF + m * 16)) + col0 + bj * HALF, v0, v1);
                }
        }
    }
};

struct Ctx {
#if defined(__HIP_DEVICE_COMPILE__)
    const __constant__ void* kargs;
#else
    const void* kargs;
#endif
    float* out; unsigned char* ws;
    LAS unsigned char* lds; int tid, lane, wave, G, bid;
    DI const float* in(int k) const {
#if defined(__HIP_DEVICE_COMPILE__)
        return ((const float* const __constant__*)kargs)[k];
#else
        return nullptr;
#endif
    }
    DI bf16_t* xn() const { return (bf16_t*)(ws + WS_XN); }
    DI bf16_t* proj() const { return (bf16_t*)(ws + WS_PROJ); }
    DI bf16_t* ksr() const { return (bf16_t*)(ws + WS_KSR); }
    DI bf16_t* kwr() const { return (bf16_t*)(ws + WS_KWR); }
    DI bf16_t* vst() const { return (bf16_t*)(ws + WS_VST); }
    DI bf16_t* vwt() const { return (bf16_t*)(ws + WS_VWT); }
    DI bf16_t* lout() const { return (bf16_t*)(ws + WS_LOUT); }
    DI bf16_t* lact() const { return (bf16_t*)(ws + WS_LACT); }
    DI bf16_t* wcat() const { return (bf16_t*)(ws + WS_WCAT); }
    DI bf16_t* woutt() const { return (bf16_t*)(ws + WS_WOUT); }
    DI bf16_t* cw1t() const { return (bf16_t*)(ws + WS_CW1); }
    DI bf16_t* wl2t() const { return (bf16_t*)(ws + WS_WL2); }
    DI bf16_t* hid() const { return (bf16_t*)(ws + WS_HID); }
    DI bf16_t* kcmp() const { return (bf16_t*)(ws + WS_KCMP); }
    DI bf16_t* vcmpt() const { return (bf16_t*)(ws + WS_VCMPT); }
    DI float* rope() const { return (float*)(ws + WS_ROPE); }
    DI float* biasc() const { return (float*)(ws + WS_BIASC); }
    DI int* ctl() const { return (int*)(ws + WS_CTL); }
    DI int* ids() const { return (int*)(ws + WS_IDS); }
    DI float* gts() const { return (float*)(ws + WS_GTS); }
    DI float* rsl() const { return (float*)(ws + WS_RSL); }
    DI bf16_t* wrt() const { return (bf16_t*)(ws + WS_WRT); }
    DI unsigned char* w1t() const { return ws + WS_W1T; }
    DI unsigned char* w2t() const { return ws + WS_W2T; }
    DI unsigned char* act() const { return ws + WS_ACT; }
    DI unsigned char* h8() const { return ws + WS_XN; }
};
enum { I_X = 0, I_LN1, I_WIN, I_MURKV, I_MUWAG, I_W0, I_W1, I_W2, I_A0, I_A1, I_A2, I_G1, I_G2, I_KK, I_KA, I_RK, I_LNXG, I_LNXB, I_QNG, I_KNG, I_PE, I_CW1, I_CW2, I_WOUT, I_LN2, I_MWR, I_MBR, I_MW1, I_MB1, I_MW2, I_MB2 };

template <class F>
DI void tconv_tile(const Ctx& c, F src, bf16_t* dst, size_t ld_dst, int k0, int nsrc0, int ndst0) {
    LAS float* tile = (LAS float*)c.lds;
    const int tk = c.tid >> 6, tn = c.tid & 63;
#pragma unroll
    for (int j = 0; j < 8; ++j) { const int k = tk + 8 * j; tile[k * 65 + tn] = src(k0 + k, nsrc0 + tn); }
    __syncthreads();
    const int n = c.tid >> 3, kq = c.tid & 7;
    float v[8];
#pragma unroll
    for (int jj = 0; jj < 8; ++jj) v[jj] = tile[(kq * 8 + jj) * 65 + n];
    u32x4 w; w.x = cvt_pk_bf16(v[0], v[1]); w.y = cvt_pk_bf16(v[2], v[3]); w.z = cvt_pk_bf16(v[4], v[5]); w.w = cvt_pk_bf16(v[6], v[7]);
    *(u32x4*)(dst + (size_t)(ndst0 + n) * ld_dst + k0 + kq * 8) = w;
    __syncthreads();
}

template <class F>
DI void tconv_tile_fp8(const Ctx& c, F src, unsigned char* dst, size_t ld_dst, int k0, int nsrc0, int ndst0, float scale) {
    LAS float* tile = (LAS float*)c.lds;
    const int tk = c.tid >> 6, tn = c.tid & 63;
#pragma unroll
    for (int j = 0; j < 8; ++j) { const int k = tk + 8 * j; tile[k * 65 + tn] = src(k0 + k, nsrc0 + tn); }
    __syncthreads();
    const int n = c.tid >> 3, kq = c.tid & 7;
    float v[8];
#pragma unroll
    for (int jj = 0; jj < 8; ++jj) v[jj] = tile[(kq * 8 + jj) * 65 + n] * scale;
    u32x2 w; w.x = cvt4_fp8(v[0], v[1], v[2], v[3]); w.y = cvt4_fp8(v[4], v[5], v[6], v[7]);
    *(u32x2*)(dst + (size_t)(ndst0 + n) * ld_dst + k0 + kq * 8) = w;
    __syncthreads();
}

template <class D>
DI void tconv_big_fp8(const Ctx& c, const float* src, size_t ld_src, unsigned char* dst, size_t ld_dst, int k0, int n0, D drow, float scale) {
    LAS float* tile = (LAS float*)c.lds;
    const int tk = c.tid >> 6, tn = c.tid & 63;
    f32x4 v[8];
#pragma unroll
    for (int j = 0; j < 8; ++j) v[j] = *(const f32x4*)(src + (size_t)(k0 + tk + 8 * j) * ld_src + n0 + tn * 4);
#pragma unroll
    for (int j = 0; j < 8; ++j) *(LAS f32x4*)(tile + (tk + 8 * j) * 260 + tn * 4) = v[j];
    __syncthreads();
    const int n = c.tid >> 1, kh = c.tid & 1;
    u32x4 w[2];
#pragma unroll
    for (int q = 0; q < 8; ++q) { const LAS float* t = tile + (kh * 32 + q * 4) * 260 + n; w[q >> 2][q & 3] = cvt4_fp8(t[0] * scale, t[260] * scale, t[520] * scale, t[780] * scale); }
    unsigned char* d = dst + (size_t)drow(n0 + n) * ld_dst + k0 + kh * 32;
    *(u32x4*)d = w[0]; *(u32x4*)(d + 16) = w[1];
    __syncthreads();
}

DI void p0_prologue(const Ctx& c) {
    const float* x = c.in(I_X); const float* ln1 = c.in(I_LN1);
    if (c.bid == 0 && c.tid < 256) c.ctl()[c.tid] = 0;
    {
        bf16_t* xn = c.xn();
        const int gw = c.bid * 8 + c.wave, nw = c.G * 8;
        f32x4 g[4];
#pragma unroll
        for (int i = 0; i < 4; ++i) g[i] = ((const f32x4*)ln1)[c.lane + 64 * i];
        for (int row = gw; row < T_TOK; row += 2 * nw) {
            const int row2 = row + nw < T_TOK ? row + nw : row;
            const f32x4* xr = (const f32x4*)(x + (size_t)row * DM); const f32x4* xr2 = (const f32x4*)(x + (size_t)row2 * DM);
            f32x4 v[4], v2[4]; float ss = 0.f, ss2 = 0.f;
#pragma unroll
            for (int i = 0; i < 4; ++i) { v[i] = __builtin_nontemporal_load(xr + c.lane + 64 * i); v2[i] = __builtin_nontemporal_load(xr2 + c.lane + 64 * i); }
#pragma unroll
            for (int i = 0; i < 4; ++i) { ss += v[i][0] * v[i][0] + v[i][1] * v[i][1] + v[i][2] * v[i][2] + v[i][3] * v[i][3]; ss2 += v2[i][0] * v2[i][0] + v2[i][1] * v2[i][1] + v2[i][2] * v2[i][2] + v2[i][3] * v2[i][3]; }
            ss = wave_sum(ss); ss2 = wave_sum(ss2);
            const float sc = rsqrtf(ss * (1.0f / DM) + 1e-6f), sc2 = rsqrtf(ss2 * (1.0f / DM) + 1e-6f);
#pragma unroll
            for (int i = 0; i < 4; ++i) {
                u32x2 w; w.x = cvt_pk_bf16(v[i][0] * sc * g[i][0], v[i][1] * sc * g[i][1]); w.y = cvt_pk_bf16(v[i][2] * sc * g[i][2], v[i][3] * sc * g[i][3]);
                *(u32x2*)(xn + (size_t)row * DM + (c.lane + 64 * i) * 4) = w;
                u32x2 w2; w2.x = cvt_pk_bf16(v2[i][0] * sc2 * g[i][0], v2[i][1] * sc2 * g[i][1]); w2.y = cvt_pk_bf16(v2[i][2] * sc2 * g[i][2], v2[i][3] * sc2 * g[i][3]);
                *(u32x2*)(xn + (size_t)row2 * DM + (c.lane + 64 * i) * 4) = w2;
            }
        }
    }
    {
        const float* w_in = c.in(I_WIN); const float* w1 = c.in(I_W1); const float* a1 = c.in(I_A1); const float* g1 = c.in(I_G1); const float* mu = c.in(I_MUWAG);
        auto src_cat = [=](int k, int n) -> float {
            if (n < N_IN_REAL) return w_in[(size_t)k * N_IN_REAL + n];
            if (n >= C_LEND) return 0.f;
            int cc = n - C_L1; const bool second = cc >= 256; cc &= 255;
            float w, m;
            if (cc < 64) { w = w1[k * 64 + cc]; m = mu[k]; }
            else if (cc < 128) { w = a1[k * 64 + cc - 64]; m = mu[DM + k]; }
            else { w = g1[k * 128 + cc - 128]; m = mu[2 * DM + k]; }
            return w * (second ? m : 1.0f - m);
        };
        const float* w_out = c.in(I_WOUT); const float* cw1 = c.in(I_CW1);
        for (int it = c.bid; it < 1408; it += c.G) {
            if (it < 896) { const int nt_ = it >> 4, kt = it & 15; tconv_tile(c, src_cat, c.wcat(), DM, kt * 64, nt_ * 64, nt_ * 64); }
            else if (it < 1152) { const int j = it - 896, nt_ = j >> 4, kt = j & 15; tconv_tile(c, [=](int k, int n) { return w_out[(size_t)k * DM + n]; }, c.woutt(), DM, kt * 64, nt_ * 64, nt_ * 64); }
            else { const int j = it - 1152, i = j >> 7, r = j & 127, nt_ = r >> 5, kt = r & 31; const float* s = cw1 + (size_t)i * 2048 * 256;
                tconv_tile(c, [=](int k, int n) { return s[(size_t)k * 256 + n]; }, c.cw1t() + (size_t)i * 256 * 2048, 2048, kt * 64, nt_ * 64, nt_ * 64); }
        }
    }
    {
        const int gt = c.bid * NTHREADS + c.tid, ngt = c.G * NTHREADS;
        float* rp = c.rope();
        for (int i = gt; i < SEQ * 32; i += ngt) { const int s = i >> 5, d = i & 31; const float inv = exp2f(-(float)d * (13.287712379549449f / 32.0f)); const float ang = (float)s * inv; rp[2 * i] = cosf(ang); rp[2 * i + 1] = sinf(ang); }
        { const float* wr = c.in(I_MWR); bf16_t* wt = c.wrt();
          for (int i = gt; i < NEXP * DM; i += ngt) { const int e = i >> 10, k = i & 1023; const float w = wr[k * NEXP + e]; const bf16_t hi = f2bf(w); wt[i] = hi; wt[NEXP * DM + i] = f2bf(w - bf2f(hi)); } }
        const float* w2 = c.in(I_W2); const float* a2 = c.in(I_A2); const float* g2 = c.in(I_G2); bf16_t* wl = c.wl2t();
        for (int i = gt; i < 1536 * 256; i += ngt) { const int n = i >> 8, k = i & 255; float v = 0.f;
            if (n < 512) { if (k < 64) v = w2[k * 512 + n]; }
            else if (n < 1024) { if (k >= 64 && k < 128) v = a2[(k - 64) * 512 + n - 512]; }
            else { if (k >= 128) v = g2[(k - 128) * 512 + n - 1024]; }
            wl[i] = f2bf(v); }
    }
    if (c.bid < 16) {
        LAS float* red = (LAS float*)c.lds;
        const int fo = c.bid * 32 + (c.tid & 31), ch = c.tid >> 5, i = fo >> 8, f = fo & 255;
        const float* pe = c.in(I_PE) + (size_t)i * 2048; const float* w = c.in(I_CW1) + (size_t)i * 2048 * 256;
        float s = 0.f;
        for (int ld = ch * 128; ld < ch * 128 + 128; ++ld) s += pe[ld] * w[(size_t)ld * 256 + f];
        red[c.tid] = s; __syncthreads();
        if (c.tid < 32) { float t = 0.f; for (int k = 0; k < 16; ++k) t += red[k * 32 + c.tid]; c.biasc()[fo] = t; }
        __syncthreads();
    }
}

DI void p2_prep(const Ctx& c) {
    const bf16_t* proj = c.proj();
    const int gt = c.bid * NTHREADS + c.tid, ngt = c.G * NTHREADS;
    {
        bf16_t* la = c.lact();
        for (int i = gt; i < T_TOK * 32; i += ngt) {
            const int t = i >> 5, cg8 = (i & 31) * 8;
            const u32x4 p1 = *(const u32x4*)(proj + (size_t)t * NPROJ + C_L1 + cg8);
            u32x4 p2 = (u32x4){0u, 0u, 0u, 0u};
            if ((t & (SEQ - 1)) != 0) p2 = *(const u32x4*)(proj + (size_t)(t - 1) * NPROJ + C_L2 + cg8);
            float z[8];
#pragma unroll
            for (int q = 0; q < 4; ++q) { z[2 * q] = bflo(p1[q]) + bflo(p2[q]); z[2 * q + 1] = bfhi(p1[q]) + bfhi(p2[q]); }
            if (cg8 < 64) {
#pragma unroll
                for (int q = 0; q < 8; ++q) z[q] = tanhf_(z[q]);
            } else if (cg8 >= 128) {
#pragma unroll
                for (int q = 0; q < 8; ++q) z[q] = sigmoidf_(z[q]);
            }
            u32x4 w; w.x = cvt_pk_bf16(z[0], z[1]); w.y = cvt_pk_bf16(z[2], z[3]); w.z = cvt_pk_bf16(z[4], z[5]); w.w = cvt_pk_bf16(z[6], z[7]);
            *(u32x4*)(la + (size_t)t * 256 + cg8) = w;
        }
    }
    {
        const float* kng = c.in(I_KNG); const float* rp = c.rope();
        for (int i = gt; i < T_TOK * 4 * 8; i += ngt) {
            const int j = i & 7, grp = i >> 3, kvh = grp & 1, which = (grp >> 1) & 1, t = grp >> 2, b = t >> 11, s = t & (SEQ - 1);
            const bf16_t* src = proj + (size_t)t * NPROJ + (which ? C_KW : C_KS) + kvh * 64;
            const u32x2 lo = *(const u32x2*)(src + 4 * j), hi = *(const u32x2*)(src + 32 + 4 * j);
            float vl[4] = {bflo(lo.x), bfhi(lo.x), bflo(lo.y), bfhi(lo.y)}, vh[4] = {bflo(hi.x), bfhi(hi.x), bflo(hi.y), bfhi(hi.y)};
            float ss = 0.f;
#pragma unroll
            for (int q = 0; q < 4; ++q) ss += vl[q] * vl[q] + vh[q] * vh[q];
            ss += __shfl_xor(ss, 1); ss += __shfl_xor(ss, 2); ss += __shfl_xor(ss, 4);
            const float rs = rsqrtf(ss * (1.0f / 64.0f) + 1e-6f);
            const float* g = kng + (1 + which) * 64;
            float ol[4], oh[4];
#pragma unroll
            for (int q = 0; q < 4; ++q) {
                const float a = vl[q] * rs * g[4 * j + q], bb = vh[q] * rs * g[32 + 4 * j + q];
                const float cs = rp[(s * 32 + 4 * j + q) * 2], sn = rp[(s * 32 + 4 * j + q) * 2 + 1];
                ol[q] = a * cs - bb * sn; oh[q] = bb * cs + a * sn;
            }
            bf16_t* dst = (which ? c.kwr() : c.ksr()) + ((size_t)(b * 2 + kvh) * SEQ + s) * 64;
            u32x2 wl, wh; wl.x = cvt_pk_bf16(ol[0], ol[1]); wl.y = cvt_pk_bf16(ol[2], ol[3]); wh.x = cvt_pk_bf16(oh[0], oh[1]); wh.y = cvt_pk_bf16(oh[2], oh[3]);
            *(u32x2*)(dst + 4 * j) = wl; *(u32x2*)(dst + 32 + 4 * j) = wh;
        }
    }
    for (int it = c.bid; it < 4096; it += c.G) {
        const int st = it & 31, kvh = (it >> 5) & 1, b = (it >> 6) & 31, which = it >> 11;
        const bf16_t* src = proj + (size_t)b * SEQ * NPROJ + (which ? C_VW : C_VS) + kvh * 64;
        bf16_t* dst = (which ? c.vwt() : c.vst()) + (size_t)(b * 2 + kvh) * 64 * SEQ;
        tconv_tile(c, [=](int k, int n) { return bf2f(src[(size_t)k * NPROJ + n]); }, dst, SEQ, st * 64, 0, 0);
    }
}

DI void p3_cmp_finish(const Ctx& c) {
    const int gw = c.bid * 8 + c.wave, nw = c.G * 8;
    const float* kng0 = c.in(I_KNG);
    for (int r = gw; r < 2 * 8192; r += nw) {
        const int i = r >> 13, m = r & 8191;
        const bf16_t* hrow = c.hid() + ((size_t)i * 8192 + m) * 256; const float* w2 = c.in(I_CW2) + (size_t)i * 256 * 64;
        float acc = 0.f;
#pragma unroll 4
        for (int f8 = 0; f8 < 32; ++f8) {
            const u32x4 hv = *(const u32x4*)(hrow + f8 * 8);
#pragma unroll
            for (int q = 0; q < 4; ++q) { acc += bflo(hv[q]) * w2[(f8 * 8 + 2 * q) * 64 + c.lane]; acc += bfhi(hv[q]) * w2[(f8 * 8 + 2 * q + 1) * 64 + c.lane]; }
        }
        if (i == 0) {
            const float ss = wave_sum(acc * acc);
            const float v = acc * rsqrtf(ss * (1.0f / 64.0f) + 1e-6f) * kng0[c.lane];
            c.kcmp()[(size_t)m * 64 + c.lane] = f2bf(v);
        } else {
            const int bk = m >> 7, n = m & 127;
            c.vcmpt()[((size_t)bk * 64 + c.lane) * 128 + n] = f2bf(acc);
        }
    }
}

DI f32x16 mfma32(const bf16x8& a, const bf16x8& b, const f32x16& cacc) { return __builtin_amdgcn_mfma_f32_32x32x16_bf16(a, b, cacc, 0, 0, 0); }
DI int crow(int reg, int hh) { return (reg & 3) + 8 * (reg >> 2) + 4 * hh; }
DI bf16x8 pack8(const f32x16& x, int s) {
    u32x4 p; p.x = cvt_pk_bf16(x[8 * s], x[8 * s + 1]); p.y = cvt_pk_bf16(x[8 * s + 2], x[8 * s + 3]); p.z = cvt_pk_bf16(x[8 * s + 4], x[8 * s + 5]); p.w = cvt_pk_bf16(x[8 * s + 6], x[8 * s + 7]);
    return __builtin_bit_cast(bf16x8, p);
}
DI f32x16 zero16() { f32x16 z; for (int i = 0; i < 16; ++i) z[i] = 0.f; return z; }

constexpr int SCAN_BUF_FLOATS = 8 * 2048 + 64;
struct ScanPrm { float mu_r[8], mu_k[8], mu_v[8], kk[8], ka[8], rk[8]; };
DI void scan_prepare(const Ctx& c, LAS float* L, int b, int h, int chunk, int ptid, const ScanPrm& P) {
    const int stp = ptid >> 3, c8 = (ptid & 7) * 8, hc = h * 64 + c8, s = chunk * 32 + stp; const size_t t = (size_t)b * SEQ + s;
    const bf16_t* cur = c.proj() + t * NPROJ + hc;
    const u32x4 rc = *(const u32x4*)(cur + C_R), kc = *(const u32x4*)(cur + C_K), vc = *(const u32x4*)(cur + C_V);
    u32x4 rq = (u32x4){0u, 0u, 0u, 0u}, kq = rq, vq = rq;
    if (s > 0) { rq = *(const u32x4*)(cur - NPROJ + C_R); kq = *(const u32x4*)(cur - NPROJ + C_K); vq = *(const u32x4*)(cur - NPROJ + C_V); }
    const bf16_t* lo = c.lout() + t * 1536 + hc;
    const u32x4 wp = *(const u32x4*)lo, ap = *(const u32x4*)(lo + 512), gp = *(const u32x4*)(lo + 1024);
    float r[8], k[8], v[8], w[8], a[8], g[8], kkv[8];
#define UNP8(dst, src) { _Pragma("unroll") for (int e_ = 0; e_ < 4; ++e_) { dst[2 * e_] = bflo(src[e_]); dst[2 * e_ + 1] = bfhi(src[e_]); } }
    { float t0[8], t1[8];
      UNP8(t0, rc); UNP8(t1, rq);
#pragma unroll
      for (int q = 0; q < 8; ++q) r[q] = t0[q] + P.mu_r[q] * (t1[q] - t0[q]);
      UNP8(t0, kc); UNP8(t1, kq);
#pragma unroll
      for (int q = 0; q < 8; ++q) k[q] = t0[q] + P.mu_k[q] * (t1[q] - t0[q]);
      UNP8(t0, vc); UNP8(t1, vq);
#pragma unroll
      for (int q = 0; q < 8; ++q) v[q] = t0[q] + P.mu_v[q] * (t1[q] - t0[q]); }
    UNP8(w, wp); UNP8(a, ap); UNP8(g, gp);
#undef UNP8
    float ss = 0.f;
#pragma unroll
    for (int q = 0; q < 8; ++q) { w[q] = __expf(-0.6065306597126334f * sigmoidf_(w[q])); a[q] = sigmoidf_(a[q]); kkv[q] = k[q] * P.kk[q]; ss += kkv[q] * kkv[q]; }
    ss = red8(ss);
    const float inv = 1.0f / fmaxf(sqrtf(ss), 1e-12f);
    float bon = 0.f; const int o = stp * 64 + c8;
#pragma unroll
    for (int hq = 0; hq < 2; ++hq) {
        f32x4 av, bv, kv, wv, rv, vv, gv;
#pragma unroll
        for (int q4 = 0; q4 < 4; ++q4) { const int q = hq * 4 + q4;
            const float kk = kkv[q] * inv, km = k[q] * (1.0f + (a[q] - 1.0f) * P.ka[q]);
            av[q4] = -kk; bv[q4] = kk * a[q]; kv[q4] = km; wv[q4] = w[q]; rv[q4] = r[q]; vv[q4] = v[q]; gv[q4] = g[q];
            bon += r[q] * km * P.rk[q]; }
        const int oo = o + hq * 4;
        *(LAS f32x4*)(L + oo) = av; *(LAS f32x4*)(L + 2048 + oo) = bv; *(LAS f32x4*)(L + 4096 + oo) = kv; *(LAS f32x4*)(L + 6144 + oo) = wv; *(LAS f32x4*)(L + 8192 + oo) = rv;
        *(LAS f32x4*)(L + 10240 + oo) = vv; *(LAS f32x4*)(L + 12288 + oo) = gv;
    }
    bon = red8(bon);
    if ((ptid & 7) == 0) L[16384 + stp] = bon;
}
DI void scan_finish(const Ctx& c, const LAS float* L, int b, int h, int chunk, int ptid, const float (&lng)[8], const float (&lnb)[8]) {
    const int stp = ptid >> 3, c8 = (ptid & 7) * 8, hc = h * 64 + c8, o = stp * 64 + c8; const size_t t = (size_t)b * SEQ + chunk * 32 + stp;
    float y[8], vv[8], gv[8];
#pragma unroll
    for (int hq = 0; hq < 2; ++hq) { const f32x4 a = *(const LAS f32x4*)(L + 14336 + o + hq * 4), bq = *(const LAS f32x4*)(L + 10240 + o + hq * 4), cq = *(const LAS f32x4*)(L + 12288 + o + hq * 4);
#pragma unroll
        for (int q = 0; q < 4; ++q) { y[hq * 4 + q] = a[q]; vv[hq * 4 + q] = bq[q]; gv[hq * 4 + q] = cq[q]; } }
    float sm = 0.f;
#pragma unroll
    for (int q = 0; q < 8; ++q) sm += y[q];
    sm = red8(sm);
    const float mean = sm * (1.0f / 64.0f);
    float vr = 0.f;
#pragma unroll
    for (int q = 0; q < 8; ++q) { const float d = y[q] - mean; vr += d * d; }
    vr = red8(vr);
    const float rstd = rsqrtf(vr * (1.0f / 64.0f) + 64e-5f), bon = (ABL & 64) ? 0.f : L[16384 + stp];
    float ov[8];
#pragma unroll
    for (int q = 0; q < 8; ++q) ov[q] = ((y[q] - mean) * rstd * lng[q] + lnb[q] + bon * vv[q]) * gv[q];
    u32x4 wv; wv.x = cvt_pk_bf16(ov[0], ov[1]); wv.y = cvt_pk_bf16(ov[2], ov[3]); wv.z = cvt_pk_bf16(ov[4], ov[5]); wv.w = cvt_pk_bf16(ov[6], ov[7]);
    if (ABL & 1) wv = (u32x4){0u, 0u, 0u, 0u};
    *(u32x4*)(c.xn() + t * DM + hc) = wv;
}
struct ScanOps { f32x4 a0, a1, b0, b1, k0, k1, w0, w1, r0, r1; f32x2 vv; };
DI void scan_load_ops(ScanOps& o, const LAS float* L, int st, int j8, int rp) {
    const int q = st * 64 + j8;
    o.a0 = *(const LAS f32x4*)(L + q); o.a1 = *(const LAS f32x4*)(L + q + 4); o.b0 = *(const LAS f32x4*)(L + 2048 + q); o.b1 = *(const LAS f32x4*)(L + 2048 + q + 4);
    o.k0 = *(const LAS f32x4*)(L + 4096 + q); o.k1 = *(const LAS f32x4*)(L + 4096 + q + 4); o.w0 = *(const LAS f32x4*)(L + 6144 + q); o.w1 = *(const LAS f32x4*)(L + 6144 + q + 4);
    o.r0 = *(const LAS f32x4*)(L + 8192 + q); o.r1 = *(const LAS f32x4*)(L + 8192 + q + 4); o.vv = *(const LAS f32x2*)(L + 10240 + st * 64 + 2 * rp);
}
DI void scan_chain(const Ctx& c, int chain) {
    const int b = chain >> 3, h = chain & 7, tid = c.tid;
    LAS float* LB0 = (LAS float*)c.lds; LAS float* LB1 = LB0 + SCAN_BUF_FLOATS;
    const bool prep = tid >= 256; const int ptid = tid & 255;
    ScanPrm P; float lng[8], lnb[8];
    { const int hc = h * 64 + (ptid & 7) * 8;
#pragma unroll
      for (int q = 0; q < 8; ++q) {
        P.mu_r[q] = c.in(I_MURKV)[hc + q]; P.mu_k[q] = c.in(I_MURKV)[512 + hc + q]; P.mu_v[q] = c.in(I_MURKV)[1024 + hc + q];
        P.kk[q] = c.in(I_KK)[hc + q]; P.ka[q] = c.in(I_KA)[hc + q]; P.rk[q] = c.in(I_RK)[hc + q]; lng[q] = c.in(I_LNXG)[hc + q]; lnb[q] = c.in(I_LNXB)[hc + q]; } }
    const int rp = tid >> 3, j8 = (tid & 7) * 8;
    f32x2 S0[4], S1[4];
#pragma unroll
    for (int q = 0; q < 4; ++q) { S0[q] = (f32x2){0.f, 0.f}; S1[q] = (f32x2){0.f, 0.f}; }
    if (prep) scan_prepare(c, LB0, b, h, 0, ptid, P);
    __syncthreads();
#pragma unroll 1
    for (int chunk = 0; chunk < SEQ / 32; ++chunk) {
        LAS float* Lc = (chunk & 1) ? LB1 : LB0; LAS float* Lo = (chunk & 1) ? LB0 : LB1;
        if (prep) {
            if (chunk >= 1) scan_finish(c, Lo, b, h, chunk - 1, ptid, lng, lnb);
            if (chunk + 1 < SEQ / 32) scan_prepare(c, Lo, b, h, chunk + 1, ptid, P);
        } else {
            ScanOps cur, nxt; scan_load_ops(cur, Lc, 0, j8, rp);
#pragma unroll 2
            for (int st = 0; st < 32; ++st) {
                scan_load_ops(nxt, Lc, st < 31 ? st + 1 : 31, j8, rp);
                const f32x2 A[4] = {{cur.a0[0], cur.a0[1]}, {cur.a0[2], cur.a0[3]}, {cur.a1[0], cur.a1[1]}, {cur.a1[2], cur.a1[3]}};
                const f32x2 Bv[4] = {{cur.b0[0], cur.b0[1]}, {cur.b0[2], cur.b0[3]}, {cur.b1[0], cur.b1[1]}, {cur.b1[2], cur.b1[3]}};
                const f32x2 Kv[4] = {{cur.k0[0], cur.k0[1]}, {cur.k0[2], cur.k0[3]}, {cur.k1[0], cur.k1[1]}, {cur.k1[2], cur.k1[3]}};
                const f32x2 Wv[4] = {{cur.w0[0], cur.w0[1]}, {cur.w0[2], cur.w0[3]}, {cur.w1[0], cur.w1[1]}, {cur.w1[2], cur.w1[3]}};
                const f32x2 Rv[4] = {{cur.r0[0], cur.r0[1]}, {cur.r0[2], cur.r0[3]}, {cur.r1[0], cur.r1[1]}, {cur.r1[2], cur.r1[3]}};
                f32x2 p0 = S0[0] * A[0], p1 = S1[0] * A[0];
#pragma unroll
                for (int q = 1; q < 4; ++q) { p0 = S0[q] * A[q] + p0; p1 = S1[q] * A[q] + p1; }
                const float sa0 = red8(p0.x + p0.y), sa1 = red8(p1.x + p1.y);
                const f32x2 sa0v = {sa0, sa0}, sa1v = {sa1, sa1}, v0v = {cur.vv.x, cur.vv.x}, v1v = {cur.vv.y, cur.vv.y};
                f32x2 y0v = {0.f, 0.f}, y1v = {0.f, 0.f};
#pragma unroll
                for (int q = 0; q < 4; ++q) {
                    S0[q] = S0[q] * Wv[q] + (sa0v * Bv[q] + v0v * Kv[q]);
                    S1[q] = S1[q] * Wv[q] + (sa1v * Bv[q] + v1v * Kv[q]);
                    y0v = S0[q] * Rv[q] + y0v; y1v = S1[q] * Rv[q] + y1v;
                }
                const float y0 = red8(y0v.x + y0v.y), y1 = red8(y1v.x + y1v.y);
                if ((tid & 7) == 0) *(LAS f32x2*)(Lc + 14336 + st * 64 + 2 * rp) = (f32x2){y0, y1};
                cur = nxt;
            }
        }
        __syncthreads();
    }
    if (prep) scan_finish(c, LB1, b, h, SEQ / 32 - 1, ptid, lng, lnb);
    __syncthreads();
}

constexpr int S2_LW = 0, S2_LP = 8192, S2_VV = 16384, S2_GV = 24576, S2_YV = 32768, S2_CL = 40960, S2_MAB = 49152, S2_BON = 53248, S2_PL = 53376,
              S2_AT = 53760, S2_RT = 57856, S2_BT = 61952, S2_KT = 66048, S2_BK = 70144, S2_KK = 74240, S2_VT = 78336, S2_UT = 82432, S2_MKB = 86528, S2_MBR = 88576, S2_MKR = 90624;
DI bf16x8 lds_frag16(const LAS unsigned char* p) { return *(const LAS bf16x8*)p; }
DI bf16x8 lds_frag8x2(const LAS unsigned char* p) { const u32x2 lo = *(const LAS u32x2*)p, hi = *(const LAS u32x2*)(p + 16); return __builtin_bit_cast(bf16x8, (u32x4){lo.x, lo.y, hi.x, hi.y}); }
DI void scan_chain2(const Ctx& c, int chain) {
    const int b = chain >> 3, h = chain & 7, tid = c.tid, lane = c.lane, w = c.wave;
    LAS unsigned char* L = c.lds;
    LAS float* LW = (LAS float*)(L + S2_LW); LAS float* LP = (LAS float*)(L + S2_LP); LAS float* VV = (LAS float*)(L + S2_VV); LAS float* GV = (LAS float*)(L + S2_GV);
    LAS float* YV = (LAS float*)(L + S2_YV); LAS float* CL = (LAS float*)(L + S2_CL); LAS float* MAB = (LAS float*)(L + S2_MAB); LAS float* BON = (LAS float*)(L + S2_BON); LAS float* PL = (LAS float*)(L + S2_PL);
    const int stp = tid >> 4, c4 = (tid & 15) * 4, hc = h * 64 + c4;
    float mu_r[4], mu_k[4], mu_v[4], kk_[4], ka_[4], rk_[4], lng[4], lnb[4];
#pragma unroll
    for (int q = 0; q < 4; ++q) {
        mu_r[q] = c.in(I_MURKV)[hc + q]; mu_k[q] = c.in(I_MURKV)[512 + hc + q]; mu_v[q] = c.in(I_MURKV)[1024 + hc + q];
        kk_[q] = c.in(I_KK)[hc + q]; ka_[q] = c.in(I_KA)[hc + q]; rk_[q] = c.in(I_RK)[hc + q]; lng[q] = c.in(I_LNXG)[hc + q]; lnb[q] = c.in(I_LNXB)[hc + q];
    }
    const int n = lane & 31, hh = lane >> 5;
    f32x16 T0 = zero16(), T1 = zero16();
    const bf16_t* proj = c.proj(); const bf16_t* lout = c.lout(); bf16_t* ymix = c.xn();
#pragma unroll 1
    for (int chunk = 0; chunk < SEQ / 32; ++chunk) {
        const int s = chunk * 32 + stp; const size_t t = (size_t)b * SEQ + s;
        float r[4], km[4], av[4], bv[4];
        {
            const bf16_t* cur = proj + t * NPROJ + hc;
            const u32x2 rc = *(const u32x2*)(cur + C_R), kc = *(const u32x2*)(cur + C_K), vc = *(const u32x2*)(cur + C_V);
            u32x2 rq = (u32x2){0u, 0u}, kq = rq, vq = rq;
            if (s > 0) { rq = *(const u32x2*)(cur - NPROJ + C_R); kq = *(const u32x2*)(cur - NPROJ + C_K); vq = *(const u32x2*)(cur - NPROJ + C_V); }
            const bf16_t* lo = lout + t * 1536 + hc;
            const u32x2 wp = *(const u32x2*)lo, ap = *(const u32x2*)(lo + 512), gp = *(const u32x2*)(lo + 1024);
            float k[4], v[4], wl[4], a[4], g[4], kkv[4];
#define UNP(dst, src) dst[0] = bflo(src.x); dst[1] = bfhi(src.x); dst[2] = bflo(src.y); dst[3] = bfhi(src.y)
            float t0[4], t1[4];
            UNP(t0, rc); UNP(t1, rq);
#pragma unroll
            for (int q = 0; q < 4; ++q) r[q] = t0[q] + mu_r[q] * (t1[q] - t0[q]);
            UNP(t0, kc); UNP(t1, kq);
#pragma unroll
            for (int q = 0; q < 4; ++q) k[q] = t0[q] + mu_k[q] * (t1[q] - t0[q]);
            UNP(t0, vc); UNP(t1, vq);
#pragma unroll
            for (int q = 0; q < 4; ++q) v[q] = t0[q] + mu_v[q] * (t1[q] - t0[q]);
            UNP(wl, wp); UNP(a, ap); UNP(g, gp);
#undef UNP
            float ss = 0.f;
#pragma unroll
            for (int q = 0; q < 4; ++q) { wl[q] = -0.6065306597126334f * sigmoidf_(wl[q]); a[q] = sigmoidf_(a[q]); kkv[q] = k[q] * kk_[q]; ss += kkv[q] * kkv[q]; }
            ss = red16(ss);
            const float inv = 1.0f / fmaxf(sqrtf(ss), 1e-12f);
            float bon = 0.f; f32x4 vv, gv, lw4;
#pragma unroll
            for (int q = 0; q < 4; ++q) { const float kk = kkv[q] * inv; km[q] = k[q] * (1.0f + (a[q] - 1.0f) * ka_[q]); av[q] = -kk; bv[q] = kk * a[q]; vv[q] = v[q]; gv[q] = g[q]; lw4[q] = wl[q]; bon += r[q] * km[q] * rk_[q]; }
            bon = red16(bon);
            const int o = stp * 64 + c4;
            *(LAS f32x4*)(LW + o) = lw4; *(LAS f32x4*)(VV + o) = vv; *(LAS f32x4*)(GV + o) = gv;
            if ((tid & 15) == 0) BON[stp] = bon;
#pragma unroll
            for (int q = 0; q < 4; ++q) *(LAS bf16_t*)(L + S2_VT + ((c4 + q) * 32 + stp) * 2) = f2bf(v[q]);
        }
        __syncthreads();
        {
            const int j = tid >> 3, sg = tid & 7;
            float c0 = LW[(4 * sg) * 64 + j], c1 = c0 + LW[(4 * sg + 1) * 64 + j], c2 = c1 + LW[(4 * sg + 2) * 64 + j], c3 = c2 + LW[(4 * sg + 3) * 64 + j];
            float run = c3;
#pragma unroll
            for (int d = 1; d < 8; d <<= 1) { const float up = __shfl_up(run, d, 8); if (sg >= d) run += up; }
            const float excl = run - c3;
            LP[(4 * sg) * 64 + j] = excl + c0; LP[(4 * sg + 1) * 64 + j] = excl + c1; LP[(4 * sg + 2) * 64 + j] = excl + c2; LP[(4 * sg + 3) * 64 + j] = excl + c3;
        }
        __syncthreads();
        {
            const f32x4 lp = *(const LAS f32x4*)(LP + stp * 64 + c4);
            f32x4 lpm = (f32x4){0.f, 0.f, 0.f, 0.f}; if (stp > 0) lpm = *(const LAS f32x4*)(LP + (stp - 1) * 64 + c4);
            float at[4], rt[4], bt[4], kt[4];
#pragma unroll
            for (int q = 0; q < 4; ++q) { const float P = __expf(lp[q]), Pm = __expf(lpm[q]), iP = __expf(-lp[q]); at[q] = Pm * av[q]; rt[q] = P * r[q]; bt[q] = bv[q] * iP; kt[q] = km[q] * iP; if (stp == 31) PL[c4 + q] = P; }
            const int ob = (stp * 64 + c4) * 2;
            { u32x2 x; x.x = cvt_pk_bf16(at[0], at[1]); x.y = cvt_pk_bf16(at[2], at[3]); *(LAS u32x2*)(L + S2_AT + ob) = x; }
            { u32x2 x; x.x = cvt_pk_bf16(rt[0], rt[1]); x.y = cvt_pk_bf16(rt[2], rt[3]); *(LAS u32x2*)(L + S2_RT + ob) = x; }
            { u32x2 x; x.x = cvt_pk_bf16(bt[0], bt[1]); x.y = cvt_pk_bf16(bt[2], bt[3]); *(LAS u32x2*)(L + S2_BT + ob) = x; }
            { u32x2 x; x.x = cvt_pk_bf16(kt[0], kt[1]); x.y = cvt_pk_bf16(kt[2], kt[3]); *(LAS u32x2*)(L + S2_KT + ob) = x; }
#pragma unroll
            for (int q = 0; q < 4; ++q) { *(LAS bf16_t*)(L + S2_BK + ((c4 + q) * 32 + stp) * 2) = f2bf(bt[q]); *(LAS bf16_t*)(L + S2_KK + ((c4 + q) * 32 + stp) * 2) = f2bf(kt[q]); }
        }
        __syncthreads();
        if (w < 4) {
            const LAS unsigned char* Xa = L + ((w & 2) ? S2_RT : S2_AT) + n * 128 + 16 * hh;
            const LAS unsigned char* Xb = L + ((w & 1) ? S2_KT : S2_BT) + n * 128 + 16 * hh;
            f32x16 m = zero16();
#pragma unroll
            for (int st = 0; st < 4; ++st) m = mfma32(lds_frag16(Xa + 32 * st), lds_frag16(Xb + 32 * st), m);
            const bool incl = (w & 2) != 0;
#pragma unroll
            for (int r_ = 0; r_ < 16; ++r_) { const int tt = crow(r_, hh); const bool keep = incl ? (n <= tt) : (n < tt); const float val = keep ? m[r_] : 0.f;
                if (w == 0) MAB[tt * 32 + n] = val; else *(LAS bf16_t*)(L + (w == 1 ? S2_MKB : (w == 2 ? S2_MBR : S2_MKR)) + (tt * 32 + n) * 2) = f2bf(val); }
        }
        __syncthreads();
        f32x16 yacc = zero16();
        if (w < 2) {
            f32x16 cacc = zero16();
            const LAS unsigned char* vt = L + S2_VT + (32 * w + n) * 64 + 16 * hh;
#pragma unroll
            for (int st = 0; st < 2; ++st) { const bf16x8 vb_ = lds_frag16(vt + 32 * st);
                cacc = mfma32(lds_frag16(L + S2_MKB + n * 64 + 16 * hh + 32 * st), vb_, cacc); yacc = mfma32(lds_frag16(L + S2_MKR + n * 64 + 16 * hh + 32 * st), vb_, yacc); }
#pragma unroll
            for (int jb = 0; jb < 2; ++jb)
#pragma unroll
                for (int st = 0; st < 2; ++st) {
                    const bf16x8 tb = pack8(jb ? T1 : T0, st);
                    const int ko = (32 * jb + 16 * st + 4 * hh) * 2;
                    cacc = mfma32(lds_frag8x2(L + S2_AT + n * 128 + ko), tb, cacc); yacc = mfma32(lds_frag8x2(L + S2_RT + n * 128 + ko), tb, yacc);
                }
#pragma unroll
            for (int r_ = 0; r_ < 16; ++r_) CL[crow(r_, hh) * 64 + 32 * w + n] = cacc[r_];
        }
        __syncthreads();
        if (tid < 256) {
            const int i = tid >> 2, l = tid & 3;
            float u[8];
#pragma unroll
            for (int e = 0; e < 8; ++e) u[e] = 0.f;
#pragma unroll
            for (int tt = 0; tt < 32; ++tt) {
                float acc_ = 0.f;
                if (tt > 0) {
                    const f32x4 m0 = *(const LAS f32x4*)(MAB + tt * 32 + 8 * l), m1 = *(const LAS f32x4*)(MAB + tt * 32 + 8 * l + 4);
#pragma unroll
                    for (int e = 0; e < 4; ++e) acc_ += u[e] * m0[e] + u[4 + e] * m1[e];
                    acc_ += dppmov<0xB1>(acc_); acc_ += dppmov<0x4E>(acc_);
                }
                const float ut = CL[tt * 64 + i] + acc_;
                if (l == (tt >> 3)) u[tt & 7] = ut;
            }
            u32x4 x; x.x = cvt_pk_bf16(u[0], u[1]); x.y = cvt_pk_bf16(u[2], u[3]); x.z = cvt_pk_bf16(u[4], u[5]); x.w = cvt_pk_bf16(u[6], u[7]);
            *(LAS u32x4*)(L + S2_UT + (i * 32 + 8 * l) * 2) = x;
        }
        __syncthreads();
        if (w < 2) {
            const LAS unsigned char* ut = L + S2_UT + (32 * w + n) * 64 + 16 * hh;
            const LAS unsigned char* vt = L + S2_VT + (32 * w + n) * 64 + 16 * hh;
#pragma unroll
            for (int st = 0; st < 2; ++st) {
                const bf16x8 ub = lds_frag16(ut + 32 * st), vb_ = lds_frag16(vt + 32 * st);
                yacc = mfma32(lds_frag16(L + S2_MBR + n * 64 + 16 * hh + 32 * st), ub, yacc);
                T0 = mfma32(lds_frag16(L + S2_BK + n * 64 + 16 * hh + 32 * st), ub, T0); T0 = mfma32(lds_frag16(L + S2_KK + n * 64 + 16 * hh + 32 * st), vb_, T0);
                T1 = mfma32(lds_frag16(L + S2_BK + (32 + n) * 64 + 16 * hh + 32 * st), ub, T1); T1 = mfma32(lds_frag16(L + S2_KK + (32 + n) * 64 + 16 * hh + 32 * st), vb_, T1);
            }
#pragma unroll
            for (int r_ = 0; r_ < 16; ++r_) { const int kr = crow(r_, hh); T0[r_] *= PL[kr]; T1[r_] *= PL[32 + kr]; YV[kr * 64 + 32 * w + n] = yacc[r_]; }
        }
        __syncthreads();
        {
            const int o = stp * 64 + c4;
            const f32x4 y = *(LAS f32x4*)(YV + o), vv = *(LAS f32x4*)(VV + o), gv = *(LAS f32x4*)(GV + o);
            float sm = y[0] + y[1] + y[2] + y[3]; sm = red16(sm);
            const float mean = sm * (1.0f / 64.0f);
            float vr = 0.f;
#pragma unroll
            for (int q = 0; q < 4; ++q) { const float d = y[q] - mean; vr += d * d; }
            vr = red16(vr);
            const float rstd = rsqrtf(vr * (1.0f / 64.0f) + 64e-5f), bon = BON[stp];
            float ov[4];
#pragma unroll
            for (int q = 0; q < 4; ++q) ov[q] = ((y[q] - mean) * rstd * lng[q] + lnb[q] + bon * vv[q]) * gv[q];
            u32x2 wv; wv.x = cvt_pk_bf16(ov[0], ov[1]); wv.y = cvt_pk_bf16(ov[2], ov[3]);
            *(u32x2*)(ymix + t * DM + hc) = wv;
        }
        __syncthreads();
    }
}

constexpr int Q_AT = 0, Q_RT = 4096, Q_BT = 8192, Q_KT = 12288, Q_BK = 16384, Q_KK = 20480, Q_VT = 24576, Q_MAB = 28672, Q_MKB = 32768, Q_MBR = 34816, Q_MKR = 36864, Q_PL = 38912, Q_BON = 39168,
              Q_VV = 39424, Q_GV = 47616, Q_SET = 55808, Q_LP = 2 * Q_SET, Q_YV = Q_LP + 8192, Q_CL = Q_YV + 8192, Q_UT = Q_CL + 8192, Q_TT = Q_UT + 4096, Q_PRM = Q_TT + 16384;
struct Scan3Prm { float mu_r[8], mu_k[8], mu_v[8], kk[8], ka[8], rk[8]; };
struct Scan3Raw { u32x4 rc, kc, vc, rq, kq, vq, wp, ap, gp; };
DI void scan3_load(const Ctx& c, Scan3Raw& R, int b, int h, int chunk, int ptid) {
    const int stp = ptid >> 3, c8 = (ptid & 7) * 8, hc = h * 64 + c8, s = chunk * 32 + stp; const size_t t = (size_t)b * SEQ + s;
    const bf16_t* cur = c.proj() + t * NPROJ + hc;
    R.rc = *(const u32x4*)(cur + C_R); R.kc = *(const u32x4*)(cur + C_K); R.vc = *(const u32x4*)(cur + C_V);
    R.rq = (u32x4){0u, 0u, 0u, 0u}; R.kq = R.rq; R.vq = R.rq;
    if (s > 0) { R.rq = *(const u32x4*)(cur - NPROJ + C_R); R.kq = *(const u32x4*)(cur - NPROJ + C_K); R.vq = *(const u32x4*)(cur - NPROJ + C_V); }
    const bf16_t* lo = c.lout() + t * 1536 + hc;
    R.wp = *(const u32x4*)lo; R.ap = *(const u32x4*)(lo + 512); R.gp = *(const u32x4*)(lo + 1024);
}
DI void scan3_s1(const Ctx& c, int h, LAS unsigned char* Q, LAS float* LP, const Scan3Raw& R, int ptid, float (&r)[8], float (&km)[8], float (&av)[8], float (&bv)[8]) {
    const int stp = ptid >> 3, c8 = (ptid & 7) * 8;
    Scan3Prm P;
    { const LAS float* pr = (const LAS float*)(c.lds + Q_PRM) + c8;
#pragma unroll
      for (int q = 0; q < 8; ++q) { P.mu_r[q] = pr[q]; P.mu_k[q] = pr[64 + q]; P.mu_v[q] = pr[128 + q]; P.kk[q] = pr[192 + q]; P.ka[q] = pr[256 + q]; P.rk[q] = pr[320 + q]; } }
    float k[8], v[8], wl[8], a[8], g[8], kkv[8];
#define UNP8(dst, src) { _Pragma("unroll") for (int e_ = 0; e_ < 4; ++e_) { dst[2 * e_] = bflo(src[e_]); dst[2 * e_ + 1] = bfhi(src[e_]); } }
    { float t0[8], t1[8];
      UNP8(t0, R.rc); UNP8(t1, R.rq);
#pragma unroll
      for (int q = 0; q < 8; ++q) r[q] = t0[q] + P.mu_r[q] * (t1[q] - t0[q]);
      UNP8(t0, R.kc); UNP8(t1, R.kq);
#pragma unroll
      for (int q = 0; q < 8; ++q) k[q] = t0[q] + P.mu_k[q] * (t1[q] - t0[q]);
      UNP8(t0, R.vc); UNP8(t1, R.vq);
#pragma unroll
      for (int q = 0; q < 8; ++q) v[q] = t0[q] + P.mu_v[q] * (t1[q] - t0[q]); }
    UNP8(wl, R.wp); UNP8(a, R.ap); UNP8(g, R.gp);
#undef UNP8
    float ss = 0.f;
#pragma unroll
    for (int q = 0; q < 8; ++q) { wl[q] = -0.6065306597126334f * sigmoidf_(wl[q]); a[q] = sigmoidf_(a[q]); kkv[q] = k[q] * P.kk[q]; ss += kkv[q] * kkv[q]; }
    ss = red8(ss);
    const float inv = 1.0f / fmaxf(sqrtf(ss), 1e-12f);
    float bon = 0.f;
#pragma unroll
    for (int q = 0; q < 8; ++q) { const float kk = kkv[q] * inv; km[q] = k[q] * (1.0f + (a[q] - 1.0f) * P.ka[q]); av[q] = -kk; bv[q] = kk * a[q]; bon += r[q] * km[q] * P.rk[q]; }
    bon = red8(bon);
    const int o = stp * 64 + c8;
    *(LAS f32x4*)(LP + o) = (f32x4){wl[0], wl[1], wl[2], wl[3]}; *(LAS f32x4*)(LP + o + 4) = (f32x4){wl[4], wl[5], wl[6], wl[7]};
    LAS float* VV = (LAS float*)(Q + Q_VV); LAS float* GV = (LAS float*)(Q + Q_GV);
    *(LAS f32x4*)(VV + o) = (f32x4){v[0], v[1], v[2], v[3]}; *(LAS f32x4*)(VV + o + 4) = (f32x4){v[4], v[5], v[6], v[7]};
    *(LAS f32x4*)(GV + o) = (f32x4){g[0], g[1], g[2], g[3]}; *(LAS f32x4*)(GV + o + 4) = (f32x4){g[4], g[5], g[6], g[7]};
    if ((ptid & 7) == 0) ((LAS float*)(Q + Q_BON))[stp] = bon;
#pragma unroll
    for (int q = 0; q < 8; ++q) *(LAS bf16_t*)(Q + Q_VT + ((c8 + q) * 32 + stp) * 2) = f2bf(v[q]);
}
DI void scan3_s2(LAS float* LP, int ptid) {
    const int j = ptid >> 2, sg = ptid & 3;
    float cv[8]; float run = 0.f;
#pragma unroll
    for (int e = 0; e < 8; ++e) { run += LP[(8 * sg + e) * 64 + j]; cv[e] = run; }
    float tot = run;
#pragma unroll
    for (int d = 1; d < 4; d <<= 1) { const float up = __shfl_up(tot, d, 4); if (sg >= d) tot += up; }
    const float excl = tot - run;
#pragma unroll
    for (int e = 0; e < 8; ++e) LP[(8 * sg + e) * 64 + j] = excl + cv[e];
}
DI void scan3_s3(LAS unsigned char* Q, const LAS float* LP, int ptid, const float (&r)[8], const float (&km)[8], const float (&av)[8], const float (&bv)[8]) {
    const int stp = ptid >> 3, c8 = (ptid & 7) * 8;
    float lp[8], lpm[8];
    { const f32x4 a0 = *(const LAS f32x4*)(LP + stp * 64 + c8), a1 = *(const LAS f32x4*)(LP + stp * 64 + c8 + 4);
#pragma unroll
      for (int q = 0; q < 4; ++q) { lp[q] = a0[q]; lp[4 + q] = a1[q]; lpm[q] = 0.f; lpm[4 + q] = 0.f; }
      if (stp > 0) { const f32x4 b0 = *(const LAS f32x4*)(LP + (stp - 1) * 64 + c8), b1 = *(const LAS f32x4*)(LP + (stp - 1) * 64 + c8 + 4);
#pragma unroll
        for (int q = 0; q < 4; ++q) { lpm[q] = b0[q]; lpm[4 + q] = b1[q]; } } }
    float at[8], rt[8], bt[8], kt[8];
#pragma unroll
    for (int q = 0; q < 8; ++q) { const float Pq = __expf(lp[q]), Pm = __expf(lpm[q]), iP = __expf(-lp[q]); at[q] = Pm * av[q]; rt[q] = Pq * r[q]; bt[q] = bv[q] * iP; kt[q] = km[q] * iP; if (stp == 31) ((LAS float*)(Q + Q_PL))[c8 + q] = Pq; }
    const int ob = (stp * 64 + c8) * 2;
#define PK8(x) ((u32x4){cvt_pk_bf16(x[0], x[1]), cvt_pk_bf16(x[2], x[3]), cvt_pk_bf16(x[4], x[5]), cvt_pk_bf16(x[6], x[7])})
    *(LAS u32x4*)(Q + Q_AT + ob) = PK8(at); *(LAS u32x4*)(Q + Q_RT + ob) = PK8(rt); *(LAS u32x4*)(Q + Q_BT + ob) = PK8(bt); *(LAS u32x4*)(Q + Q_KT + ob) = PK8(kt);
#undef PK8
#pragma unroll
    for (int q = 0; q < 8; ++q) { *(LAS bf16_t*)(Q + Q_BK + ((c8 + q) * 32 + stp) * 2) = f2bf(bt[q]); *(LAS bf16_t*)(Q + Q_KK + ((c8 + q) * 32 + stp) * 2) = f2bf(kt[q]); }
}
DI void scan3_s4(LAS unsigned char* Q, int m, int n, int hh) {
    const LAS unsigned char* Xa = Q + ((m & 2) ? Q_RT : Q_AT) + n * 128 + 16 * hh;
    const LAS unsigned char* Xb = Q + ((m & 1) ? Q_KT : Q_BT) + n * 128 + 16 * hh;
    f32x16 acc = zero16();
#pragma unroll
    for (int st = 0; st < 4; ++st) acc = mfma32(lds_frag16(Xa + 32 * st), lds_frag16(Xb + 32 * st), acc);
    const bool incl = (m & 2) != 0;
#pragma unroll
    for (int r_ = 0; r_ < 16; ++r_) { const int tt = crow(r_, hh); const bool keep = incl ? (n <= tt) : (n < tt); const float val = keep ? acc[r_] : 0.f;
        if (m == 0) ((LAS float*)(Q + Q_MAB))[tt * 32 + n] = val; else *(LAS bf16_t*)(Q + (m == 1 ? Q_MKB : (m == 2 ? Q_MBR : Q_MKR)) + (tt * 32 + n) * 2) = f2bf(val); }
}
DI void scan3_s8(const Ctx& c, const LAS unsigned char* Q, const LAS float* YV, int b, int h, int chunk, int ptid) {
    const int stp = ptid >> 3, c8 = (ptid & 7) * 8, hc = h * 64 + c8, o = stp * 64 + c8; const size_t t = (size_t)b * SEQ + chunk * 32 + stp;
    float lng[8], lnb[8];
    { const LAS float* pr = (const LAS float*)(c.lds + Q_PRM) + c8;
#pragma unroll
      for (int q = 0; q < 8; ++q) { lng[q] = pr[384 + q]; lnb[q] = pr[448 + q]; } }
    const LAS float* VV = (const LAS float*)(Q + Q_VV); const LAS float* GV = (const LAS float*)(Q + Q_GV);
    float y[8], vv[8], gv[8];
#pragma unroll
    for (int hq = 0; hq < 2; ++hq) { const f32x4 a = *(const LAS f32x4*)(YV + o + hq * 4), bq = *(const LAS f32x4*)(VV + o + hq * 4), cq = *(const LAS f32x4*)(GV + o + hq * 4);
#pragma unroll
        for (int q = 0; q < 4; ++q) { y[hq * 4 + q] = a[q]; vv[hq * 4 + q] = bq[q]; gv[hq * 4 + q] = cq[q]; } }
    float sm = 0.f;
#pragma unroll
    for (int q = 0; q < 8; ++q) sm += y[q];
    sm = red8(sm);
    const float mean = sm * (1.0f / 64.0f);
    float vr = 0.f;
#pragma unroll
    for (int q = 0; q < 8; ++q) { const float d = y[q] - mean; vr += d * d; }
    vr = red8(vr);
    const float rstd = rsqrtf(vr * (1.0f / 64.0f) + 64e-5f), bon = (ABL & 64) ? 0.f : ((const LAS float*)(Q + Q_BON))[stp];
    float ov[8];
#pragma unroll
    for (int q = 0; q < 8; ++q) ov[q] = ((y[q] - mean) * rstd * lng[q] + lnb[q] + bon * vv[q]) * gv[q];
    u32x4 wv; wv.x = cvt_pk_bf16(ov[0], ov[1]); wv.y = cvt_pk_bf16(ov[2], ov[3]); wv.z = cvt_pk_bf16(ov[4], ov[5]); wv.w = cvt_pk_bf16(ov[6], ov[7]);
    if (ABL & 1) wv = (u32x4){0u, 0u, 0u, 0u};
    *(u32x4*)(c.xn() + t * DM + hc) = wv;
}
DI void scan_chain3(const Ctx& c, int chain) {
    const int b = chain >> 3, h = chain & 7, tid = c.tid, lane = c.lane, w = c.wave;
    LAS unsigned char* L = c.lds;
    LAS float* LP = (LAS float*)(L + Q_LP); LAS float* YV = (LAS float*)(L + Q_YV); LAS float* CL = (LAS float*)(L + Q_CL);
    const bool prep = tid >= 256; const int ptid = tid & 255, n = lane & 31, hh = lane >> 5;
    LAS float* TT = (LAS float*)(L + Q_TT) + (w & 1) * 2048 + lane;
    if (w < 2) {
#pragma unroll
        for (int q = 0; q < 32; ++q) TT[q * 64] = 0.f;
    }
    float r_[8], km_[8], av_[8], bv_[8];
    Scan3Raw R;
    if (tid < 64) { LAS float* pr = (LAS float*)(L + Q_PRM); const int hc = h * 64 + tid;
        pr[tid] = c.in(I_MURKV)[hc]; pr[64 + tid] = c.in(I_MURKV)[512 + hc]; pr[128 + tid] = c.in(I_MURKV)[1024 + hc]; pr[192 + tid] = c.in(I_KK)[hc]; pr[256 + tid] = c.in(I_KA)[hc]; pr[320 + tid] = c.in(I_RK)[hc];
        pr[384 + tid] = c.in(I_LNXG)[hc]; pr[448 + tid] = c.in(I_LNXB)[hc]; }
    if (prep) scan3_load(c, R, b, h, 0, ptid);
    __syncthreads();
    if (prep) { scan3_s1(c, h, L, LP, R, ptid, r_, km_, av_, bv_); scan3_load(c, R, b, h, 1, ptid); }
    __syncthreads();
    if (prep) scan3_s2(LP, ptid);
    __syncthreads();
    if (prep) scan3_s3(L, LP, ptid, r_, km_, av_, bv_);
    __syncthreads();
    if (prep) scan3_s4(L, w - 4, n, hh);
    __syncthreads();
#pragma unroll 1
    for (int chunk = 0; chunk < SEQ / 32; ++chunk) {
        LAS unsigned char* Qc = L + (chunk & 1) * Q_SET;
        LAS unsigned char* Qn = L + ((chunk + 1) & 1) * Q_SET;
        const bool more = chunk + 1 < SEQ / 32;
        if (prep) {
            if (more) scan3_s1(c, h, Qn, LP, R, ptid, r_, km_, av_, bv_);
        } else if (w < 2) {
            f32x16 cacc = zero16(), yacc = zero16();
            const LAS unsigned char* vt = Qc + Q_VT + (32 * w + n) * 64 + 16 * hh;
#pragma unroll
            for (int st = 0; st < 2; ++st) { const bf16x8 vb_ = lds_frag16(vt + 32 * st);
                cacc = mfma32(lds_frag16(Qc + Q_MKB + n * 64 + 16 * hh + 32 * st), vb_, cacc); yacc = mfma32(lds_frag16(Qc + Q_MKR + n * 64 + 16 * hh + 32 * st), vb_, yacc); }
#pragma unroll
            for (int jb = 0; jb < 2; ++jb)
#pragma unroll
                for (int st = 0; st < 2; ++st) {
                    u32x4 tp_;
#pragma unroll
                    for (int e = 0; e < 4; ++e) tp_[e] = cvt_pk_bf16(TT[(jb * 16 + 8 * st + 2 * e) * 64], TT[(jb * 16 + 8 * st + 2 * e + 1) * 64]);
                    const bf16x8 tb = __builtin_bit_cast(bf16x8, tp_);
                    const int ko = (32 * jb + 16 * st + 4 * hh) * 2;
                    cacc = mfma32(lds_frag8x2(Qc + Q_AT + n * 128 + ko), tb, cacc); yacc = mfma32(lds_frag8x2(Qc + Q_RT + n * 128 + ko), tb, yacc);
                }
#pragma unroll
            for (int q = 0; q < 16; ++q) { CL[crow(q, hh) * 64 + 32 * w + n] = cacc[q]; YV[crow(q, hh) * 64 + 32 * w + n] = yacc[q]; }
        }
        __syncthreads();
        if (prep) { if (chunk + 2 < SEQ / 32) scan3_load(c, R, b, h, chunk + 2, ptid); if (more) scan3_s2(LP, ptid); }
        else {
            const int i = tid >> 2, l = tid & 3;
            const LAS float* MAB = (const LAS float*)(Qc + Q_MAB);
            float u[8];
#pragma unroll
            for (int e = 0; e < 8; ++e) u[e] = 0.f;
#pragma unroll 1
            for (int to = 0; to < 4; ++to) {
#pragma unroll
                for (int te = 0; te < 8; ++te) {
                    const int tt = to * 8 + te;
                    const f32x4 m0 = *(const LAS f32x4*)(MAB + tt * 32 + 8 * l), m1 = *(const LAS f32x4*)(MAB + tt * 32 + 8 * l + 4);
                    float sa_ = 0.f, sb_ = 0.f;
#pragma unroll
                    for (int e = 0; e < 4; ++e) { sa_ += u[e] * m0[e]; sb_ += u[4 + e] * m1[e]; }
                    sa_ += sb_; sa_ += dppmov<0xB1>(sa_); sa_ += dppmov<0x4E>(sa_);
                    const float ut = CL[tt * 64 + i] + sa_;
                    if (l == to) u[te] = ut;
                }
            }
            u32x4 x; x.x = cvt_pk_bf16(u[0], u[1]); x.y = cvt_pk_bf16(u[2], u[3]); x.z = cvt_pk_bf16(u[4], u[5]); x.w = cvt_pk_bf16(u[6], u[7]);
            *(LAS u32x4*)(L + Q_UT + (i * 32 + 8 * l) * 2) = x;
        }
        __syncthreads();
        if (prep) { if (more) scan3_s3(Qn, LP, ptid, r_, km_, av_, bv_); }
        else if (w < 2) {
            const LAS unsigned char* ut = L + Q_UT + (32 * w + n) * 64 + 16 * hh;
            const LAS unsigned char* vt = Qc + Q_VT + (32 * w + n) * 64 + 16 * hh;
            f32x16 T0, T1, yacc;
#pragma unroll
            for (int q = 0; q < 16; ++q) { T0[q] = TT[q * 64]; T1[q] = TT[(16 + q) * 64]; yacc[q] = YV[crow(q, hh) * 64 + 32 * w + n]; }
#pragma unroll
            for (int st = 0; st < 2; ++st) {
                const bf16x8 ub = lds_frag16(ut + 32 * st), vb_ = lds_frag16(vt + 32 * st);
                yacc = mfma32(lds_frag16(Qc + Q_MBR + n * 64 + 16 * hh + 32 * st), ub, yacc);
                T0 = mfma32(lds_frag16(Qc + Q_BK + n * 64 + 16 * hh + 32 * st), ub, T0); T1 = mfma32(lds_frag16(Qc + Q_BK + (32 + n) * 64 + 16 * hh + 32 * st), ub, T1);
                T0 = mfma32(lds_frag16(Qc + Q_KK + n * 64 + 16 * hh + 32 * st), vb_, T0); T1 = mfma32(lds_frag16(Qc + Q_KK + (32 + n) * 64 + 16 * hh + 32 * st), vb_, T1);
            }
            const LAS float* PL = (const LAS float*)(Qc + Q_PL);
#pragma unroll
            for (int q = 0; q < 16; ++q) { const int kr = crow(q, hh); TT[q * 64] = T0[q] * PL[kr]; TT[(16 + q) * 64] = T1[q] * PL[32 + kr]; YV[kr * 64 + 32 * w + n] = yacc[q]; }
        }
        __syncthreads();
        if (prep) { if (more) scan3_s4(Qn, w - 4, n, hh); scan3_s8(c, Qc, YV, b, h, chunk, ptid); }
        __syncthreads();
    }
}


DI float pair_max(float x) { const u32x2 r = __builtin_amdgcn_permlane32_swap(__float_as_uint(x), __float_as_uint(x), false, false); return fmaxf(__uint_as_float(r.x), __uint_as_float(r.y)); }
DI float pair_sum(float x) { const u32x2 r = __builtin_amdgcn_permlane32_swap(__float_as_uint(x), __float_as_uint(x), false, false); return __uint_as_float(r.x) + __uint_as_float(r.y); }
DI float fexp2(float x) { return __builtin_amdgcn_exp2f(x); }
constexpr float M_FLOOR = -30000.0f, NEGBIG = -1e30f;
DI bf16x8 att_vf(const LAS unsigned char* vr, int g, int ksw) { const u32x2 lo_ = *(const LAS u32x2*)(vr + ((g ^ ksw) << 4)), hi_ = *(const LAS u32x2*)(vr + (((g + 1) ^ ksw) << 4)); return __builtin_bit_cast(bf16x8, (u32x4){lo_.x, lo_.y, hi_.x, hi_.y}); }
constexpr int ATT_RING_OFF = 16384, ATT_SLOT = 16384;

template <int MODE>
DI void flash_lds(const Ctx& c, const bf16_t* Kb, const bf16_t* Vt, unsigned blkmask, const bf16x8 (&q)[4], int tq, int qb, unsigned selmask, int n, int hh, int half, float gate, f32x16 (&out)[2]) {
    LAS unsigned char* ring = c.lds + ATT_RING_OFF;
    const int row = c.tid >> 3, gsw = (c.tid & 7) ^ ((row >> 1) & 7);
    const bf16_t* ksrc = Kb + (size_t)row * 64 + gsw * 8;
    const bf16_t* vsrc = Vt + (size_t)row * SEQ + gsw * 8;
    const unsigned wofs = (unsigned)c.wave * 1024u;
#define ATT_ISSUE(j, slot) do { \
        __builtin_amdgcn_global_load_lds((const unsigned*)(ksrc + (size_t)(j) * 4096), (LAS unsigned*)(ring + (slot) * ATT_SLOT + wofs), 16, 0, 0); \
        __builtin_amdgcn_global_load_lds((const unsigned*)(vsrc + (size_t)(j) * 64), (LAS unsigned*)(ring + (slot) * ATT_SLOT + 8192 + wofs), 16, 0, 0); } while (0)
    unsigned m = blkmask; const int nb = __builtin_popcount(m);
    int j0 = -1, j1 = -1;
    if (nb > 0) { j0 = __builtin_ctz(m); m &= m - 1; ATT_ISSUE(j0, 0); }
    if (nb > 1) { j1 = __builtin_ctz(m); m &= m - 1; ATT_ISSUE(j1, 1); }
    float lrun = 0.f; f32x16 o[2]; o[0] = zero16(); o[1] = zero16();
    const int ksw = (n >> 1) & 7;
    int slot = 0;
#pragma unroll 1
    for (int i = 0; i < nb; ++i) {
        if (i + 1 < nb) asm volatile("s_waitcnt vmcnt(2)" ::: "memory"); else asm volatile("s_waitcnt vmcnt(0)" ::: "memory");
        __builtin_amdgcn_s_barrier();
        asm volatile("" ::: "memory");
        int j2 = -1;
        if (i + 2 < nb) { j2 = __builtin_ctz(m); m &= m - 1; const int s2 = slot >= 1 ? slot - 1 : 2; ATT_ISSUE(j2, s2); }
        const LAS unsigned char* kb = ring + slot * ATT_SLOT; const LAS unsigned char* vb = kb + 8192;
        const bool bit = (MODE == 0) ? ((selmask >> j0) & 1u) : true;
        if (__ballot(bit) != 0ull) {
            int cls0 = 1, cls1 = 1;
            if (j0 == qb) { cls0 = (0 < half) ? 1 : 2; cls1 = (1 == half) ? 2 : 0; }
            if (MODE == 1 && j0 == qb - 4) { cls0 = (0 == half) ? 3 : 0; cls1 = (1 > half) ? 1 : 3; }
            f32x16 s0 = zero16(), s1 = zero16();
            const LAS unsigned char* kr0 = kb + n * 128; const LAS unsigned char* kr1 = kr0 + 32 * 128;
            if (cls0 && cls1) {
#pragma unroll
                for (int s = 0; s < 4; ++s) { const bf16x8 ka = *(const LAS bf16x8*)(kr0 + (((2 * s + hh) ^ ksw) << 4)), kc = *(const LAS bf16x8*)(kr1 + (((2 * s + hh) ^ ksw) << 4)); s0 = mfma32(ka, q[s], s0); s1 = mfma32(kc, q[s], s1); }
            } else if (cls0) {
#pragma unroll
                for (int s = 0; s < 4; ++s) { const bf16x8 ka = *(const LAS bf16x8*)(kr0 + (((2 * s + hh) ^ ksw) << 4)); s0 = mfma32(ka, q[s], s0); }
            } else {
#pragma unroll
                for (int s = 0; s < 4; ++s) { const bf16x8 kc = *(const LAS bf16x8*)(kr1 + (((2 * s + hh) ^ ksw) << 4)); s1 = mfma32(kc, q[s], s1); }
            }
            const int tl = tq & 31;
            if (cls0 >= 2) {
#pragma unroll
                for (int r = 0; r < 16; ++r) { const int kl = crow(r, hh); const bool v = (cls0 == 2) ? (kl <= tl) : (kl > tl); s0[r] = v ? s0[r] : NEGBIG; }
            }
            if (cls1 >= 2) {
#pragma unroll
                for (int r = 0; r < 16; ++r) { const int kl = crow(r, hh); const bool v = (cls1 == 2) ? (kl <= tl) : (kl > tl); s1[r] = v ? s1[r] : NEGBIG; }
            }
            if (MODE == 0) {
#pragma unroll
                for (int r = 0; r < 16; ++r) { s0[r] = bit ? s0[r] : NEGBIG; s1[r] = bit ? s1[r] : NEGBIG; }
            }
            float psa = 0.f, psb = 0.f;
            if (cls0) {
#pragma unroll
                for (int r = 0; r < 16; ++r) { s0[r] = fexp2(s0[r]); psa += s0[r]; }
            }
            if (cls1) {
#pragma unroll
                for (int r = 0; r < 16; ++r) { s1[r] = fexp2(s1[r]); psb += s1[r]; }
            }
            const unsigned bitw = bit ? 0xffffffffu : 0u;
            lrun += psa + psb;
#define ATT_PK(x, h_) ({ u32x4 p_ = __builtin_bit_cast(u32x4, pack8(x, h_));  __builtin_bit_cast(bf16x8, p_); })
            const LAS unsigned char* vr0 = vb + n * 128 + 8 * hh; const LAS unsigned char* vr1 = vr0 + 32 * 128;
#define ATT_VF(vr, g) att_vf((vr), (g), ksw)
            if (cls0) {
                const bf16x8 pa = ATT_PK(s0, 0), pb = ATT_PK(s0, 1);
                o[0] = mfma32(ATT_VF(vr0, 0), pa, o[0]); o[1] = mfma32(ATT_VF(vr1, 0), pa, o[1]);
                o[0] = mfma32(ATT_VF(vr0, 2), pb, o[0]); o[1] = mfma32(ATT_VF(vr1, 2), pb, o[1]);
            }
            if (cls1) {
                const bf16x8 pa = ATT_PK(s1, 0), pb = ATT_PK(s1, 1);
                o[0] = mfma32(ATT_VF(vr0, 4), pa, o[0]); o[1] = mfma32(ATT_VF(vr1, 4), pa, o[1]);
                o[0] = mfma32(ATT_VF(vr0, 6), pb, o[0]); o[1] = mfma32(ATT_VF(vr1, 6), pb, o[1]);
            }
#undef ATT_VF
#undef ATT_PK
        }
        j0 = j1; j1 = j2; slot = slot == 2 ? 0 : slot + 1;
    }
    __builtin_amdgcn_s_barrier();
    asm volatile("" ::: "memory");
#undef ATT_ISSUE
    const float lt = pair_sum(lrun), sc = lt > 0.f ? gate / lt : 0.f;
#pragma unroll
    for (int r = 0; r < 16; ++r) { out[0][r] += o[0][r] * sc; out[1][r] += o[1][r] * sc; }
}

template <bool ROT>
DI void load_q(const Ctx& c, const bf16_t* qp, int pos, int hh, bf16x8 (&qf)[4]) {
    float y[4][8]; float ss = 0.f;
#pragma unroll
    for (int s = 0; s < 4; ++s) { const u32x4 raw = *(const u32x4*)(qp + 16 * s);
#pragma unroll
        for (int e = 0; e < 4; ++e) { y[s][2 * e] = bflo(raw[e]); y[s][2 * e + 1] = bfhi(raw[e]); ss += y[s][2 * e] * y[s][2 * e] + y[s][2 * e + 1] * y[s][2 * e + 1]; } }
    ss += __shfl_xor(ss, 32);
    const float rs = rsqrtf(ss * (1.0f / 64.0f) + 1e-6f) * (0.125f * 1.4426950408889634f);
    const float* qg = c.in(I_QNG) + 8 * hh;
#pragma unroll
    for (int s = 0; s < 4; ++s)
#pragma unroll
        for (int e = 0; e < 8; ++e) y[s][e] *= rs * qg[16 * s + e];
    if (!ROT) {
#pragma unroll
        for (int s = 0; s < 4; ++s) { u32x4 p; for (int e = 0; e < 4; ++e) p[e] = cvt_pk_bf16(y[s][2 * e], y[s][2 * e + 1]); qf[s] = __builtin_bit_cast(bf16x8, p); }
    } else {
        const float* rp = c.rope() + (size_t)pos * 64 + 16 * hh;
#pragma unroll
        for (int s = 0; s < 2; ++s) {
            float lo[8], hi[8];
#pragma unroll
            for (int e = 0; e < 8; ++e) { const float cs = rp[32 * s + 2 * e], sn = rp[32 * s + 2 * e + 1]; lo[e] = y[s][e] * cs - y[s + 2][e] * sn; hi[e] = y[s + 2][e] * cs + y[s][e] * sn; }
            u32x4 pl, ph; for (int e = 0; e < 4; ++e) { pl[e] = cvt_pk_bf16(lo[2 * e], lo[2 * e + 1]); ph[e] = cvt_pk_bf16(hi[2 * e], hi[2 * e + 1]); }
            qf[s] = __builtin_bit_cast(bf16x8, pl); qf[s + 2] = __builtin_bit_cast(bf16x8, ph);
        }
    }
}

DI void attn_item(const Ctx& c, int item) {
    const int qb = (item + 4 * (item >> 8)) & 31, kvh = (item >> 5) & 1, b = item >> 6;
    const int w = c.wave, g = w >> 1, head = kvh * 4 + g, n = c.lane & 31, hh = c.lane >> 5;
    const int tokw0 = qb * 64 + (w & 1) * 32, pos = tokw0 + n, tq = (w & 1) * 32 + n;
    LAS float* IMP = (LAS float*)c.lds;
    LAS unsigned* SEL = (LAS unsigned*)(c.lds + 8192);
    for (int i = c.tid; i < 64 * 32; i += NTHREADS) IMP[i] = 0.f;
    if (c.tid == 0) SEL[64] = 0u;
    const bf16_t* prow = c.proj() + ((size_t)b * SEQ + pos) * NPROJ;
    const bf16_t* qp = prow + C_Q + head * 64 + 8 * hh;
    float gate[3];
    { const bf16_t* gp = prow + C_GL + head * 3; for (int i = 0; i < 3; ++i) gate[i] = ((ABL >> (3 + i)) & 1) ? 0.f : sigmoidf_(bf2f(gp[i])); }
    f32x16 out[2]; out[0] = zero16(); out[1] = zero16();
    {
        LAS unsigned char* ring = c.lds + ATT_RING_OFF;
        {
            const int row = c.tid >> 3, gsw = (c.tid & 7) ^ ((row >> 1) & 7); const unsigned wofs = (unsigned)c.wave * 1024u;
            const bf16_t* kc = c.kcmp() + (size_t)(b * 2 + kvh) * 128 * 64 + (size_t)row * 64 + gsw * 8;
            const bf16_t* vc = c.vcmpt() + (size_t)(b * 2 + kvh) * 64 * 128 + (size_t)row * 128 + gsw * 8;
#pragma unroll
            for (int j = 0; j < 2; ++j) {
                __builtin_amdgcn_global_load_lds((const unsigned*)(kc + j * 4096), (LAS unsigned*)(ring + j * ATT_SLOT + wofs), 16, 0, 0);
                __builtin_amdgcn_global_load_lds((const unsigned*)(vc + j * 64), (LAS unsigned*)(ring + j * ATT_SLOT + 8192 + wofs), 16, 0, 0);
            }
        }
        bf16x8 qn[4]; load_q<false>(c, qp, pos, hh, qn);
        asm volatile("s_waitcnt vmcnt(0)" ::: "memory");
        __syncthreads();
        const int ksw = (n >> 1) & 7;
        float mrun = -1e30f, lrun = 0.f;
#pragma unroll 1
        for (int t = 0; t < 4; ++t) {
            const LAS unsigned char* kr = ring + (t >> 1) * ATT_SLOT + (32 * (t & 1) + n) * 128;
            f32x16 sc = zero16();
#pragma unroll
            for (int s = 0; s < 4; ++s) { const bf16x8 kf = *(const LAS bf16x8*)(kr + (((2 * s + hh) ^ ksw) << 4)); sc = mfma32(kf, qn[s], sc); }
            float mx = -1e30f;
#pragma unroll
            for (int r = 0; r < 16; ++r) { const int key = t * 32 + crow(r, hh); const bool v = key <= 126 && key * 16 + 31 <= pos; mx = v ? fmaxf(mx, sc[r]) : mx; }
            const float mnew = fmaxf(mrun, mx); float ps = 0.f;
#pragma unroll
            for (int r = 0; r < 16; ++r) { const int key = t * 32 + crow(r, hh); const bool v = key <= 126 && key * 16 + 31 <= pos; ps += v ? fexp2(sc[r] - mnew) : 0.f; }
            lrun = lrun * fexp2(mrun - mnew) + ps; mrun = mnew;
        }
        {
            const float mo = __shfl_xor(mrun, 32), lo_ = __shfl_xor(lrun, 32), mm = fmaxf(mrun, mo);
            lrun = lrun * fexp2(mrun - mm) + lo_ * fexp2(mo - mm); mrun = mm;
        }
        const float inv = lrun > 0.f ? 1.0f / lrun : 0.f;
        float carry = 0.f;
#pragma unroll 1
        for (int t = 0; t < 4; ++t) {
            const LAS unsigned char* kr = ring + (t >> 1) * ATT_SLOT + (32 * (t & 1) + n) * 128;
            const LAS unsigned char* vb = ring + (t >> 1) * ATT_SLOT + 8192;
            const int tt = t & 1;
            f32x16 sc = zero16();
#pragma unroll
            for (int s = 0; s < 4; ++s) { const bf16x8 kf = *(const LAS bf16x8*)(kr + (((2 * s + hh) ^ ksw) << 4)); sc = mfma32(kf, qn[s], sc); }
#pragma unroll
            for (int r = 0; r < 16; ++r) { const int key = t * 32 + crow(r, hh); const bool v = key <= 126 && key * 16 + 31 <= pos; sc[r] = v ? fexp2(sc[r] - mrun) * inv : 0.f; }
            const bf16x8 pf0 = pack8(sc, 0), pf1 = pack8(sc, 1);
#pragma unroll
            for (int rb = 0; rb < 2; ++rb) {
                const LAS unsigned char* vr = vb + (32 * rb + n) * 128 + 8 * hh;
                const u32x2 l0 = *(const LAS u32x2*)(vr + (((4 * tt) ^ ksw) << 4)), h0 = *(const LAS u32x2*)(vr + (((4 * tt + 1) ^ ksw) << 4));
                const u32x2 l1 = *(const LAS u32x2*)(vr + (((4 * tt + 2) ^ ksw) << 4)), h1 = *(const LAS u32x2*)(vr + (((4 * tt + 3) ^ ksw) << 4));
                const bf16x8 v0 = __builtin_bit_cast(bf16x8, (u32x4){l0.x, l0.y, h0.x, h0.y}), v1 = __builtin_bit_cast(bf16x8, (u32x4){l1.x, l1.y, h1.x, h1.y});
                out[rb] = mfma32(v0, pf0, out[rb]); out[rb] = mfma32(v1, pf1, out[rb]);
            }
            float Ep[4];
#pragma unroll
            for (int q = 0; q < 4; ++q) Ep[q] = __shfl_xor(sc[4 * q + 3], 32);
#pragma unroll
            for (int q = 0; q < 4; ++q) {
                const float Gs = sc[4 * q] + sc[4 * q + 1] + sc[4 * q + 2] + sc[4 * q + 3];
                const float prev0 = q > 0 ? Ep[q - 1] : carry;
                const float add = hh ? Ep[q] : prev0;
                __hip_atomic_fetch_add(IMP + tq * 32 + 8 * t + 2 * q + hh, Gs + add, __ATOMIC_RELAXED, __HIP_MEMORY_SCOPE_WORKGROUP);
            }
            carry = Ep[3];
        }
#pragma unroll
        for (int r = 0; r < 16; ++r) { out[0][r] *= gate[0]; out[1][r] *= gate[0]; }
    }
    __syncthreads();
    {
        const int tkn = c.tid >> 3, sub = c.tid & 7;
        unsigned mask;
        if (qb < 8) mask = (1u << (qb + 1)) - 1u;
        else {
            mask = 1u | (1u << qb) | (1u << (qb - 1));
            const f32x4 iv = *(const LAS f32x4*)(IMP + tkn * 32 + sub * 4);
            float v[4];
#pragma unroll
            for (int e = 0; e < 4; ++e) { const int j = sub * 4 + e; v[e] = (j >= 1 && j <= qb - 2) ? iv[e] : -1.0f; }
#pragma unroll 1
            for (int pick = 0; pick < 5; ++pick) {
                float bv = v[0]; int bj = sub * 4;
#pragma unroll
                for (int e = 1; e < 4; ++e) if (v[e] > bv) { bv = v[e]; bj = sub * 4 + e; }
#define TOPK_STEP(CTRL) { const float pv_ = dppmov<CTRL>(bv); const int pj_ = __builtin_amdgcn_update_dpp(0, bj, CTRL, 0xf, 0xf, true); const bool t_ = pv_ > bv || (pv_ == bv && pj_ < bj); bv = t_ ? pv_ : bv; bj = t_ ? pj_ : bj; }
                TOPK_STEP(0xB1) TOPK_STEP(0x4E) TOPK_STEP(0x141)
#undef TOPK_STEP
                if (bv < 0.f) break;
                mask |= 1u << bj;
#pragma unroll
                for (int e = 0; e < 4; ++e) if (sub * 4 + e == bj) v[e] = -1.0f;
            }
        }
        if (sub == 0) { SEL[tkn] = mask; __hip_atomic_fetch_or(SEL + 64, mask, __ATOMIC_RELAXED, __HIP_MEMORY_SCOPE_WORKGROUP); }
    }
    __syncthreads();
    const unsigned selmask = SEL[tq];
    const unsigned anysel = SEL[64] & ((2u << qb) - 1u);
    {
        bf16x8 qr[4]; load_q<true>(c, qp, pos, hh, qr);
        flash_lds<0>(c, c.ksr() + (size_t)(b * 2 + kvh) * SEQ * 64, c.vst() + (size_t)(b * 2 + kvh) * 64 * SEQ, anysel, qr, tq, qb, selmask, n, hh, w & 1, gate[1], out);
        const unsigned wmask = ((2u << qb) - 1u) & ~((qb >= 4) ? ((1u << (qb - 4)) - 1u) : 0u);
        flash_lds<1>(c, c.kwr() + (size_t)(b * 2 + kvh) * SEQ * 64, c.vwt() + (size_t)(b * 2 + kvh) * 64 * SEQ, wmask, qr, tq, qb, 0xffffffffu, n, hh, w & 1, gate[2], out);
    }
    bf16_t* yp = c.xn() + ((size_t)b * SEQ + pos) * DM + 512 + head * 64 + 4 * hh;
#pragma unroll
    for (int rb = 0; rb < 2; ++rb)
#pragma unroll
        for (int q = 0; q < 4; ++q) { u32x2 wv; wv.x = cvt_pk_bf16(out[rb][4 * q], out[rb][4 * q + 1]); wv.y = cvt_pk_bf16(out[rb][4 * q + 2], out[rb][4 * q + 3]); if (ABL & 2) wv = (u32x2){0u, 0u}; *(u32x2*)(yp + 32 * rb + 8 * q) = wv; }
    __syncthreads();
}

DI void p5_moe_weights(const Ctx& c) {
    const float* w1 = c.in(I_MW1); const float* w2 = c.in(I_MW2);
    for (int it = c.bid; it < 4096 + 2048; it += c.G) {
        if (it < 4096) {
            const int e = it >> 7, r = it & 127, ntile = r >> 4, kt = r & 15;
            tconv_big_fp8(c, w1 + (size_t)e * DM * 2048, 2048, c.w1t() + (size_t)e * 2048 * DM, DM, kt * 64, ntile * 256,
                          [](int nn) { const int half = nn >> 10, jn = nn & 1023; return (jn >> 7) * 256 + half * 128 + (jn & 127); }, 32.0f);
        } else {
            const int j = it - 4096, e = j >> 6, r = j & 63, ntile = r >> 4, kt = r & 15;
            tconv_big_fp8(c, w2 + (size_t)e * DFF * DM, DM, c.w2t() + (size_t)e * DM * DFF, DFF, kt * 64, ntile * 256, [](int nn) { return nn; }, 32.0f);
        }
    }
}

DI void p6_router(const Ctx& c, int dry) {
    LAS float* LN2 = (LAS float*)c.lds;
    for (int i = c.tid; i < DM; i += NTHREADS) LN2[i] = c.in(I_LN2)[i];
    __syncthreads();
    const float* x1 = c.out; unsigned char* hb = c.h8(); const bf16_t* wt = c.wrt();
    int* cnt = c.ctl(); int* ids = c.ids(); float* rsl = c.rsl(); unsigned* tp = (unsigned*)(c.ws + WS_TP); float* tg = (float*)(c.ws + WS_TG);
    const int n = c.lane & 31, hh = c.lane >> 5;
    const float* br = c.in(I_MBR);
    const int gw = c.bid * 8 + c.wave, nw = c.G * 8;
    LAS int* LCNT = (LAS int*)(c.lds + 8192); LAS int* LBASE = LCNT + 32;
    if (c.tid < NEXP) LCNT[c.tid] = 0;
    __syncthreads();
    for (int t0b = c.bid * 256; t0b < T_TOK; t0b += c.G * 256) {
        const int t0 = t0b + c.wave * 32; const bool live = t0 < T_TOK; const int tok = live ? t0 + n : n;
        const float* xp = x1 + (size_t)tok * DM + 8 * hh; unsigned char* hp = hb + (size_t)tok * DM + 8 * hh;
        const bf16_t* wp = wt + (size_t)n * DM + 8 * hh;
        f32x16 acc = zero16(); float ss = 0.f;
#pragma unroll 4
        for (int s = 0; s < 64; ++s) {
            const f32x4 xa = __builtin_nontemporal_load((const f32x4*)(xp + 16 * s)), xb = __builtin_nontemporal_load((const f32x4*)(xp + 16 * s + 4));
            const f32x4 ga = *(const LAS f32x4*)(LN2 + 16 * s + 8 * hh), gb = *(const LAS f32x4*)(LN2 + 16 * s + 8 * hh + 4);
            float v[8];
#pragma unroll
            for (int j = 0; j < 4; ++j) { v[j] = xa[j] * ga[j]; v[4 + j] = xb[j] * gb[j]; }
            u32x4 ph, pl;
#pragma unroll
            for (int j = 0; j < 4; ++j) { ss += v[2 * j] * v[2 * j] + v[2 * j + 1] * v[2 * j + 1]; ph[j] = cvt_pk_bf16(v[2 * j], v[2 * j + 1]); pl[j] = cvt_pk_bf16(v[2 * j] - bflo(ph[j]), v[2 * j + 1] - bfhi(ph[j])); }
            { u32x2 w8; w8.x = cvt4_fp8(v[0], v[1], v[2], v[3]); w8.y = cvt4_fp8(v[4], v[5], v[6], v[7]); *(u32x2*)(hp + 16 * s) = w8; }
            const bf16x8 whi = *(const bf16x8*)(wp + 16 * s), wlo = *(const bf16x8*)(wp + NEXP * DM + 16 * s);
            const bf16x8 xhi = __builtin_bit_cast(bf16x8, ph), xlo = __builtin_bit_cast(bf16x8, pl);
            acc = mfma32(whi, xhi, acc); acc = mfma32(wlo, xhi, acc); acc = mfma32(whi, xlo, acc);
        }
        ss = pair_sum(ss);
        const float rs = rsqrtf(ss * (1.0f / DM) + 1e-6f);
        float tv[4] = {-3.0e38f, -3.0e38f, -3.0e38f, -3.0e38f}; int te[4] = {0, 0, 0, 0};
#pragma unroll
        for (int r = 0; r < 16; ++r) {
            const int e = crow(r, hh); const float lg = acc[r] * rs + br[e];
            const bool b0 = lg > tv[0], b1 = lg > tv[1], b2 = lg > tv[2], b3 = lg > tv[3];
            tv[3] = b2 ? tv[2] : (b3 ? lg : tv[3]); te[3] = b2 ? te[2] : (b3 ? e : te[3]);
            tv[2] = b1 ? tv[1] : (b2 ? lg : tv[2]); te[2] = b1 ? te[1] : (b2 ? e : te[2]);
            tv[1] = b0 ? tv[0] : (b1 ? lg : tv[1]); te[1] = b0 ? te[0] : (b1 ? e : te[1]);
            tv[0] = b0 ? lg : tv[0]; te[0] = b0 ? e : te[0];
        }
        float pv[4]; int pe[4];
#pragma unroll
        for (int k = 0; k < 4; ++k) { pv[k] = __shfl_xor(tv[k], 32); pe[k] = __shfl_xor(te[k], 32); }
#pragma unroll
        for (int k = 0; k < 4; ++k) {
            const float lg = pv[k]; const int e = pe[k];
            const bool b0 = lg > tv[0] || (lg == tv[0] && e < te[0]), b1 = lg > tv[1] || (lg == tv[1] && e < te[1]), b2 = lg > tv[2] || (lg == tv[2] && e < te[2]), b3 = lg > tv[3] || (lg == tv[3] && e < te[3]);
            tv[3] = b2 ? tv[2] : (b3 ? lg : tv[3]); te[3] = b2 ? te[2] : (b3 ? e : te[3]);
            tv[2] = b1 ? tv[1] : (b2 ? lg : tv[2]); te[2] = b1 ? te[1] : (b2 ? e : te[2]);
            tv[1] = b0 ? tv[0] : (b1 ? lg : tv[1]); te[1] = b0 ? te[0] : (b1 ? e : te[1]);
            tv[0] = b0 ? lg : tv[0]; te[0] = b0 ? e : te[0];
        }
        const float e1 = __expf(tv[1] - tv[0]), e2 = __expf(tv[2] - tv[0]), e3 = __expf(tv[3] - tv[0]), inv = 1.0f / (1.0f + e1 + e2 + e3);
        int exs[2], lps[2]; float gvs[2];
#pragma unroll
        for (int kk = 0; kk < 2; ++kk) {
            exs[kk] = hh ? (kk ? te[3] : te[2]) : (kk ? te[1] : te[0]);
            gvs[kk] = (hh ? (kk ? e3 : e2) : (kk ? e1 : 1.0f)) * inv;
            lps[kk] = (live && !dry) ? __hip_atomic_fetch_add(LCNT + exs[kk], 1, __ATOMIC_RELAXED, __HIP_MEMORY_SCOPE_WORKGROUP) : 0;
        }
        __syncthreads();
        if (c.tid < NEXP) { const int nloc = LCNT[c.tid]; LBASE[c.tid] = nloc > 0 ? atomicAdd(cnt + c.tid, nloc) : 0; }
        __syncthreads();
        if (live && !dry) {
#pragma unroll
            for (int kk = 0; kk < 2; ++kk) {
                const int k = 2 * hh + kk, li = exs[kk], ps = LBASE[li] + lps[kk];
                ids[(size_t)li * T_TOK + ps] = tok; rsl[(size_t)li * T_TOK + ps] = rs;
                tp[(size_t)tok * 4 + k] = ((unsigned)li << 24) | (unsigned)ps; tg[(size_t)tok * 4 + k] = gvs[kk];
            }
        }
        __syncthreads();
        if (c.tid < NEXP) LCNT[c.tid] = 0;
        __syncthreads();
    }
    __syncthreads();
}

constexpr int DIR_OFF = STAGE_BYTES;
DI MoeDir moe_dir_build(const Ctx& c) {
    LAS int* pref = (LAS int*)(c.lds + DIR_OFF); LAS int* cn = pref + 160; LAS int* rpref = pref + 320;
    if (c.tid < NLIST) cn[c.tid] = c.ctl()[c.tid];
    __syncthreads();
    if (c.tid == 0) { int s = 0; for (int l = 0; l < NLIST; ++l) { pref[l] = s; s += (cn[l] + BM - 1) / BM; } pref[NLIST] = s; }
    __syncthreads();
    MoeDir d; d.pref = pref; d.cnt = cn; d.rpref = rpref; return d;
}

DI void p9_combine(const Ctx& c, const MoeDir& dir, float gmul) {
    const unsigned* tp = (const unsigned*)(c.ws + WS_TP); const float* tg = (const float*)(c.ws + WS_TG);
    const int gw = c.bid * 8 + c.wave, nw = c.G * 8;
    for (int tok = gw; tok < T_TOK; tok += nw) {
        const u32x4 pv = *(const u32x4*)(tp + (size_t)tok * 4); const f32x4 gv = *(const f32x4*)(tg + (size_t)tok * 4);
        const bf16_t* yr[4];
#pragma unroll
        for (int k = 0; k < 4; ++k) { const int li = pv[k] >> 24, ps = pv[k] & 0xffffff; yr[k] = (const bf16_t*)(c.ws + y_row_off(dir.pref[li] * BM + ps)); }
        float* op = c.out + (size_t)tok * DM;
#pragma unroll
        for (int i = 0; i < 4; ++i) {
            const int col = (c.lane + 64 * i) * 4;
            f32x4 a = __builtin_nontemporal_load((const f32x4*)(op + col));
#pragma unroll
            for (int k = 0; k < 4; ++k) { const u32x2 y = __builtin_nontemporal_load((const u32x2*)(yr[k] + col)); const float g = gv[k] * gmul; a[0] += g * bflo(y.x); a[1] += g * bfhi(y.x); a[2] += g * bflo(y.y); a[3] += g * bfhi(y.y); }
            __builtin_nontemporal_store(a, (f32x4*)(op + col));
        }
    }
}

#define XB_TMO      128
#define XB_XCNT(j)  (256  + 64 * (j))
#define XB_XSUB(j)  (1280 + 64 * (j))
#define XB_XGEN(j)  (2304 + 64 * (j))
#define XB_TOP      3328
#define XB_TOPGEN   3392
#define XCD_BAR_WORDS 3456
#define XB_SPIN_CAP (1u << 20)
DI unsigned xb_ld(unsigned* p) { return __hip_atomic_load(p, __ATOMIC_RELAXED, __HIP_MEMORY_SCOPE_AGENT); }
DI unsigned xb_add(unsigned* p, unsigned v) { return __hip_atomic_fetch_add(p, v, __ATOMIC_RELAXED, __HIP_MEMORY_SCOPE_AGENT); }
DI unsigned xb_xcc_id() { return (unsigned)__builtin_amdgcn_s_getreg((3 << 11) | 20) & 0xFu; }
#define XB_SPIN(cond, bar) do { unsigned _sp = 0; while (cond) { __builtin_amdgcn_s_sleep(1); \
    if ((++_sp & 255u) == 0u) { if (xb_ld(&(bar)[XB_TMO])) break; if (_sp > XB_SPIN_CAP) { atomicAdd(&(bar)[XB_TMO], 1u); break; } } } } while (0)
struct XcdBarrier { unsigned* bar; unsigned x; volatile LAS unsigned* st; };
DI XcdBarrier xcd_barrier_post(unsigned* bar, volatile LAS unsigned* st) {
    XcdBarrier b; b.bar = bar; b.x = xb_xcc_id(); b.st = st;
    if (threadIdx.x == 0) (void)xb_add(&bar[XB_XCNT(b.x)], 1u);
    return b;
}
DI void xcd_barrier_complete(unsigned* bar, unsigned x, unsigned& nloc, unsigned& nx) {
    const unsigned G = gridDim.x * gridDim.y * gridDim.z;
    unsigned sum, cnt, mine, sp = 0u;
    for (;;) {
        sum = 0u; cnt = 0u; mine = 0u;
#pragma unroll
        for (unsigned j = 0; j < 16; ++j) { const unsigned cc = xb_ld(&bar[XB_XCNT(j)]); sum += cc; cnt += (cc > 0u) ? 1u : 0u; mine = (j == x) ? cc : mine; }
        if (sum == G) break;
        __builtin_amdgcn_s_sleep(1);
        if ((++sp & 255u) == 0u) { if (xb_ld(&bar[XB_TMO])) break; if (sp > XB_SPIN_CAP) { atomicAdd(&bar[XB_TMO], 1u); break; } }
    }
    nloc = mine > 0u ? mine : 1u; nx = cnt > 0u ? cnt : 1u;
}
DI void xcd_barrier(const XcdBarrier& b) {
    asm volatile("s_waitcnt vmcnt(0)" ::: "memory");
    __syncthreads();
    if (threadIdx.x == 0) {
        unsigned* bar = b.bar;
        __builtin_amdgcn_s_waitcnt(0);
        unsigned nloc = b.st[0], nx = b.st[1];
        if (nloc == 0u) { xcd_barrier_complete(bar, b.x, nloc, nx); b.st[0] = nloc; b.st[1] = nx; }
        const unsigned old = xb_add(&bar[XB_XSUB(b.x)], 1u);
        const unsigned gen = old / nloc;
        if (old + 1u == (gen + 1u) * nloc) {
            __builtin_amdgcn_fence(__ATOMIC_RELEASE, "agent");
            asm volatile("s_waitcnt vmcnt(0)" ::: "memory");
            const unsigned og = xb_add(&bar[XB_TOP], 1u);
            const unsigned tg = og / nx;
            if (og + 1u == (tg + 1u) * nx) xb_add(&bar[XB_TOPGEN], 1u);
            else XB_SPIN(xb_ld(&bar[XB_TOPGEN]) == tg, bar);
            __builtin_amdgcn_fence(__ATOMIC_ACQUIRE, "agent");
            xb_add(&bar[XB_XGEN(b.x)], 1u);
            asm volatile("s_waitcnt vmcnt(0)" ::: "memory");
        } else {
            XB_SPIN(xb_ld(&bar[XB_XGEN(b.x)]) == gen, bar);
            __builtin_amdgcn_fence(__ATOMIC_ACQUIRE, "agent");
            asm volatile("s_waitcnt vmcnt(0)" ::: "memory");
        }
    }
    __syncthreads();
}

__global__ void __launch_bounds__(NTHREADS, 2) fwd_kernel(Args a) {
    extern __shared__ __attribute__((aligned(16))) unsigned char lds_raw[];
    Ctx c;
#if defined(__HIP_DEVICE_COMPILE__)
    c.kargs = __builtin_amdgcn_kernarg_segment_ptr();
#endif
    c.out = a.out; c.ws = a.ws; c.lds = (LAS unsigned char*)lds_raw;
    c.tid = threadIdx.x; c.lane = c.tid & 63; c.wave = __builtin_amdgcn_readfirstlane(c.tid >> 6); c.G = gridDim.x; c.bid = blockIdx.x;
    cg::grid_group grid = cg::this_grid();
    volatile LAS unsigned* xbst = (volatile LAS unsigned*)(c.lds + LDS_BYTES - 16);
    if (c.tid == 0) { xbst[0] = 0u; xbst[1] = 0u; }
    __syncthreads();
    XcdBarrier xbar; xbar.bar = (unsigned*)(c.ws + WS_BAR); xbar.x = 0; xbar.st = xbst;
    if (a.coop) xbar = xcd_barrier_post((unsigned*)(c.ws + WS_BAR), xbst);
    const int lo = a.ph_lo, hi = a.ph_hi;
#ifndef PH_MASK
#define PH_MASK 0x303ff
#endif
#define IN(k) (((PH_MASK >> (k)) & 1) && lo <= (k) && (k) < hi)
#define SEAM(k) do { if (a.coop && IN(k) && IN((k) + 1)) { if ((k) == 0) grid.sync(); else xcd_barrier(xbar); } } while (0)
    if (IN(0)) p0_prologue(c);
    SEAM(0);
    if (IN(1)) {
        DenseBf16<14, 0> g{}; g.nt = 16; g.kstepA = 128; g.ldb = DM; g.G = c.G; g.c = c.bid; g.n_rt = T_TOK / BM;
        g.A = c.xn(); g.lda = DM; g.Bt = c.wcat(); g.O = c.proj(); g.ldo = NPROJ; g.bias0 = nullptr; g.bias1 = nullptr; g.bsplit = 0; g.bend = 0;
        gemm_phase(c.lds, g);
    }
    SEAM(1);
    if (IN(2)) {
        p2_prep(c);
        CmpGemm g{}; g.nt = 32; g.kstepA = NPROJ * 2; g.ldb = 2048; g.G = c.G; g.c = c.bid;
        g.proj = c.proj(); g.cw1t = c.cw1t(); g.hid = c.hid(); g.biasc = c.biasc();
        gemm_phase(c.lds, g);
    }
    SEAM(2);
    if (IN(3)) {
        DenseBf16<6, 0> g{}; g.nt = 4; g.kstepA = 128; g.ldb = 256; g.G = c.G; g.c = c.bid; g.n_rt = T_TOK / BM;
        g.A = c.lact(); g.lda = 256; g.Bt = c.wl2t(); g.O = c.lout(); g.ldo = 1536; g.bias0 = c.in(I_W0); g.bias1 = c.in(I_A0); g.bsplit = 512; g.bend = 1024;
        gemm_phase(c.lds, g);
        p3_cmp_finish(c);
    }
    SEAM(3);
    if (IN(4)) {
        for (int rep = 0; rep < 1 + ((REP >> 16) & 1); ++rep) if ((PH_MASK >> 16) & 1) for (int ch = c.bid; ch < NBATCH * 8; ch += c.G) { if (SCAN_V2 == 2) scan_chain3(c, ch); else if (SCAN_V2 == 1) scan_chain2(c, ch); else scan_chain(c, ch); }
        for (int rep = 0; rep < 1 + ((REP >> 17) & 1); ++rep) if ((PH_MASK >> 17) & 1) for (int it = c.bid; it < NBATCH * 2 * 32; it += c.G) attn_item(c, it);
    }
    SEAM(4);
    if (IN(5)) {
        p5_moe_weights(c);
        OutProj g{}; g.nt = 16; g.kstepA = 128; g.ldb = DM; g.G = c.G; g.c = c.bid; g.A = c.xn(); g.Bt = c.woutt(); g.x = c.in(I_X); g.out = c.out;
        gemm_phase(c.lds, g);
    }
    SEAM(5);
    if (IN(6)) p6_router(c, a.dry);
    SEAM(6);
    if (IN(7)) {
        Moe1 g{}; g.nt = 8; g.kstepA = 128; g.ldb = DM / 2; g.G = c.G; g.c = c.bid; g.dir = moe_dir_build(c);
        g.h = c.h8(); g.w1t = c.w1t(); g.b1 = c.in(I_MB1); g.ids = c.ids(); g.rsl = c.rsl(); g.act = c.act();
        gemm_phase_gather(c.lds, g);
    }
    SEAM(7);
    if (IN(8)) {
        Moe2 g{}; g.nt = 8; g.kstepA = 128; g.ldb = DFF / 2; g.G = c.G; g.c = c.bid; g.dir = moe_dir_build(c);
        g.act = c.act(); g.w2t = c.w2t(); g.b2 = c.in(I_MB2); g.ws = c.ws;
        gemm_phase(c.lds, g);
    }
    SEAM(8);
    if (IN(9)) { const MoeDir d = moe_dir_build(c); p9_combine(c, d, (a.dry || (ABL & 4)) ? 0.f : 1.f); }
#undef IN
#undef SEAM
}

#ifndef HOST_SEQ
#define HOST_SEQ 0,1,2,3,4,5,6,7,8,9
#endif
#ifndef MK_MULTI
#define MK_MULTI 0
#endif
#ifndef HOST_REP
#define HOST_REP 0x8
#endif
constexpr int N_PHASES = 10;
extern "C" void kernel_launch(void* const* d_in, const int* in_sizes, int n_in, void* d_out, int out_size, void* d_ws, size_t ws_size, hipStream_t stream) {
    static int grid = 0;
    if (grid == 0) {
        if (n_in != 31 || out_size != T_TOK * DM || ws_size < WS_END) { fprintf(stderr, "kernel_launch: unexpected shapes: n_in %d out %d ws %zu (need %zu)\n", n_in, out_size, ws_size, (size_t)WS_END); grid = -1; return; }
        int dev = 0, cus = 0, per_cu = 0;
        (void)hipGetDevice(&dev); (void)hipDeviceGetAttribute(&cus, hipDeviceAttributeMultiprocessorCount, dev);
        if (hipFuncSetAttribute((const void*)fwd_kernel, hipFuncAttributeMaxDynamicSharedMemorySize, LDS_BYTES) != hipSuccess) { fprintf(stderr, "kernel_launch: hipFuncSetAttribute failed\n"); grid = -1; return; }
        if (hipOccupancyMaxActiveBlocksPerMultiprocessor(&per_cu, (const void*)fwd_kernel, NTHREADS, LDS_BYTES) != hipSuccess || per_cu < 1) { fprintf(stderr, "kernel_launch: occupancy query says %d blocks per CU\n", per_cu); grid = -1; return; }
        grid = cus * 1;
        fprintf(stderr, "kernel_launch: cus %d per_cu %d grid %d\n", cus, per_cu, grid);
    }
    if (grid < 0) return;
    Args a{};
    for (int i = 0; i < 31; ++i) a.in[i] = (const float*)d_in[i];
    a.out = (float*)d_out; a.ws = (unsigned char*)d_ws; a.dry = 0;
#if MK_MULTI
    static const int seq[] = {HOST_SEQ};
    for (unsigned i = 0; i < sizeof(seq) / sizeof(seq[0]); ++i) { const int p = seq[i] % 100; a.ph_lo = p; a.ph_hi = p + 1; a.coop = 0; a.dry = seq[i] >= 100; hipLaunchKernelGGL(fwd_kernel, dim3(grid), dim3(NTHREADS), LDS_BYTES, stream, a); }
#else
    a.ph_lo = 0; a.ph_hi = N_PHASES; a.coop = 1;
    if (hipMemsetAsync((char*)d_ws + WS_BAR, 0, XCD_BAR_WORDS * sizeof(unsigned), stream) != hipSuccess) { fprintf(stderr, "kernel_launch: hipMemsetAsync of the barrier words failed\n"); return; }
    void* args[] = {&a};
    hipError_t e = hipLaunchCooperativeKernel((const void*)fwd_kernel, dim3(grid), dim3(NTHREADS), args, LDS_BYTES, stream);
    if (e != hipSuccess) fprintf(stderr, "kernel_launch: cooperative launch failed: %s (grid %d)\n", hipGetErrorString(e), grid);
#endif
}
```

```cpp
#include <hip/hip_runtime.h>
#include <hip/hip_cooperative_groups.h>
#include <cstdio>
#include <cstdint>
namespace cg = cooperative_groups;

#define LAS __attribute__((address_space(3)))
#define DI __device__ __forceinline__
typedef unsigned short bf16_t;
typedef short bf16x8 __attribute__((ext_vector_type(8)));
typedef float f32x4 __attribute__((ext_vector_type(4)));
typedef float f32x2 __attribute__((ext_vector_type(2)));
typedef float f32x16 __attribute__((ext_vector_type(16)));
typedef unsigned u32x4 __attribute__((ext_vector_type(4)));
typedef unsigned u32x2 __attribute__((ext_vector_type(2)));

#ifndef ABL
#define ABL 0
#endif
#ifndef SCAN_V2
#define SCAN_V2 2
#endif
#ifndef REP
#define REP 0
#endif
constexpr int T_TOK = 65536, SEQ = 2048, NBATCH = 32, DM = 1024;
constexpr int NPROJ = 3584;
constexpr int C_R = 0, C_K = 512, C_V = 1024, C_Q = 1536, C_KC = 2048, C_VC = 2176, C_KS = 2304, C_VS = 2432, C_KW = 2560, C_VW = 2688, C_GL = 2816;
constexpr int N_IN_REAL = 2840, C_L1 = 2840, C_L2 = 3096, C_LEND = 3352;
constexpr int NEXP = 32, DFF = 1024;
constexpr int NTHREADS = 512;
constexpr int LDS_BYTES = 160 * 1024;

constexpr size_t MiB = 1ull << 20;
constexpr size_t WS_XN = 0;
constexpr size_t WS_PROJ = 128 * MiB;
constexpr size_t WS_KSR = 576 * MiB;
constexpr size_t WS_KWR = 592 * MiB;
constexpr size_t WS_VST = 608 * MiB;
constexpr size_t WS_VWT = 624 * MiB;
constexpr size_t WS_LOUT = 640 * MiB;
constexpr size_t WS_LACT = 832 * MiB;
constexpr size_t WS_WCAT = 864 * MiB;
constexpr size_t WS_WOUT = 871 * MiB;
constexpr size_t WS_CW1 = 873 * MiB;
constexpr size_t WS_WL2 = 875 * MiB;
constexpr size_t WS_HID = 876 * MiB;
constexpr size_t WS_KCMP = 884 * MiB;
constexpr size_t WS_VCMPT = 885 * MiB;
constexpr size_t WS_ROPE = 886 * MiB;
constexpr size_t WS_BIASC = 887 * MiB;
constexpr size_t WS_RSL = 968 * MiB;
constexpr size_t WS_CTL = 1000 * MiB;
constexpr size_t WS_WRT = 886 * MiB + 524288;
constexpr size_t WS_IDS = 904 * MiB;
constexpr size_t WS_GTS = 936 * MiB;
constexpr size_t WS_W1T = 128 * MiB;
constexpr size_t WS_W2T = 192 * MiB;
constexpr size_t WS_ACT = 320 * MiB;
constexpr size_t WS_TP = 1001 * MiB;
constexpr size_t WS_TG = 1002 * MiB;
constexpr size_t WS_BAR = 1003 * MiB;
constexpr size_t WS_END = 1004 * MiB;
#define DI_EARLY __device__ __forceinline__
DI_EARLY size_t y_row_off(int r) { return r < 98304 ? (size_t)r * 2048 : (r < 147456 ? 224 * MiB + (size_t)(r - 98304) * 2048 : 608 * MiB + (size_t)(r - 147456) * 2048); }

struct Args {
    const float* in[31];
    float* out;
    unsigned char* ws;
    int ph_lo, ph_hi, coop, dry;
};

DI float bf2f(bf16_t b) { return __uint_as_float(((unsigned)b) << 16); }
typedef __bf16 bf16v2_t __attribute__((ext_vector_type(2)));
DI unsigned cvt_pk_bf16(float lo, float hi) { f32x2 v = {lo, hi}; bf16v2_t r = __builtin_convertvector(v, bf16v2_t); return __builtin_bit_cast(unsigned, r); }
DI bf16_t f2bf(float f) { return (bf16_t)(cvt_pk_bf16(f, 0.f) & 0xffffu); }
DI float bflo(unsigned u) { return __uint_as_float(u << 16); }
DI float bfhi(unsigned u) { return __uint_as_float(u & 0xffff0000u); }
DI float wave_sum(float v) { for (int o = 32; o > 0; o >>= 1) v += __shfl_xor(v, o); return v; }
template <int CTRL> DI float dppmov(float x) { return __int_as_float(__builtin_amdgcn_update_dpp(0, __float_as_int(x), CTRL, 0xf, 0xf, true)); }
DI float red8(float x) { x += dppmov<0xB1>(x); x += dppmov<0x4E>(x); x += dppmov<0x141>(x); return x; }
DI float red16(float x) { x = red8(x); x += dppmov<0x140>(x); return x; }
DI float sigmoidf_(float x) { return 1.0f / (1.0f + __expf(-x)); }
DI float tanhf_(float x) { float e = __expf(2.0f * x); return 1.0f - 2.0f / (e + 1.0f); }
DI float gelu_tanh(float x) { float u = 0.7978845608028654f * (x + 0.044715f * x * x * x); return 0.5f * x * (1.0f + tanhf_(u)); }

constexpr int BM = 256, BK = 64, HALF = 128, HTB = HALF * BK * 2, STAGE_BYTES = 8 * HTB;
constexpr int AUX_OFF = STAGE_BYTES + 4096, AUX_SLOT = 3072;
DI int lds_byte(int r, int c) { const int st = (r >> 4) * 2 + (c >> 5), rr = r & 15, cc = c & 31, ob = rr * 64 + cc * 2; return st * 1024 + (ob ^ (((ob >> 9) & 1) << 5)); }
DI void stage_rc(int b, int& R, int& C) { const int st = b / 1024, sb = b % 1024, swz = sb ^ (((sb >> 9) & 1) << 5); R = (st >> 1) * 16 + swz / 64; C = (st & 1) * 32 + (swz % 64) / 2; }
DI int perm32(int rho) { const int n = rho >> 4, i = rho & 15; return 8 * (i >> 2) + 4 * n + (i & 3); }

typedef int v8i_t __attribute__((ext_vector_type(8)));
typedef int v4i_t __attribute__((ext_vector_type(4)));
template <bool FP8> struct FragT;
template <> struct FragT<false> { bf16x8 k[2]; };
template <> struct FragT<true> { v8i_t v; };
DI void ld_frag(FragT<false>& f, const LAS unsigned char* p0, const LAS unsigned char* p1) { f.k[0] = *(const LAS bf16x8*)p0; f.k[1] = *(const LAS bf16x8*)p1; }
DI void ld_frag(FragT<true>& f, const LAS unsigned char* p0, const LAS unsigned char* p1) { const v4i_t lo = *(const LAS v4i_t*)p0, hi = *(const LAS v4i_t*)p1; f.v = __builtin_shufflevector(lo, hi, 0, 1, 2, 3, 4, 5, 6, 7); }
DI f32x4 mma_frag(const FragT<false>& b, const FragT<false>& a, f32x4 cacc) { cacc = __builtin_amdgcn_mfma_f32_16x16x32_bf16(b.k[0], a.k[0], cacc, 0, 0, 0); return __builtin_amdgcn_mfma_f32_16x16x32_bf16(b.k[1], a.k[1], cacc, 0, 0, 0); }
DI f32x4 mma_frag(const FragT<true>& b, const FragT<true>& a, f32x4 cacc) {
    const int sc = 0x7f7f7f7f;
    asm volatile("v_mfma_scale_f32_16x16x128_f8f6f4 %0, %1, %2, %0, %3, %3 op_sel_hi:[0,0,0]" : "+v"(cacc) : "v"(b.v), "v"(a.v), "v"(sc));
    return cacc;
}
DI unsigned cvt4_fp8(float a, float b, float cc, float d) { unsigned w = 0; w = __builtin_amdgcn_cvt_pk_fp8_f32(a, b, w, false); w = __builtin_amdgcn_cvt_pk_fp8_f32(cc, d, w, true); return w; }
struct Unit { int rt, pn, e, rl; };

template <class P>
DI void gemm_phase(LAS unsigned char* lds, const P& S) {
    const int tid = threadIdx.x, wid = __builtin_amdgcn_readfirstlane(tid >> 6), lane = tid & 63, wr = wid >> 2, wc = wid & 3, fr = lane & 15, fq = lane >> 4;
    const int nt = S.nt;
    int R[2], C[2]; unsigned voffB[2];
#pragma unroll
    for (int i = 0; i < 2; ++i) { stage_rc(tid * 16 + i * 8192, R[i], C[i]); const int Rb = P::PERM ? ((R[i] & ~31) + perm32(R[i] & 31)) : R[i]; voffB[i] = (unsigned)(Rb * S.ldb + C[i]) * 2u; }
    const size_t kstepA = (size_t)S.kstepA, kstepB = (size_t)(BK * 2);
    const size_t hstepB = (size_t)HALF * S.ldb * 2;
    const unsigned ldsw = (unsigned)wid * 1024u;
    const int aoff0 = lds_byte(wr * 64 + fr, fq * 8), aoff1 = aoff0 + 1024;
    const int boff0 = lds_byte(wc * 32 + fr, fq * 8), boff1 = boff0 + 1024;
#define G_SA(b, h) (((b) * 2 + (h)) * HTB)
#define G_SB(b, h) ((4 + (b) * 2 + (h)) * HTB)
#define G_STAGE(bufoff, gbase, voff) do { _Pragma("unroll") for (int _i = 0; _i < 2; ++_i) \
        __builtin_amdgcn_global_load_lds((const unsigned*)((const char*)(gbase) + (voff)[_i]), (LAS unsigned*)(lds + (bufoff) + ldsw + _i * 8192), 16, 0, 0); } while (0)
#define G_LDA(dst, b, h) do { _Pragma("unroll") for (int m = 0; m < 4; ++m) ld_frag(dst[m], lds + G_SA(b, h) + aoff0 + m * 2048, lds + G_SA(b, h) + aoff1 + m * 2048); } while (0)
#define G_LDB(dst, b, h) do { _Pragma("unroll") for (int n = 0; n < 2; ++n) ld_frag(dst[n], lds + G_SB(b, h) + boff0 + n * 2048, lds + G_SB(b, h) + boff1 + n * 2048); } while (0)
#define G_MMA(ai, bj, At, Bt) do { __builtin_amdgcn_s_setprio(1); _Pragma("unroll") for (int m = 0; m < 4; ++m) _Pragma("unroll") for (int n = 0; n < 2; ++n) \
        acc[ai][bj][m][n] = mma_frag(Bt[n], At[m], acc[ai][bj][m][n]); __builtin_amdgcn_s_setprio(0); } while (0)
#define G_WAIT_V(n) asm volatile("s_waitcnt vmcnt(" #n ")" ::: "memory")
#define G_WAIT_L(n) asm volatile("s_waitcnt lgkmcnt(" #n ")" ::: "memory")
#define G_BAR __builtin_amdgcn_s_barrier()
#define G_SCHED __builtin_amdgcn_sched_barrier(0)
    Unit cur, nxt; int ui = 0;
    if (!S.next(0, cur)) return;
    f32x4 acc[2][2][4][2];
#pragma unroll
    for (int a = 0; a < 2; ++a)
#pragma unroll
        for (int b = 0; b < 2; ++b)
#pragma unroll
            for (int m = 0; m < 4; ++m)
#pragma unroll
                for (int n = 0; n < 2; ++n) acc[a][b][m][n] = (f32x4){0.f, 0.f, 0.f, 0.f};
    FragT<P::FP8> At[4], B0[2], B1[2];
    const char* cA; unsigned coff[2][2];
    S.a_src(cur, R, C, cA, coff);
    const char* cB = S.b_src(cur);
    if constexpr (P::AUX) S.aux_issue(cur, lds + AUX_OFF, lane);
    G_STAGE(G_SB(0, 0), cB, voffB); G_STAGE(G_SB(0, 1), cB + hstepB, voffB); G_STAGE(G_SA(0, 0), cA, coff[0]); G_STAGE(G_SA(0, 1), cA, coff[1]);
    if (wr == 1) G_BAR;
    G_WAIT_V(2); G_BAR;
    G_STAGE(G_SB(1, 0), cB + kstepB, voffB); G_STAGE(G_SA(1, 0), cA + kstepA, coff[0]); G_STAGE(G_SB(1, 1), cB + hstepB + kstepB, voffB);
    G_WAIT_V(6); G_BAR;
    for (;;) {
        const bool has_next = S.next(ui + 1, nxt);
        const char* nA = cA; unsigned noff[2][2] = {{coff[0][0], coff[0][1]}, {coff[1][0], coff[1][1]}}; const char* nB = cB;
        if (has_next) { S.a_src(nxt, R, C, nA, noff); nB = S.b_src(nxt); }
        for (int t = 0; t < nt; t += 2) {
            const bool last = (t == nt - 2);
            const char* a1 = cA + (size_t)(t + 1) * kstepA;
            const char* a2 = last ? nA : cA + (size_t)(t + 2) * kstepA; const char* b2 = last ? nB : cB + (size_t)(t + 2) * kstepB;
            const char* a3 = a2 + kstepA; const char* b3 = b2 + kstepB;
            unsigned o2[2][2]; const unsigned lmask = last ? 0xffffffffu : 0u;
#pragma unroll
            for (int h = 0; h < 2; ++h)
#pragma unroll
                for (int i = 0; i < 2; ++i) o2[h][i] = coff[h][i] ^ ((coff[h][i] ^ noff[h][i]) & lmask);
            G_LDB(B0, 0, 0); G_LDB(B1, 0, 1); G_SCHED; G_LDA(At, 0, 0); G_STAGE(G_SA(1, 1), a1, coff[1]);
            G_WAIT_V(8); G_WAIT_L(0); G_BAR; G_MMA(0, 0, At, B0); G_MMA(0, 1, At, B1); G_BAR; G_SCHED;
            G_LDA(At, 0, 1); G_STAGE(G_SB(0, 0), b2, voffB); G_STAGE(G_SB(0, 1), b2 + hstepB, voffB); G_STAGE(G_SA(0, 0), a2, o2[0]);
            G_WAIT_V(8); G_WAIT_L(0); G_BAR; G_MMA(1, 0, At, B0); G_MMA(1, 1, At, B1); G_BAR; G_SCHED;
            G_LDB(B0, 1, 0); G_LDB(B1, 1, 1); G_SCHED; G_LDA(At, 1, 0); G_STAGE(G_SA(0, 1), a2, o2[1]);
            G_WAIT_V(8); G_WAIT_L(0); G_BAR; G_MMA(0, 0, At, B0); G_MMA(0, 1, At, B1); G_BAR; G_SCHED;
            G_LDA(At, 1, 1); G_STAGE(G_SB(1, 0), b3, voffB); G_STAGE(G_SB(1, 1), b3 + hstepB, voffB); G_STAGE(G_SA(1, 0), a3, o2[0]);
            G_WAIT_V(8); G_WAIT_L(0); G_BAR; G_MMA(1, 0, At, B0); G_MMA(1, 1, At, B1); G_BAR; G_SCHED;
        }
        if (wr == 0) G_BAR;
        if (P::FP8) asm volatile("s_nop 15\n\ts_nop 15" ::: "memory");
        S.epi(acc, cur, wr, wc, fr, fq, lds + AUX_OFF + (ui & 1) * AUX_SLOT);
        if (!has_next) break;
#pragma unroll
        for (int a = 0; a < 2; ++a)
#pragma unroll
            for (int b = 0; b < 2; ++b)
#pragma unroll
                for (int m = 0; m < 4; ++m)
#pragma unroll
                    for (int n = 0; n < 2; ++n) acc[a][b][m][n] = (f32x4){0.f, 0.f, 0.f, 0.f};
        if (P::FP8) asm volatile("s_nop 7" ::: "memory");
        cur = nxt; cA = nA; cB = nB; ++ui;
        if constexpr (P::AUX) S.aux_issue(cur, lds + AUX_OFF + (ui & 1) * AUX_SLOT, lane);
        if (wr == 1) G_BAR;
#pragma unroll
        for (int h = 0; h < 2; ++h)
#pragma unroll
            for (int i = 0; i < 2; ++i) coff[h][i] = noff[h][i];
    }
    G_WAIT_V(0);
    G_BAR;
#undef G_SA
#undef G_SB
#undef G_STAGE
#undef G_LDA
#undef G_LDB
#undef G_MMA
#undef G_WAIT_V
#undef G_WAIT_L
#undef G_BAR
#undef G_SCHED
}

template <class P>
DI void gemm_phase_gather(LAS unsigned char* lds, const P& S) {
    const int tid = threadIdx.x, wid = __builtin_amdgcn_readfirstlane(tid >> 6), lane = tid & 63, wr = wid >> 2, wc = wid & 3, fr = lane & 15, fq = lane >> 4;
    const int nt = S.nt;
    int R[2], C[2]; unsigned voffB[2];
#pragma unroll
    for (int i = 0; i < 2; ++i) { stage_rc(tid * 16 + i * 8192, R[i], C[i]); const int Rb = P::PERM ? ((R[i] & ~31) + perm32(R[i] & 31)) : R[i]; voffB[i] = (unsigned)(Rb * S.ldb + C[i]) * 2u; }
    const size_t kstepA = (size_t)S.kstepA, kstepB = (size_t)(BK * 2);
    const size_t hstepB = (size_t)HALF * S.ldb * 2;
    const unsigned ldsw = (unsigned)wid * 1024u;
    const int aoff0 = lds_byte(wr * 64 + fr, fq * 8), aoff1 = aoff0 + 1024;
    const int boff0 = lds_byte(wc * 32 + fr, fq * 8), boff1 = boff0 + 1024;
#define G_SA(b, h) (((b) * 2 + (h)) * HTB)
#define G_SB(b, h) ((4 + (b) * 2 + (h)) * HTB)
#define G_STAGE(bufoff, gbase, voff) do { _Pragma("unroll") for (int _i = 0; _i < 2; ++_i) \
        __builtin_amdgcn_global_load_lds((const unsigned*)((const char*)(gbase) + (voff)[_i]), (LAS unsigned*)(lds + (bufoff) + ldsw + _i * 8192), 16, 0, 0); } while (0)
#define G_LDA(dst, b, h) do { _Pragma("unroll") for (int m = 0; m < 4; ++m) ld_frag(dst[m], lds + G_SA(b, h) + aoff0 + m * 2048, lds + G_SA(b, h) + aoff1 + m * 2048); } while (0)
#define G_LDB(dst, b, h) do { _Pragma("unroll") for (int n = 0; n < 2; ++n) ld_frag(dst[n], lds + G_SB(b, h) + boff0 + n * 2048, lds + G_SB(b, h) + boff1 + n * 2048); } while (0)
#define G_MMA(ai, bj, At, Bt) do { __builtin_amdgcn_s_setprio(1); _Pragma("unroll") for (int m = 0; m < 4; ++m) _Pragma("unroll") for (int n = 0; n < 2; ++n) \
        acc[ai][bj][m][n] = mma_frag(Bt[n], At[m], acc[ai][bj][m][n]); __builtin_amdgcn_s_setprio(0); } while (0)
#define G_WAIT_V(n) asm volatile("s_waitcnt vmcnt(" #n ")" ::: "memory")
#define G_WAIT_L(n) asm volatile("s_waitcnt lgkmcnt(" #n ")" ::: "memory")
#define G_BAR __builtin_amdgcn_s_barrier()
#define G_SCHED __builtin_amdgcn_sched_barrier(0)
    Unit cur, nxt; int ui = 0;
    if (!S.next(0, cur)) return;
    f32x4 acc[2][2][4][2];
#pragma unroll
    for (int a = 0; a < 2; ++a)
#pragma unroll
        for (int b = 0; b < 2; ++b)
#pragma unroll
            for (int m = 0; m < 4; ++m)
#pragma unroll
                for (int n = 0; n < 2; ++n) acc[a][b][m][n] = (f32x4){0.f, 0.f, 0.f, 0.f};
    FragT<P::FP8> At[4], B0[2], B1[2];
    const char* cA = S.a_base(cur);
    const char* cB = S.b_src(cur);
    S.ids_issue(cur, lds + AUX_OFF + 2048, lane); S.aux_issue(cur, lds + AUX_OFF, lane);
    G_WAIT_V(0);
    int crl = cur.rl, ccn = S.dir.cnt[cur.e];
#define G_AOFF(dst, slot_, rl_, cn_, h_) do { _Pragma("unroll") for (int _i = 0; _i < 2; ++_i) { const int _r = (h_) * HALF + R[_i]; int _t = ((const LAS int*)(slot_))[_r]; _t = ((rl_) * BM + _r) < (cn_) ? _t : 0; dst[_i] = (unsigned)(_t * DM + C[_i] * 2); } } while (0)
    unsigned ao[2];
    { const LAS unsigned char* s0 = lds + AUX_OFF + 2048; G_STAGE(G_SB(0, 0), cB, voffB); G_STAGE(G_SB(0, 1), cB + hstepB, voffB); G_AOFF(ao, s0, crl, ccn, 0); G_STAGE(G_SA(0, 0), cA, ao); G_AOFF(ao, s0, crl, ccn, 1); G_STAGE(G_SA(0, 1), cA, ao); }
    if (wr == 1) G_BAR;
    G_WAIT_V(2); G_BAR;
    { const LAS unsigned char* s0 = lds + AUX_OFF + 2048; G_STAGE(G_SB(1, 0), cB + kstepB, voffB); G_AOFF(ao, s0, crl, ccn, 0); G_STAGE(G_SA(1, 0), cA + kstepA, ao); G_STAGE(G_SB(1, 1), cB + hstepB + kstepB, voffB); }
    G_WAIT_V(6); G_BAR;
    for (;;) {
        const bool has_next = S.next(ui + 1, nxt);
        const char* nA = cA; const char* nB = cB; int nrl = crl, ncn = ccn;
        const LAS unsigned char* slc = lds + AUX_OFF + (ui & 1) * AUX_SLOT + 2048; const LAS unsigned char* sln = lds + AUX_OFF + ((ui + 1) & 1) * AUX_SLOT + 2048;
        if (has_next) { nA = S.a_base(nxt); nB = S.b_src(nxt); nrl = nxt.rl; ncn = S.dir.cnt[nxt.e]; S.ids_issue(nxt, lds + AUX_OFF + ((ui + 1) & 1) * AUX_SLOT + 2048, lane); }
        for (int t = 0; t < nt; t += 2) {
            const bool last = (t == nt - 2);
            const char* a1 = cA + (size_t)(t + 1) * kstepA;
            const char* a2 = last ? nA : cA + (size_t)(t + 2) * kstepA; const char* b2 = last ? nB : cB + (size_t)(t + 2) * kstepB;
            const char* a3 = a2 + kstepA; const char* b3 = b2 + kstepB;
            const LAS unsigned char* sl2 = (last && has_next) ? sln : slc; const int rl2 = (last && has_next) ? nrl : crl, cn2 = (last && has_next) ? ncn : ccn;
            G_LDB(B0, 0, 0); G_LDB(B1, 0, 1); G_SCHED; G_LDA(At, 0, 0); G_AOFF(ao, slc, crl, ccn, 1); G_STAGE(G_SA(1, 1), a1, ao);
            G_WAIT_V(8); G_WAIT_L(0); G_BAR; G_MMA(0, 0, At, B0); G_MMA(0, 1, At, B1); G_BAR; G_SCHED;
            G_LDA(At, 0, 1); G_STAGE(G_SB(0, 0), b2, voffB); G_STAGE(G_SB(0, 1), b2 + hstepB, voffB); G_AOFF(ao, sl2, rl2, cn2, 0); G_STAGE(G_SA(0, 0), a2, ao);
            G_WAIT_V(8); G_WAIT_L(0); G_BAR; G_MMA(1, 0, At, B0); G_MMA(1, 1, At, B1); G_BAR; G_SCHED;
            G_LDB(B0, 1, 0); G_LDB(B1, 1, 1); G_SCHED; G_LDA(At, 1, 0); G_AOFF(ao, sl2, rl2, cn2, 1); G_STAGE(G_SA(0, 1), a2, ao);
            G_WAIT_V(8); G_WAIT_L(0); G_BAR; G_MMA(0, 0, At, B0); G_MMA(0, 1, At, B1); G_BAR; G_SCHED;
            G_LDA(At, 1, 1); G_STAGE(G_SB(1, 0), b3, voffB); G_STAGE(G_SB(1, 1), b3 + hstepB, voffB); G_AOFF(ao, sl2, rl2, cn2, 0); G_STAGE(G_SA(1, 0), a3, ao);
            G_WAIT_V(8); G_WAIT_L(0); G_BAR; G_MMA(1, 0, At, B0); G_MMA(1, 1, At, B1); G_BAR; G_SCHED;
        }
        if (wr == 0) G_BAR;
        if (P::FP8) asm volatile("s_nop 15\n\ts_nop 15" ::: "memory");
        S.epi(acc, cur, wr, wc, fr, fq, lds + AUX_OFF + (ui & 1) * AUX_SLOT);
        if (!has_next) break;
#pragma unroll
        for (int a = 0; a < 2; ++a)
#pragma unroll
            for (int b = 0; b < 2; ++b)
#pragma unroll
                for (int m = 0; m < 4; ++m)
#pragma unroll
                    for (int n = 0; n < 2; ++n) acc[a][b][m][n] = (f32x4){0.f, 0.f, 0.f, 0.f};
        if (P::FP8) asm volatile("s_nop 7" ::: "memory");
        cur = nxt; cA = nA; cB = nB; ++ui;
        if constexpr (P::AUX) S.aux_issue(cur, lds + AUX_OFF + (ui & 1) * AUX_SLOT, lane);
        if (wr == 1) G_BAR;
        crl = nrl; ccn = ncn;
    }
    G_WAIT_V(0);
    G_BAR;
#undef G_AOFF
#undef G_SA
#undef G_SB
#undef G_STAGE
#undef G_LDA
#undef G_LDB
#undef G_MMA
#undef G_WAIT_V
#undef G_WAIT_L
#undef G_BAR
#undef G_SCHED
}

template <int NPN> DI bool unit_map(int i, int G, int c, int n_rt, Unit& u) {
    const int L = i * G + c, x = L & 7, q = L >> 3;
    u.rt = (q / NPN) * 8 + x; u.pn = q % NPN; u.e = 0; u.rl = 0;
    return u.rt < n_rt;
}

DI void store8_bf16(bf16_t* p, const f32x4& v0, const f32x4& v1) {
    u32x4 w; w.x = cvt_pk_bf16(v0[0], v0[1]); w.y = cvt_pk_bf16(v0[2], v0[3]); w.z = cvt_pk_bf16(v1[0], v1[1]); w.w = cvt_pk_bf16(v1[2], v1[3]);
    __builtin_nontemporal_store(w, (u32x4*)p);
}

template <int NPN, int ACT> struct DenseBf16 {
    static constexpr bool PERM = true, FP8 = false, AUX = false;
    int nt, kstepA, ldb; int G, c, n_rt;
    const bf16_t* A; int lda; const bf16_t* Bt; bf16_t* O; int ldo;
    const float* bias0; const float* bias1; int bsplit, bend;
    DI bool next(int i, Unit& u) const { return unit_map<NPN>(i, G, c, n_rt, u); }
    DI void a_src(const Unit& u, const int (&R)[2], const int (&C)[2], const char*& base, unsigned (&off)[2][2]) const {
        base = (const char*)(A + (size_t)u.rt * BM * lda);
#pragma unroll
        for (int h = 0; h < 2; ++h)
#pragma unroll
            for (int i = 0; i < 2; ++i) off[h][i] = (unsigned)((h * HALF + R[i]) * lda + C[i]) * 2u;
    }
    DI const char* b_src(const Unit& u) const { return (const char*)(Bt + (size_t)u.pn * BM * ldb); }
    DI float bias_at(int col) const { if (col < bsplit) return bias0 ? bias0[col] : 0.f; if (col < bend) return bias1 ? bias1[col - bsplit] : 0.f; return 0.f; }
    DI void epi(const f32x4 (&acc)[2][2][4][2], const Unit& u, int wr, int wc, int fr, int fq, const LAS unsigned char* aux) const {
        const int row0 = u.rt * BM + wr * 64 + fr, col0 = u.pn * BM + wc * 32 + 8 * fq;
#pragma unroll
        for (int bj = 0; bj < 2; ++bj) {
            f32x4 b0, b1;
#pragma unroll
            for (int j = 0; j < 4; ++j) { b0[j] = bias_at(col0 + bj * HALF + j); b1[j] = bias_at(col0 + bj * HALF + 4 + j); }
#pragma unroll
            for (int ai = 0; ai < 2; ++ai)
#pragma unroll
                for (int m = 0; m < 4; ++m) {
                    f32x4 v0 = acc[ai][bj][m][0] + b0, v1 = acc[ai][bj][m][1] + b1;
                    if (ACT == 1) {
#pragma unroll
                        for (int j = 0; j < 4; ++j) { v0[j] = gelu_tanh(v0[j]); v1[j] = gelu_tanh(v1[j]); }
                    }
                    store8_bf16(O + (size_t)(row0 + ai * HALF + m * 16) * ldo + col0 + bj * HALF, v0, v1);
                }
        }
    }
};

struct CmpGemm {
    static constexpr bool PERM = true, FP8 = false, AUX = false;
    int nt, kstepA, ldb; int G, c;
    const bf16_t* proj; const bf16_t* cw1t; bf16_t* hid; const float* biasc;
    DI bool next(int i, Unit& u) const { const int L = i * G + c; u.e = L & 1; u.rt = L >> 1; u.pn = 0; u.rl = 0; return L < 64; }
    DI void a_src(const Unit& u, const int (&R)[2], const int (&C)[2], const char*& base, unsigned (&off)[2][2]) const {
        base = (const char*)proj;
#pragma unroll
        for (int h = 0; h < 2; ++h)
#pragma unroll
            for (int i = 0; i < 2; ++i) {
                const int m = u.rt * BM + h * HALF + R[i], b = m >> 8, kvh = (m >> 7) & 1; int n = m & 127; n = n > 126 ? 126 : n;
                off[h][i] = (unsigned)(((size_t)(b * SEQ + n * 16) * NPROJ + (u.e ? C_VC : C_KC) + kvh * 64 + C[i]) * 2u);
            }
    }
    DI const char* b_src(const Unit& u) const { return (const char*)(cw1t + (size_t)u.e * 256 * 2048); }
    DI void epi(const f32x4 (&acc)[2][2][4][2], const Unit& u, int wr, int wc, int fr, int fq, const LAS unsigned char* aux) const {
        const int row0 = u.rt * BM + wr * 64 + fr, col0 = wc * 32 + 8 * fq;
        bf16_t* O = hid + (size_t)u.e * 8192 * 256; const float* bs = biasc + u.e * 256;
#pragma unroll
        for (int bj = 0; bj < 2; ++bj) {
            f32x4 b0 = *(const f32x4*)(bs + col0 + bj * HALF), b1 = *(const f32x4*)(bs + col0 + bj * HALF + 4);
#pragma unroll
            for (int ai = 0; ai < 2; ++ai)
#pragma unroll
                for (int m = 0; m < 4; ++m) {
                    f32x4 v0 = acc[ai][bj][m][0] + b0, v1 = acc[ai][bj][m][1] + b1;
#pragma unroll
                    for (int j = 0; j < 4; ++j) { v0[j] = gelu_tanh(v0[j]); v1[j] = gelu_tanh(v1[j]); }
                    store8_bf16(O + (size_t)(row0 + ai * HALF + m * 16) * 256 + col0 + bj * HALF, v0, v1);
                }
        }
    }
};

struct OutProj {
    static constexpr bool PERM = false, FP8 = false, AUX = false;
    int nt, kstepA, ldb; int G, c;
    const bf16_t* A; const bf16_t* Bt; const float* x; float* out;
    DI bool next(int i, Unit& u) const { return unit_map<4>(i, G, c, T_TOK / BM, u); }
    DI void a_src(const Unit& u, const int (&R)[2], const int (&C)[2], const char*& base, unsigned (&off)[2][2]) const {
        base = (const char*)(A + (size_t)u.rt * BM * DM);
#pragma unroll
        for (int h = 0; h < 2; ++h)
#pragma unroll
            for (int i = 0; i < 2; ++i) off[h][i] = (unsigned)((h * HALF + R[i]) * DM + C[i]) * 2u;
    }
    DI const char* b_src(const Unit& u) const { return (const char*)(Bt + (size_t)u.pn * BM * DM); }
    DI void epi(const f32x4 (&acc)[2][2][4][2], const Unit& u, int wr, int wc, int fr, int fq, const LAS unsigned char* aux) const {
        const int row0 = u.rt * BM + wr * 64 + fr, col0 = u.pn * BM + wc * 32 + 4 * fq;
#pragma unroll
        for (int ai = 0; ai < 2; ++ai)
#pragma unroll
            for (int m = 0; m < 4; ++m) {
                const size_t ro = (size_t)(row0 + ai * HALF + m * 16) * DM + col0;
#pragma unroll
                for (int bj = 0; bj < 2; ++bj)
#pragma unroll
                    for (int n = 0; n < 2; ++n) { const f32x4 xv = *(const f32x4*)(x + ro + bj * HALF + n * 16); *(f32x4*)(out + ro + bj * HALF + n * 16) = acc[ai][bj][m][n] + xv; }
            }
    }
};

constexpr int NLIST = NEXP;
struct MoeDir { const LAS int* pref; const LAS int* cnt; const LAS int* rpref; };
DI int dir_search(const LAS int* p, int n, int v) { int lo = 0, hi = n;
#pragma unroll 1
    while (hi - lo > 1) { const int mid = (lo + hi) >> 1; if (p[mid] <= v) lo = mid; else hi = mid; }
    return lo; }

struct Moe1 {
    static constexpr bool PERM = true, FP8 = true, AUX = true;
    int nt, kstepA, ldb; int G, c;
    MoeDir dir; const unsigned char* h; const unsigned char* w1t; const float* b1; const int* ids; const float* rsl; unsigned char* act;
    DI bool next(int i, Unit& u) const { if (!unit_map<8>(i, G, c, dir.pref[NLIST], u)) return false; u.e = dir_search(dir.pref, NLIST, u.rt); u.rl = u.rt - dir.pref[u.e]; return true; }
    DI void a_src(const Unit& u, const int (&R)[2], const int (&C)[2], const char*& base, unsigned (&off)[2][2]) const {
        base = (const char*)h; const int cn = dir.cnt[u.e];
#pragma unroll
        for (int hh = 0; hh < 2; ++hh)
#pragma unroll
            for (int i = 0; i < 2; ++i) { const int idx = u.rl * BM + hh * HALF + R[i]; const int tok = idx < cn ? ids[(size_t)u.e * T_TOK + idx] : 0; off[hh][i] = (unsigned)(tok * DM + C[i] * 2); }
    }
    DI const char* b_src(const Unit& u) const { return (const char*)(w1t + ((size_t)u.e * 2048 + (size_t)u.pn * BM) * DM); }
    DI const char* a_base(const Unit&) const { return (const char*)h; }
    DI void ids_issue(const Unit& u, LAS unsigned char* dst, int lane) const {
        __builtin_amdgcn_global_load_lds((const unsigned*)(ids + (size_t)u.e * T_TOK + (size_t)u.rl * BM + lane * 4), (LAS unsigned*)dst, 16, 0, 0);
    }
    DI void aux_issue(const Unit& u, LAS unsigned char* slot, int lane) const {
        const float* rsrc = rsl + (size_t)u.e * T_TOK + (size_t)u.rl * BM + lane * 4;
        const float* bsrc = b1 + (size_t)u.e * 2048 + (lane >> 5) * 1024 + u.pn * 128 + (lane & 31) * 4;
        __builtin_amdgcn_global_load_lds((const unsigned*)rsrc, (LAS unsigned*)slot, 16, 0, 0);
        __builtin_amdgcn_global_load_lds((const unsigned*)bsrc, (LAS unsigned*)(slot + 1024), 16, 0, 0);
    }
    DI void epi(const f32x4 (&acc)[2][2][4][2], const Unit& u, int wr, int wc, int fr, int fq, const LAS unsigned char* aux) const {
        const int row0 = u.rt * BM + wr * 64 + fr, cl = wc * 32 + 8 * fq;
        const LAS float* ars = (const LAS float*)aux; const LAS float* ab = ars + 256 + cl;
        const f32x4 g0 = *(const LAS f32x4*)ab, g1 = *(const LAS f32x4*)(ab + 4), l0 = *(const LAS f32x4*)(ab + 128), l1 = *(const LAS f32x4*)(ab + 132);
#pragma unroll
        for (int ai = 0; ai < 2; ++ai)
#pragma unroll
            for (int m = 0; m < 4; ++m) {
                f32x4 v[2];
                const float rs32 = ars[ai * HALF + wr * 64 + m * 16 + fr] * (1.0f / 32.0f);
#pragma unroll
                for (int n = 0; n < 2; ++n)
#pragma unroll
                    for (int j = 0; j < 4; ++j) {
                        float glu = acc[ai][0][m][n][j] * rs32 + (n ? g1[j] : g0[j]), lin = acc[ai][1][m][n][j] * rs32 + (n ? l1[j] : l0[j]);
                        glu = fminf(glu, 7.0f); lin = fminf(fmaxf(lin, -7.0f), 7.0f);
                        v[n][j] = glu * __builtin_amdgcn_rcpf(1.0f + __builtin_amdgcn_exp2f(-1.702f * 1.4426950408889634f * glu)) * (lin + 1.0f);
                    }
                { u32x2 w8; w8.x = cvt4_fp8(v[0][0], v[0][1], v[0][2], v[0][3]); w8.y = cvt4_fp8(v[1][0], v[1][1], v[1][2], v[1][3]); *(u32x2*)(act + (size_t)(row0 + ai * HALF + m * 16) * DFF + u.pn * 128 + cl) = w8; }
            }
    }
};

struct Moe2 {
    static constexpr bool PERM = true, FP8 = true, AUX = true;
    int nt, kstepA, ldb; int G, c;
    MoeDir dir; const unsigned char* act; const unsigned char* w2t; const float* b2; unsigned char* ws;
    DI bool next(int i, Unit& u) const { if (!unit_map<4>(i, G, c, dir.pref[NLIST], u)) return false; u.e = dir_search(dir.pref, NLIST, u.rt); u.rl = u.rt - dir.pref[u.e]; return true; }
    DI void a_src(const Unit& u, const int (&R)[2], const int (&C)[2], const char*& base, unsigned (&off)[2][2]) const {
        base = (const char*)(act + (size_t)u.rt * BM * DFF);
#pragma unroll
        for (int h = 0; h < 2; ++h)
#pragma unroll
            for (int i = 0; i < 2; ++i) off[h][i] = (unsigned)((h * HALF + R[i]) * DFF + C[i] * 2);
    }
    DI const char* b_src(const Unit& u) const { return (const char*)(w2t + ((size_t)u.e * 1024 + (size_t)u.pn * BM) * DFF); }
    DI void aux_issue(const Unit& u, LAS unsigned char* slot, int lane) const {
        __builtin_amdgcn_global_load_lds((const unsigned*)(b2 + (size_t)u.e * DM + u.pn * BM + lane * 4), (LAS unsigned*)slot, 16, 0, 0);
    }
    DI void epi(const f32x4 (&acc)[2][2][4][2], const Unit& u, int wr, int wc, int fr, int fq, const LAS unsigned char* aux) const {
        const int row0 = u.rt * BM + wr * 64 + fr, col0 = u.pn * BM + wc * 32 + 8 * fq;
#pragma unroll
        for (int bj = 0; bj < 2; ++bj) {
            const LAS float* ab = (const LAS float*)aux + wc * 32 + 8 * fq + bj * HALF; const f32x4 b0 = *(const LAS f32x4*)ab, b1 = *(const LAS f32x4*)(ab + 4);
#pragma unroll
            for (int ai = 0; ai < 2; ++ai)
#pragma unroll
                for (int m = 0; m < 4; ++m) {
                    const f32x4 v0 = acc[ai][bj][m][0] * (1.0f / 32.0f) + b0, v1 = acc[ai][bj][m][1] * (1.0f / 32.0f) + b1;
                    store8_bf16((bf16_t*)(ws + y_row_off(row0 + ai * HALF + m * 16)) + col0 + bj * HALF, v0, v1);
                }
        }
    }
};

struct Ctx {
#if defined(__HIP_DEVICE_COMPILE__)
    const __constant__ void* kargs;
#else
    const void* kargs;
#endif
    float* out; unsigned char* ws;
    LAS unsigned char* lds; int tid, lane, wave, G, bid;
    DI const float* in(int k) const {
#if defined(__HIP_DEVICE_COMPILE__)
        return ((const float* const __constant__*)kargs)[k];
#else
        return nullptr;
#endif
    }
    DI bf16_t* xn() const { return (bf16_t*)(ws + WS_XN); }
    DI bf16_t* proj() const { return (bf16_t*)(ws + WS_PROJ); }
    DI bf16_t* ksr() const { return (bf16_t*)(ws + WS_KSR); }
    DI bf16_t* kwr() const { return (bf16_t*)(ws + WS_KWR); }
    DI bf16_t* vst() const { return (bf16_t*)(ws + WS_VST); }
    DI bf16_t* vwt() const { return (bf16_t*)(ws + WS_VWT); }
    DI bf16_t* lout() const { return (bf16_t*)(ws + WS_LOUT); }
    DI bf16_t* lact() const { return (bf16_t*)(ws + WS_LACT); }
    DI bf16_t* wcat() const { return (bf16_t*)(ws + WS_WCAT); }
    DI bf16_t* woutt() const { return (bf16_t*)(ws + WS_WOUT); }
    DI bf16_t* cw1t() const { return (bf16_t*)(ws + WS_CW1); }
    DI bf16_t* wl2t() const { return (bf16_t*)(ws + WS_WL2); }
    DI bf16_t* hid() const { return (bf16_t*)(ws + WS_HID); }
    DI bf16_t* kcmp() const { return (bf16_t*)(ws + WS_KCMP); }
    DI bf16_t* vcmpt() const { return (bf16_t*)(ws + WS_VCMPT); }
    DI float* rope() const { return (float*)(ws + WS_ROPE); }
    DI float* biasc() const { return (float*)(ws + WS_BIASC); }
    DI int* ctl() const { return (int*)(ws + WS_CTL); }
    DI int* ids() const { return (int*)(ws + WS_IDS); }
    DI float* gts() const { return (float*)(ws + WS_GTS); }
    DI float* rsl() const { return (float*)(ws + WS_RSL); }
    DI bf16_t* wrt() const { return (bf16_t*)(ws + WS_WRT); }
    DI unsigned char* w1t() const { return ws + WS_W1T; }
    DI unsigned char* w2t() const { return ws + WS_W2T; }
    DI unsigned char* act() const { return ws + WS_ACT; }
    DI unsigned char* h8() const { return ws + WS_XN; }
};
enum { I_X = 0, I_LN1, I_WIN, I_MURKV, I_MUWAG, I_W0, I_W1, I_W2, I_A0, I_A1, I_A2, I_G1, I_G2, I_KK, I_KA, I_RK, I_LNXG, I_LNXB, I_QNG, I_KNG, I_PE, I_CW1, I_CW2, I_WOUT, I_LN2, I_MWR, I_MBR, I_MW1, I_MB1, I_MW2, I_MB2 };

template <class F>
DI void tconv_tile(const Ctx& c, F src, bf16_t* dst, size_t ld_dst, int k0, int nsrc0, int ndst0) {
    LAS float* tile = (LAS float*)c.lds;
    const int tk = c.tid >> 6, tn = c.tid & 63;
#pragma unroll
    for (int j = 0; j < 8; ++j) { const int k = tk + 8 * j; tile[k * 65 + tn] = src(k0 + k, nsrc0 + tn); }
    __syncthreads();
    const int n = c.tid >> 3, kq = c.tid & 7;
    float v[8];
#pragma unroll
    for (int jj = 0; jj < 8; ++jj) v[jj] = tile[(kq * 8 + jj) * 65 + n];
    u32x4 w; w.x = cvt_pk_bf16(v[0], v[1]); w.y = cvt_pk_bf16(v[2], v[3]); w.z = cvt_pk_bf16(v[4], v[5]); w.w = cvt_pk_bf16(v[6], v[7]);
    *(u32x4*)(dst + (size_t)(ndst0 + n) * ld_dst + k0 + kq * 8) = w;
    __syncthreads();
}

template <class F>
DI void tconv_tile_fp8(const Ctx& c, F src, unsigned char* dst, size_t ld_dst, int k0, int nsrc0, int ndst0, float scale) {
    LAS float* tile = (LAS float*)c.lds;
    const int tk = c.tid >> 6, tn = c.tid & 63;
#pragma unroll
    for (int j = 0; j < 8; ++j) { const int k = tk + 8 * j; tile[k * 65 + tn] = src(k0 + k, nsrc0 + tn); }
    __syncthreads();
    const int n = c.tid >> 3, kq = c.tid & 7;
    float v[8];
#pragma unroll
    for (int jj = 0; jj < 8; ++jj) v[jj] = tile[(kq * 8 + jj) * 65 + n] * scale;
    u32x2 w; w.x = cvt4_fp8(v[0], v[1], v[2], v[3]); w.y = cvt4_fp8(v[4], v[5], v[6], v[7]);
    *(u32x2*)(dst + (size_t)(ndst0 + n) * ld_dst + k0 + kq * 8) = w;
    __syncthreads();
}

template <class D>
DI void tconv_big_fp8(const Ctx& c, const float* src, size_t ld_src, unsigned char* dst, size_t ld_dst, int k0, int n0, D drow, float scale) {
    LAS float* tile = (LAS float*)c.lds;
    const int tk = c.tid >> 6, tn = c.tid & 63;
    f32x4 v[8];
#pragma unroll
    for (int j = 0; j < 8; ++j) v[j] = *(const f32x4*)(src + (size_t)(k0 + tk + 8 * j) * ld_src + n0 + tn * 4);
#pragma unroll
    for (int j = 0; j < 8; ++j) *(LAS f32x4*)(tile + (tk + 8 * j) * 260 + tn * 4) = v[j];
    __syncthreads();
    const int n = c.tid >> 1, kh = c.tid & 1;
    u32x4 w[2];
#pragma unroll
    for (int q = 0; q < 8; ++q) { const LAS float* t = tile + (kh * 32 + q * 4) * 260 + n; w[q >> 2][q & 3] = cvt4_fp8(t[0] * scale, t[260] * scale, t[520] * scale, t[780] * scale); }
    unsigned char* d = dst + (size_t)drow(n0 + n) * ld_dst + k0 + kh * 32;
    *(u32x4*)d = w[0]; *(u32x4*)(d + 16) = w[1];
    __syncthreads();
}

DI void p0_prologue(const Ctx& c) {
    const float* x = c.in(I_X); const float* ln1 = c.in(I_LN1);
    if (c.bid == 0 && c.tid < 256) c.ctl()[c.tid] = 0;
    {
        bf16_t* xn = c.xn();
        const int gw = c.bid * 8 + c.wave, nw = c.G * 8;
        f32x4 g[4];
#pragma unroll
        for (int i = 0; i < 4; ++i) g[i] = ((const f32x4*)ln1)[c.lane + 64 * i];
        for (int row = gw; row < T_TOK; row += nw) {
            const f32x4* xr = (const f32x4*)(x + (size_t)row * DM);
            f32x4 v[4]; float ss = 0.f;
#pragma unroll
            for (int i = 0; i < 4; ++i) { v[i] = __builtin_nontemporal_load(xr + c.lane + 64 * i); ss += v[i][0] * v[i][0] + v[i][1] * v[i][1] + v[i][2] * v[i][2] + v[i][3] * v[i][3]; }
            ss = wave_sum(ss);
            const float sc = rsqrtf(ss * (1.0f / DM) + 1e-6f);
#pragma unroll
            for (int i = 0; i < 4; ++i) {
                u32x2 w; w.x = cvt_pk_bf16(v[i][0] * sc * g[i][0], v[i][1] * sc * g[i][1]); w.y = cvt_pk_bf16(v[i][2] * sc * g[i][2], v[i][3] * sc * g[i][3]);
                *(u32x2*)(xn + (size_t)row * DM + (c.lane + 64 * i) * 4) = w;
            }
        }
    }
    {
        const float* w_in = c.in(I_WIN); const float* w1 = c.in(I_W1); const float* a1 = c.in(I_A1); const float* g1 = c.in(I_G1); const float* mu = c.in(I_MUWAG);
        auto src_cat = [=](int k, int n) -> float {
            if (n < N_IN_REAL) return w_in[(size_t)k * N_IN_REAL + n];
            if (n >= C_LEND) return 0.f;
            int cc = n - C_L1; const bool second = cc >= 256; cc &= 255;
            float w, m;
            if (cc < 64) { w = w1[k * 64 + cc]; m = mu[k]; }
            else if (cc < 128) { w = a1[k * 64 + cc - 64]; m = mu[DM + k]; }
            else { w = g1[k * 128 + cc - 128]; m = mu[2 * DM + k]; }
            return w * (second ? m : 1.0f - m);
        };
        const float* w_out = c.in(I_WOUT); const float* cw1 = c.in(I_CW1);
        for (int it = c.bid; it < 1408; it += c.G) {
            if (it < 896) { const int nt_ = it >> 4, kt = it & 15; tconv_tile(c, src_cat, c.wcat(), DM, kt * 64, nt_ * 64, nt_ * 64); }
            else if (it < 1152) { const int j = it - 896, nt_ = j >> 4, kt = j & 15; tconv_tile(c, [=](int k, int n) { return w_out[(size_t)k * DM + n]; }, c.woutt(), DM, kt * 64, nt_ * 64, nt_ * 64); }
            else { const int j = it - 1152, i = j >> 7, r = j & 127, nt_ = r >> 5, kt = r & 31; const float* s = cw1 + (size_t)i * 2048 * 256;
                tconv_tile(c, [=](int k, int n) { return s[(size_t)k * 256 + n]; }, c.cw1t() + (size_t)i * 256 * 2048, 2048, kt * 64, nt_ * 64, nt_ * 64); }
        }
    }
    {
        const int gt = c.bid * NTHREADS + c.tid, ngt = c.G * NTHREADS;
        float* rp = c.rope();
        for (int i = gt; i < SEQ * 32; i += ngt) { const int s = i >> 5, d = i & 31; const float inv = exp2f(-(float)d * (13.287712379549449f / 32.0f)); const float ang = (float)s * inv; rp[2 * i] = cosf(ang); rp[2 * i + 1] = sinf(ang); }
        { const float* wr = c.in(I_MWR); bf16_t* wt = c.wrt();
          for (int i = gt; i < NEXP * DM; i += ngt) { const int e = i >> 10, k = i & 1023; const float w = wr[k * NEXP + e]; const bf16_t hi = f2bf(w); wt[i] = hi; wt[NEXP * DM + i] = f2bf(w - bf2f(hi)); } }
        const float* w2 = c.in(I_W2); const float* a2 = c.in(I_A2); const float* g2 = c.in(I_G2); bf16_t* wl = c.wl2t();
        for (int i = gt; i < 1536 * 256; i += ngt) { const int n = i >> 8, k = i & 255; float v = 0.f;
            if (n < 512) { if (k < 64) v = w2[k * 512 + n]; }
            else if (n < 1024) { if (k >= 64 && k < 128) v = a2[(k - 64) * 512 + n - 512]; }
            else { if (k >= 128) v = g2[(k - 128) * 512 + n - 1024]; }
            wl[i] = f2bf(v); }
    }
    if (c.bid < 16) {
        LAS float* red = (LAS float*)c.lds;
        const int fo = c.bid * 32 + (c.tid & 31), ch = c.tid >> 5, i = fo >> 8, f = fo & 255;
        const float* pe = c.in(I_PE) + (size_t)i * 2048; const float* w = c.in(I_CW1) + (size_t)i * 2048 * 256;
        float s = 0.f;
        for (int ld = ch * 128; ld < ch * 128 + 128; ++ld) s += pe[ld] * w[(size_t)ld * 256 + f];
        red[c.tid] = s; __syncthreads();
        if (c.tid < 32) { float t = 0.f; for (int k = 0; k < 16; ++k) t += red[k * 32 + c.tid]; c.biasc()[fo] = t; }
        __syncthreads();
    }
}

DI void p2_prep(const Ctx& c) {
    const bf16_t* proj = c.proj();
    const int gt = c.bid * NTHREADS + c.tid, ngt = c.G * NTHREADS;
    {
        bf16_t* la = c.lact();
        for (int i = gt; i < T_TOK * 32; i += ngt) {
            const int t = i >> 5, cg8 = (i & 31) * 8;
            const u32x4 p1 = *(const u32x4*)(proj + (size_t)t * NPROJ + C_L1 + cg8);
            u32x4 p2 = (u32x4){0u, 0u, 0u, 0u};
            if ((t & (SEQ - 1)) != 0) p2 = *(const u32x4*)(proj + (size_t)(t - 1) * NPROJ + C_L2 + cg8);
            float z[8];
#pragma unroll
            for (int q = 0; q < 4; ++q) { z[2 * q] = bflo(p1[q]) + bflo(p2[q]); z[2 * q + 1] = bfhi(p1[q]) + bfhi(p2[q]); }
            if (cg8 < 64) {
#pragma unroll
                for (int q = 0; q < 8; ++q) z[q] = tanhf_(z[q]);
            } else if (cg8 >= 128) {
#pragma unroll
                for (int q = 0; q < 8; ++q) z[q] = sigmoidf_(z[q]);
            }
            u32x4 w; w.x = cvt_pk_bf16(z[0], z[1]); w.y = cvt_pk_bf16(z[2], z[3]); w.z = cvt_pk_bf16(z[4], z[5]); w.w = cvt_pk_bf16(z[6], z[7]);
            *(u32x4*)(la + (size_t)t * 256 + cg8) = w;
        }
    }
    {
        const float* kng = c.in(I_KNG); const float* rp = c.rope();
        for (int i = gt; i < T_TOK * 4 * 8; i += ngt) {
            const int j = i & 7, grp = i >> 3, kvh = grp & 1, which = (grp >> 1) & 1, t = grp >> 2, b = t >> 11, s = t & (SEQ - 1);
            const bf16_t* src = proj + (size_t)t * NPROJ + (which ? C_KW : C_KS) + kvh * 64;
            const u32x2 lo = *(const u32x2*)(src + 4 * j), hi = *(const u32x2*)(src + 32 + 4 * j);
            float vl[4] = {bflo(lo.x), bfhi(lo.x), bflo(lo.y), bfhi(lo.y)}, vh[4] = {bflo(hi.x), bfhi(hi.x), bflo(hi.y), bfhi(hi.y)};
            float ss = 0.f;
#pragma unroll
            for (int q = 0; q < 4; ++q) ss += vl[q] * vl[q] + vh[q] * vh[q];
            ss += __shfl_xor(ss, 1); ss += __shfl_xor(ss, 2); ss += __shfl_xor(ss, 4);
            const float rs = rsqrtf(ss * (1.0f / 64.0f) + 1e-6f);
            const float* g = kng + (1 + which) * 64;
            float ol[4], oh[4];
#pragma unroll
            for (int q = 0; q < 4; ++q) {
                const float a = vl[q] * rs * g[4 * j + q], bb = vh[q] * rs * g[32 + 4 * j + q];
                const float cs = rp[(s * 32 + 4 * j + q) * 2], sn = rp[(s * 32 + 4 * j + q) * 2 + 1];
                ol[q] = a * cs - bb * sn; oh[q] = bb * cs + a * sn;
            }
            bf16_t* dst = (which ? c.kwr() : c.ksr()) + ((size_t)(b * 2 + kvh) * SEQ + s) * 64;
            u32x2 wl, wh; wl.x = cvt_pk_bf16(ol[0], ol[1]); wl.y = cvt_pk_bf16(ol[2], ol[3]); wh.x = cvt_pk_bf16(oh[0], oh[1]); wh.y = cvt_pk_bf16(oh[2], oh[3]);
            *(u32x2*)(dst + 4 * j) = wl; *(u32x2*)(dst + 32 + 4 * j) = wh;
        }
    }
    for (int it = c.bid; it < 4096; it += c.G) {
        const int st = it & 31, kvh = (it >> 5) & 1, b = (it >> 6) & 31, which = it >> 11;
        const bf16_t* src = proj + (size_t)b * SEQ * NPROJ + (which ? C_VW : C_VS) + kvh * 64;
        bf16_t* dst = (which ? c.vwt() : c.vst()) + (size_t)(b * 2 + kvh) * 64 * SEQ;
        tconv_tile(c, [=](int k, int n) { return bf2f(src[(size_t)k * NPROJ + n]); }, dst, SEQ, st * 64, 0, 0);
    }
}

DI void p3_cmp_finish(const Ctx& c) {
    const int gw = c.bid * 8 + c.wave, nw = c.G * 8;
    const float* kng0 = c.in(I_KNG);
    for (int r = gw; r < 2 * 8192; r += nw) {
        const int i = r >> 13, m = r & 8191;
        const bf16_t* hrow = c.hid() + ((size_t)i * 8192 + m) * 256; const float* w2 = c.in(I_CW2) + (size_t)i * 256 * 64;
        float acc = 0.f;
#pragma unroll 4
        for (int f8 = 0; f8 < 32; ++f8) {
            const u32x4 hv = *(const u32x4*)(hrow + f8 * 8);
#pragma unroll
            for (int q = 0; q < 4; ++q) { acc += bflo(hv[q]) * w2[(f8 * 8 + 2 * q) * 64 + c.lane]; acc += bfhi(hv[q]) * w2[(f8 * 8 + 2 * q + 1) * 64 + c.lane]; }
        }
        if (i == 0) {
            const float ss = wave_sum(acc * acc);
            const float v = acc * rsqrtf(ss * (1.0f / 64.0f) + 1e-6f) * kng0[c.lane];
            c.kcmp()[(size_t)m * 64 + c.lane] = f2bf(v);
        } else {
            const int bk = m >> 7, n = m & 127;
            c.vcmpt()[((size_t)bk * 64 + c.lane) * 128 + n] = f2bf(acc);
        }
    }
}

DI f32x16 mfma32(const bf16x8& a, const bf16x8& b, const f32x16& cacc) { return __builtin_amdgcn_mfma_f32_32x32x16_bf16(a, b, cacc, 0, 0, 0); }
DI int crow(int reg, int hh) { return (reg & 3) + 8 * (reg >> 2) + 4 * hh; }
DI bf16x8 pack8(const f32x16& x, int s) {
    u32x4 p; p.x = cvt_pk_bf16(x[8 * s], x[8 * s + 1]); p.y = cvt_pk_bf16(x[8 * s + 2], x[8 * s + 3]); p.z = cvt_pk_bf16(x[8 * s + 4], x[8 * s + 5]); p.w = cvt_pk_bf16(x[8 * s + 6], x[8 * s + 7]);
    return __builtin_bit_cast(bf16x8, p);
}
DI f32x16 zero16() { f32x16 z; for (int i = 0; i < 16; ++i) z[i] = 0.f; return z; }

constexpr int SCAN_BUF_FLOATS = 8 * 2048 + 64;
struct ScanPrm { float mu_r[8], mu_k[8], mu_v[8], kk[8], ka[8], rk[8]; };
DI void scan_prepare(const Ctx& c, LAS float* L, int b, int h, int chunk, int ptid, const ScanPrm& P) {
    const int stp = ptid >> 3, c8 = (ptid & 7) * 8, hc = h * 64 + c8, s = chunk * 32 + stp; const size_t t = (size_t)b * SEQ + s;
    const bf16_t* cur = c.proj() + t * NPROJ + hc;
    const u32x4 rc = *(const u32x4*)(cur + C_R), kc = *(const u32x4*)(cur + C_K), vc = *(const u32x4*)(cur + C_V);
    u32x4 rq = (u32x4){0u, 0u, 0u, 0u}, kq = rq, vq = rq;
    if (s > 0) { rq = *(const u32x4*)(cur - NPROJ + C_R); kq = *(const u32x4*)(cur - NPROJ + C_K); vq = *(const u32x4*)(cur - NPROJ + C_V); }
    const bf16_t* lo = c.lout() + t * 1536 + hc;
    const u32x4 wp = *(const u32x4*)lo, ap = *(const u32x4*)(lo + 512), gp = *(const u32x4*)(lo + 1024);
    float r[8], k[8], v[8], w[8], a[8], g[8], kkv[8];
#define UNP8(dst, src) { _Pragma("unroll") for (int e_ = 0; e_ < 4; ++e_) { dst[2 * e_] = bflo(src[e_]); dst[2 * e_ + 1] = bfhi(src[e_]); } }
    { float t0[8], t1[8];
      UNP8(t0, rc); UNP8(t1, rq);
#pragma unroll
      for (int q = 0; q < 8; ++q) r[q] = t0[q] + P.mu_r[q] * (t1[q] - t0[q]);
      UNP8(t0, kc); UNP8(t1, kq);
#pragma unroll
      for (int q = 0; q < 8; ++q) k[q] = t0[q] + P.mu_k[q] * (t1[q] - t0[q]);
      UNP8(t0, vc); UNP8(t1, vq);
#pragma unroll
      for (int q = 0; q < 8; ++q) v[q] = t0[q] + P.mu_v[q] * (t1[q] - t0[q]); }
    UNP8(w, wp); UNP8(a, ap); UNP8(g, gp);
#undef UNP8
    float ss = 0.f;
#pragma unroll
    for (int q = 0; q < 8; ++q) { w[q] = __expf(-0.6065306597126334f * sigmoidf_(w[q])); a[q] = sigmoidf_(a[q]); kkv[q] = k[q] * P.kk[q]; ss += kkv[q] * kkv[q]; }
    ss = red8(ss);
    const float inv = 1.0f / fmaxf(sqrtf(ss), 1e-12f);
    float bon = 0.f; const int o = stp * 64 + c8;
#pragma unroll
    for (int hq = 0; hq < 2; ++hq) {
        f32x4 av, bv, kv, wv, rv, vv, gv;
#pragma unroll
        for (int q4 = 0; q4 < 4; ++q4) { const int q = hq * 4 + q4;
            const float kk = kkv[q] * inv, km = k[q] * (1.0f + (a[q] - 1.0f) * P.ka[q]);
            av[q4] = -kk; bv[q4] = kk * a[q]; kv[q4] = km; wv[q4] = w[q]; rv[q4] = r[q]; vv[q4] = v[q]; gv[q4] = g[q];
            bon += r[q] * km * P.rk[q]; }
        const int oo = o + hq * 4;
        *(LAS f32x4*)(L + oo) = av; *(LAS f32x4*)(L + 2048 + oo) = bv; *(LAS f32x4*)(L + 4096 + oo) = kv; *(LAS f32x4*)(L + 6144 + oo) = wv; *(LAS f32x4*)(L + 8192 + oo) = rv;
        *(LAS f32x4*)(L + 10240 + oo) = vv; *(LAS f32x4*)(L + 12288 + oo) = gv;
    }
    bon = red8(bon);
    if ((ptid & 7) == 0) L[16384 + stp] = bon;
}
DI void scan_finish(const Ctx& c, const LAS float* L, int b, int h, int chunk, int ptid, const float (&lng)[8], const float (&lnb)[8]) {
    const int stp = ptid >> 3, c8 = (ptid & 7) * 8, hc = h * 64 + c8, o = stp * 64 + c8; const size_t t = (size_t)b * SEQ + chunk * 32 + stp;
    float y[8], vv[8], gv[8];
#pragma unroll
    for (int hq = 0; hq < 2; ++hq) { const f32x4 a = *(const LAS f32x4*)(L + 14336 + o + hq * 4), bq = *(const LAS f32x4*)(L + 10240 + o + hq * 4), cq = *(const LAS f32x4*)(L + 12288 + o + hq * 4);
#pragma unroll
        for (int q = 0; q < 4; ++q) { y[hq * 4 + q] = a[q]; vv[hq * 4 + q] = bq[q]; gv[hq * 4 + q] = cq[q]; } }
    float sm = 0.f;
#pragma unroll
    for (int q = 0; q < 8; ++q) sm += y[q];
    sm = red8(sm);
    const float mean = sm * (1.0f / 64.0f);
    float vr = 0.f;
#pragma unroll
    for (int q = 0; q < 8; ++q) { const float d = y[q] - mean; vr += d * d; }
    vr = red8(vr);
    const float rstd = rsqrtf(vr * (1.0f / 64.0f) + 64e-5f), bon = (ABL & 64) ? 0.f : L[16384 + stp];
    float ov[8];
#pragma unroll
    for (int q = 0; q < 8; ++q) ov[q] = ((y[q] - mean) * rstd * lng[q] + lnb[q] + bon * vv[q]) * gv[q];
    u32x4 wv; wv.x = cvt_pk_bf16(ov[0], ov[1]); wv.y = cvt_pk_bf16(ov[2], ov[3]); wv.z = cvt_pk_bf16(ov[4], ov[5]); wv.w = cvt_pk_bf16(ov[6], ov[7]);
    if (ABL & 1) wv = (u32x4){0u, 0u, 0u, 0u};
    *(u32x4*)(c.xn() + t * DM + hc) = wv;
}
struct ScanOps { f32x4 a0, a1, b0, b1, k0, k1, w0, w1, r0, r1; f32x2 vv; };
DI void scan_load_ops(ScanOps& o, const LAS float* L, int st, int j8, int rp) {
    const int q = st * 64 + j8;
    o.a0 = *(const LAS f32x4*)(L + q); o.a1 = *(const LAS f32x4*)(L + q + 4); o.b0 = *(const LAS f32x4*)(L + 2048 + q); o.b1 = *(const LAS f32x4*)(L + 2048 + q + 4);
    o.k0 = *(const LAS f32x4*)(L + 4096 + q); o.k1 = *(const LAS f32x4*)(L + 4096 + q + 4); o.w0 = *(const LAS f32x4*)(L + 6144 + q); o.w1 = *(const LAS f32x4*)(L + 6144 + q + 4);
    o.r0 = *(const LAS f32x4*)(L + 8192 + q); o.r1 = *(const LAS f32x4*)(L + 8192 + q + 4); o.vv = *(const LAS f32x2*)(L + 10240 + st * 64 + 2 * rp);
}
DI void scan_chain(const Ctx& c, int chain) {
    const int b = chain >> 3, h = chain & 7, tid = c.tid;
    LAS float* LB0 = (LAS float*)c.lds; LAS float* LB1 = LB0 + SCAN_BUF_FLOATS;
    const bool prep = tid >= 256; const int ptid = tid & 255;
    ScanPrm P; float lng[8], lnb[8];
    { const int hc = h * 64 + (ptid & 7) * 8;
#pragma unroll
      for (int q = 0; q < 8; ++q) {
        P.mu_r[q] = c.in(I_MURKV)[hc + q]; P.mu_k[q] = c.in(I_MURKV)[512 + hc + q]; P.mu_v[q] = c.in(I_MURKV)[1024 + hc + q];
        P.kk[q] = c.in(I_KK)[hc + q]; P.ka[q] = c.in(I_KA)[hc + q]; P.rk[q] = c.in(I_RK)[hc + q]; lng[q] = c.in(I_LNXG)[hc + q]; lnb[q] = c.in(I_LNXB)[hc + q]; } }
    const int rp = tid >> 3, j8 = (tid & 7) * 8;
    f32x2 S0[4], S1[4];
#pragma unroll
    for (int q = 0; q < 4; ++q) { S0[q] = (f32x2){0.f, 0.f}; S1[q] = (f32x2){0.f, 0.f}; }
    if (prep) scan_prepare(c, LB0, b, h, 0, ptid, P);
    __syncthreads();
#pragma unroll 1
    for (int chunk = 0; chunk < SEQ / 32; ++chunk) {
        LAS float* Lc = (chunk & 1) ? LB1 : LB0; LAS float* Lo = (chunk & 1) ? LB0 : LB1;
        if (prep) {
            if (chunk >= 1) scan_finish(c, Lo, b, h, chunk - 1, ptid, lng, lnb);
            if (chunk + 1 < SEQ / 32) scan_prepare(c, Lo, b, h, chunk + 1, ptid, P);
        } else {
            ScanOps cur, nxt; scan_load_ops(cur, Lc, 0, j8, rp);
#pragma unroll 2
            for (int st = 0; st < 32; ++st) {
                scan_load_ops(nxt, Lc, st < 31 ? st + 1 : 31, j8, rp);
                const f32x2 A[4] = {{cur.a0[0], cur.a0[1]}, {cur.a0[2], cur.a0[3]}, {cur.a1[0], cur.a1[1]}, {cur.a1[2], cur.a1[3]}};
                const f32x2 Bv[4] = {{cur.b0[0], cur.b0[1]}, {cur.b0[2], cur.b0[3]}, {cur.b1[0], cur.b1[1]}, {cur.b1[2], cur.b1[3]}};
                const f32x2 Kv[4] = {{cur.k0[0], cur.k0[1]}, {cur.k0[2], cur.k0[3]}, {cur.k1[0], cur.k1[1]}, {cur.k1[2], cur.k1[3]}};
                const f32x2 Wv[4] = {{cur.w0[0], cur.w0[1]}, {cur.w0[2], cur.w0[3]}, {cur.w1[0], cur.w1[1]}, {cur.w1[2], cur.w1[3]}};
                const f32x2 Rv[4] = {{cur.r0[0], cur.r0[1]}, {cur.r0[2], cur.r0[3]}, {cur.r1[0], cur.r1[1]}, {cur.r1[2], cur.r1[3]}};
                f32x2 p0 = S0[0] * A[0], p1 = S1[0] * A[0];
#pragma unroll
                for (int q = 1; q < 4; ++q) { p0 = S0[q] * A[q] + p0; p1 = S1[q] * A[q] + p1; }
                const float sa0 = red8(p0.x + p0.y), sa1 = red8(p1.x + p1.y);
                const f32x2 sa0v = {sa0, sa0}, sa1v = {sa1, sa1}, v0v = {cur.vv.x, cur.vv.x}, v1v = {cur.vv.y, cur.vv.y};
                f32x2 y0v = {0.f, 0.f}, y1v = {0.f, 0.f};
#pragma unroll
                for (int q = 0; q < 4; ++q) {
                    S0[q] = S0[q] * Wv[q] + (sa0v * Bv[q] + v0v * Kv[q]);
                    S1[q] = S1[q] * Wv[q] + (sa1v * Bv[q] + v1v * Kv[q]);
                    y0v = S0[q] * Rv[q] + y0v; y1v = S1[q] * Rv[q] + y1v;
                }
                const float y0 = red8(y0v.x + y0v.y), y1 = red8(y1v.x + y1v.y);
                if ((tid & 7) == 0) *(LAS f32x2*)(Lc + 14336 + st * 64 + 2 * rp) = (f32x2){y0, y1};
                cur = nxt;
            }
        }
        __syncthreads();
    }
    if (prep) scan_finish(c, LB1, b, h, SEQ / 32 - 1, ptid, lng, lnb);
    __syncthreads();
}

constexpr int S2_LW = 0, S2_LP = 8192, S2_VV = 16384, S2_GV = 24576, S2_YV = 32768, S2_CL = 40960, S2_MAB = 49152, S2_BON = 53248, S2_PL = 53376,
              S2_AT = 53760, S2_RT = 57856, S2_BT = 61952, S2_KT = 66048, S2_BK = 70144, S2_KK = 74240, S2_VT = 78336, S2_UT = 82432, S2_MKB = 86528, S2_MBR = 88576, S2_MKR = 90624;
DI bf16x8 lds_frag16(const LAS unsigned char* p) { return *(const LAS bf16x8*)p; }
DI bf16x8 lds_frag8x2(const LAS unsigned char* p) { const u32x2 lo = *(const LAS u32x2*)p, hi = *(const LAS u32x2*)(p + 16); return __builtin_bit_cast(bf16x8, (u32x4){lo.x, lo.y, hi.x, hi.y}); }
DI void scan_chain2(const Ctx& c, int chain) {
    const int b = chain >> 3, h = chain & 7, tid = c.tid, lane = c.lane, w = c.wave;
    LAS unsigned char* L = c.lds;
    LAS float* LW = (LAS float*)(L + S2_LW); LAS float* LP = (LAS float*)(L + S2_LP); LAS float* VV = (LAS float*)(L + S2_VV); LAS float* GV = (LAS float*)(L + S2_GV);
    LAS float* YV = (LAS float*)(L + S2_YV); LAS float* CL = (LAS float*)(L + S2_CL); LAS float* MAB = (LAS float*)(L + S2_MAB); LAS float* BON = (LAS float*)(L + S2_BON); LAS float* PL = (LAS float*)(L + S2_PL);
    const int stp = tid >> 4, c4 = (tid & 15) * 4, hc = h * 64 + c4;
    float mu_r[4], mu_k[4], mu_v[4], kk_[4], ka_[4], rk_[4], lng[4], lnb[4];
#pragma unroll
    for (int q = 0; q < 4; ++q) {
        mu_r[q] = c.in(I_MURKV)[hc + q]; mu_k[q] = c.in(I_MURKV)[512 + hc + q]; mu_v[q] = c.in(I_MURKV)[1024 + hc + q];
        kk_[q] = c.in(I_KK)[hc + q]; ka_[q] = c.in(I_KA)[hc + q]; rk_[q] = c.in(I_RK)[hc + q]; lng[q] = c.in(I_LNXG)[hc + q]; lnb[q] = c.in(I_LNXB)[hc + q];
    }
    const int n = lane & 31, hh = lane >> 5;
    f32x16 T0 = zero16(), T1 = zero16();
    const bf16_t* proj = c.proj(); const bf16_t* lout = c.lout(); bf16_t* ymix = c.xn();
#pragma unroll 1
    for (int chunk = 0; chunk < SEQ / 32; ++chunk) {
        const int s = chunk * 32 + stp; const size_t t = (size_t)b * SEQ + s;
        float r[4], km[4], av[4], bv[4];
        {
            const bf16_t* cur = proj + t * NPROJ + hc;
            const u32x2 rc = *(const u32x2*)(cur + C_R), kc = *(const u32x2*)(cur + C_K), vc = *(const u32x2*)(cur + C_V);
            u32x2 rq = (u32x2){0u, 0u}, kq = rq, vq = rq;
            if (s > 0) { rq = *(const u32x2*)(cur - NPROJ + C_R); kq = *(const u32x2*)(cur - NPROJ + C_K); vq = *(const u32x2*)(cur - NPROJ + C_V); }
            const bf16_t* lo = lout + t * 1536 + hc;
            const u32x2 wp = *(const u32x2*)lo, ap = *(const u32x2*)(lo + 512), gp = *(const u32x2*)(lo + 1024);
            float k[4], v[4], wl[4], a[4], g[4], kkv[4];
#define UNP(dst, src) dst[0] = bflo(src.x); dst[1] = bfhi(src.x); dst[2] = bflo(src.y); dst[3] = bfhi(src.y)
            float t0[4], t1[4];
            UNP(t0, rc); UNP(t1, rq);
#pragma unroll
            for (int q = 0; q < 4; ++q) r[q] = t0[q] + mu_r[q] * (t1[q] - t0[q]);
            UNP(t0, kc); UNP(t1, kq);
#pragma unroll
            for (int q = 0; q < 4; ++q) k[q] = t0[q] + mu_k[q] * (t1[q] - t0[q]);
            UNP(t0, vc); UNP(t1, vq);
#pragma unroll
            for (int q = 0; q < 4; ++q) v[q] = t0[q] + mu_v[q] * (t1[q] - t0[q]);
            UNP(wl, wp); UNP(a, ap); UNP(g, gp);
#undef UNP
            float ss = 0.f;
#pragma unroll
            for (int q = 0; q < 4; ++q) { wl[q] = -0.6065306597126334f * sigmoidf_(wl[q]); a[q] = sigmoidf_(a[q]); kkv[q] = k[q] * kk_[q]; ss += kkv[q] * kkv[q]; }
            ss = red16(ss);
            const float inv = 1.0f / fmaxf(sqrtf(ss), 1e-12f);
            float bon = 0.f; f32x4 vv, gv, lw4;
#pragma unroll
            for (int q = 0; q < 4; ++q) { const float kk = kkv[q] * inv; km[q] = k[q] * (1.0f + (a[q] - 1.0f) * ka_[q]); av[q] = -kk; bv[q] = kk * a[q]; vv[q] = v[q]; gv[q] = g[q]; lw4[q] = wl[q]; bon += r[q] * km[q] * rk_[q]; }
            bon = red16(bon);
            const int o = stp * 64 + c4;
            *(LAS f32x4*)(LW + o) = lw4; *(LAS f32x4*)(VV + o) = vv; *(LAS f32x4*)(GV + o) = gv;
            if ((tid & 15) == 0) BON[stp] = bon;
#pragma unroll
            for (int q = 0; q < 4; ++q) *(LAS bf16_t*)(L + S2_VT + ((c4 + q) * 32 + stp) * 2) = f2bf(v[q]);
        }
        __syncthreads();
        {
            const int j = tid >> 3, sg = tid & 7;
            float c0 = LW[(4 * sg) * 64 + j], c1 = c0 + LW[(4 * sg + 1) * 64 + j], c2 = c1 + LW[(4 * sg + 2) * 64 + j], c3 = c2 + LW[(4 * sg + 3) * 64 + j];
            float run = c3;
#pragma unroll
            for (int d = 1; d < 8; d <<= 1) { const float up = __shfl_up(run, d, 8); if (sg >= d) run += up; }
            const float excl = run - c3;
            LP[(4 * sg) * 64 + j] = excl + c0; LP[(4 * sg + 1) * 64 + j] = excl + c1; LP[(4 * sg + 2) * 64 + j] = excl + c2; LP[(4 * sg + 3) * 64 + j] = excl + c3;
        }
        __syncthreads();
        {
            const f32x4 lp = *(const LAS f32x4*)(LP + stp * 64 + c4);
            f32x4 lpm = (f32x4){0.f, 0.f, 0.f, 0.f}; if (stp > 0) lpm = *(const LAS f32x4*)(LP + (stp - 1) * 64 + c4);
            float at[4], rt[4], bt[4], kt[4];
#pragma unroll
            for (int q = 0; q < 4; ++q) { const float P = __expf(lp[q]), Pm = __expf(lpm[q]), iP = __expf(-lp[q]); at[q] = Pm * av[q]; rt[q] = P * r[q]; bt[q] = bv[q] * iP; kt[q] = km[q] * iP; if (stp == 31) PL[c4 + q] = P; }
            const int ob = (stp * 64 + c4) * 2;
            { u32x2 x; x.x = cvt_pk_bf16(at[0], at[1]); x.y = cvt_pk_bf16(at[2], at[3]); *(LAS u32x2*)(L + S2_AT + ob) = x; }
            { u32x2 x; x.x = cvt_pk_bf16(rt[0], rt[1]); x.y = cvt_pk_bf16(rt[2], rt[3]); *(LAS u32x2*)(L + S2_RT + ob) = x; }
            { u32x2 x; x.x = cvt_pk_bf16(bt[0], bt[1]); x.y = cvt_pk_bf16(bt[2], bt[3]); *(LAS u32x2*)(L + S2_BT + ob) = x; }
            { u32x2 x; x.x = cvt_pk_bf16(kt[0], kt[1]); x.y = cvt_pk_bf16(kt[2], kt[3]); *(LAS u32x2*)(L + S2_KT + ob) = x; }
#pragma unroll
            for (int q = 0; q < 4; ++q) { *(LAS bf16_t*)(L + S2_BK + ((c4 + q) * 32 + stp) * 2) = f2bf(bt[q]); *(LAS bf16_t*)(L + S2_KK + ((c4 + q) * 32 + stp) * 2) = f2bf(kt[q]); }
        }
        __syncthreads();
        if (w < 4) {
            const LAS unsigned char* Xa = L + ((w & 2) ? S2_RT : S2_AT) + n * 128 + 16 * hh;
            const LAS unsigned char* Xb = L + ((w & 1) ? S2_KT : S2_BT) + n * 128 + 16 * hh;
            f32x16 m = zero16();
#pragma unroll
            for (int st = 0; st < 4; ++st) m = mfma32(lds_frag16(Xa + 32 * st), lds_frag16(Xb + 32 * st), m);
            const bool incl = (w & 2) != 0;
#pragma unroll
            for (int r_ = 0; r_ < 16; ++r_) { const int tt = crow(r_, hh); const bool keep = incl ? (n <= tt) : (n < tt); const float val = keep ? m[r_] : 0.f;
                if (w == 0) MAB[tt * 32 + n] = val; else *(LAS bf16_t*)(L + (w == 1 ? S2_MKB : (w == 2 ? S2_MBR : S2_MKR)) + (tt * 32 + n) * 2) = f2bf(val); }
        }
        __syncthreads();
        f32x16 yacc = zero16();
        if (w < 2) {
            f32x16 cacc = zero16();
            const LAS unsigned char* vt = L + S2_VT + (32 * w + n) * 64 + 16 * hh;
#pragma unroll
            for (int st = 0; st < 2; ++st) { const bf16x8 vb_ = lds_frag16(vt + 32 * st);
                cacc = mfma32(lds_frag16(L + S2_MKB + n * 64 + 16 * hh + 32 * st), vb_, cacc); yacc = mfma32(lds_frag16(L + S2_MKR + n * 64 + 16 * hh + 32 * st), vb_, yacc); }
#pragma unroll
            for (int jb = 0; jb < 2; ++jb)
#pragma unroll
                for (int st = 0; st < 2; ++st) {
                    const bf16x8 tb = pack8(jb ? T1 : T0, st);
                    const int ko = (32 * jb + 16 * st + 4 * hh) * 2;
                    cacc = mfma32(lds_frag8x2(L + S2_AT + n * 128 + ko), tb, cacc); yacc = mfma32(lds_frag8x2(L + S2_RT + n * 128 + ko), tb, yacc);
                }
#pragma unroll
            for (int r_ = 0; r_ < 16; ++r_) CL[crow(r_, hh) * 64 + 32 * w + n] = cacc[r_];
        }
        __syncthreads();
        if (tid < 256) {
            const int i = tid >> 2, l = tid & 3;
            float u[8];
#pragma unroll
            for (int e = 0; e < 8; ++e) u[e] = 0.f;
#pragma unroll
            for (int tt = 0; tt < 32; ++tt) {
                float acc_ = 0.f;
                if (tt > 0) {
                    const f32x4 m0 = *(const LAS f32x4*)(MAB + tt * 32 + 8 * l), m1 = *(const LAS f32x4*)(MAB + tt * 32 + 8 * l + 4);
#pragma unroll
                    for (int e = 0; e < 4; ++e) acc_ += u[e] * m0[e] + u[4 + e] * m1[e];
                    acc_ += dppmov<0xB1>(acc_); acc_ += dppmov<0x4E>(acc_);
                }
                const float ut = CL[tt * 64 + i] + acc_;
                if (l == (tt >> 3)) u[tt & 7] = ut;
            }
            u32x4 x; x.x = cvt_pk_bf16(u[0], u[1]); x.y = cvt_pk_bf16(u[2], u[3]); x.z = cvt_pk_bf16(u[4], u[5]); x.w = cvt_pk_bf16(u[6], u[7]);
            *(LAS u32x4*)(L + S2_UT + (i * 32 + 8 * l) * 2) = x;
        }
        __syncthreads();
        if (w < 2) {
            const LAS unsigned char* ut = L + S2_UT + (32 * w + n) * 64 + 16 * hh;
            const LAS unsigned char* vt = L + S2_VT + (32 * w + n) * 64 + 16 * hh;
#pragma unroll
            for (int st = 0; st < 2; ++st) {
                const bf16x8 ub = lds_frag16(ut + 32 * st), vb_ = lds_frag16(vt + 32 * st);
                yacc = mfma32(lds_frag16(L + S2_MBR + n * 64 + 16 * hh + 32 * st), ub, yacc);
                T0 = mfma32(lds_frag16(L + S2_BK + n * 64 + 16 * hh + 32 * st), ub, T0); T0 = mfma32(lds_frag16(L + S2_KK + n * 64 + 16 * hh + 32 * st), vb_, T0);
                T1 = mfma32(lds_frag16(L + S2_BK + (32 + n) * 64 + 16 * hh + 32 * st), ub, T1); T1 = mfma32(lds_frag16(L + S2_KK + (32 + n) * 64 + 16 * hh + 32 * st), vb_, T1);
            }
#pragma unroll
            for (int r_ = 0; r_ < 16; ++r_) { const int kr = crow(r_, hh); T0[r_] *= PL[kr]; T1[r_] *= PL[32 + kr]; YV[kr * 64 + 32 * w + n] = yacc[r_]; }
        }
        __syncthreads();
        {
            const int o = stp * 64 + c4;
            const f32x4 y = *(LAS f32x4*)(YV + o), vv = *(LAS f32x4*)(VV + o), gv = *(LAS f32x4*)(GV + o);
            float sm = y[0] + y[1] + y[2] + y[3]; sm = red16(sm);
            const float mean = sm * (1.0f / 64.0f);
            float vr = 0.f;
#pragma unroll
            for (int q = 0; q < 4; ++q) { const float d = y[q] - mean; vr += d * d; }
            vr = red16(vr);
            const float rstd = rsqrtf(vr * (1.0f / 64.0f) + 64e-5f), bon = BON[stp];
            float ov[4];
#pragma unroll
            for (int q = 0; q < 4; ++q) ov[q] = ((y[q] - mean) * rstd * lng[q] + lnb[q] + bon * vv[q]) * gv[q];
            u32x2 wv; wv.x = cvt_pk_bf16(ov[0], ov[1]); wv.y = cvt_pk_bf16(ov[2], ov[3]);
            *(u32x2*)(ymix + t * DM + hc) = wv;
        }
        __syncthreads();
    }
}

constexpr int Q_AT = 0, Q_RT = 4096, Q_BT = 8192, Q_KT = 12288, Q_BK = 16384, Q_KK = 20480, Q_VT = 24576, Q_MAB = 28672, Q_MKB = 32768, Q_MBR = 34816, Q_MKR = 36864, Q_PL = 38912, Q_BON = 39168,
              Q_VV = 39424, Q_GV = 47616, Q_SET = 55808, Q_LP = 2 * Q_SET, Q_YV = Q_LP + 8192, Q_CL = Q_YV + 8192, Q_UT = Q_CL + 8192, Q_TT = Q_UT + 4096, Q_PRM = Q_TT + 16384;
struct Scan3Prm { float mu_r[8], mu_k[8], mu_v[8], kk[8], ka[8], rk[8]; };
struct Scan3Raw { u32x4 rc, kc, vc, rq, kq, vq, wp, ap, gp; };
DI void scan3_load(const Ctx& c, Scan3Raw& R, int b, int h, int chunk, int ptid) {
    const int stp = ptid >> 3, c8 = (ptid & 7) * 8, hc = h * 64 + c8, s = chunk * 32 + stp; const size_t t = (size_t)b * SEQ + s;
    const bf16_t* cur = c.proj() + t * NPROJ + hc;
    R.rc = *(const u32x4*)(cur + C_R); R.kc = *(const u32x4*)(cur + C_K); R.vc = *(const u32x4*)(cur + C_V);
    R.rq = (u32x4){0u, 0u, 0u, 0u}; R.kq = R.rq; R.vq = R.rq;
    if (s > 0) { R.rq = *(const u32x4*)(cur - NPROJ + C_R); R.kq = *(const u32x4*)(cur - NPROJ + C_K); R.vq = *(const u32x4*)(cur - NPROJ + C_V); }
    const bf16_t* lo = c.lout() + t * 1536 + hc;
    R.wp = *(const u32x4*)lo; R.ap = *(const u32x4*)(lo + 512); R.gp = *(const u32x4*)(lo + 1024);
}
DI void scan3_s1(const Ctx& c, int h, LAS unsigned char* Q, LAS float* LP, const Scan3Raw& R, int ptid, float (&r)[8], float (&km)[8], float (&av)[8], float (&bv)[8]) {
    const int stp = ptid >> 3, c8 = (ptid & 7) * 8;
    Scan3Prm P;
    { const LAS float* pr = (const LAS float*)(c.lds + Q_PRM) + c8;
#pragma unroll
      for (int q = 0; q < 8; ++q) { P.mu_r[q] = pr[q]; P.mu_k[q] = pr[64 + q]; P.mu_v[q] = pr[128 + q]; P.kk[q] = pr[192 + q]; P.ka[q] = pr[256 + q]; P.rk[q] = pr[320 + q]; } }
    float k[8], v[8], wl[8], a[8], g[8], kkv[8];
#define UNP8(dst, src) { _Pragma("unroll") for (int e_ = 0; e_ < 4; ++e_) { dst[2 * e_] = bflo(src[e_]); dst[2 * e_ + 1] = bfhi(src[e_]); } }
    { float t0[8], t1[8];
      UNP8(t0, R.rc); UNP8(t1, R.rq);
#pragma unroll
      for (int q = 0; q < 8; ++q) r[q] = t0[q] + P.mu_r[q] * (t1[q] - t0[q]);
      UNP8(t0, R.kc); UNP8(t1, R.kq);
#pragma unroll
      for (int q = 0; q < 8; ++q) k[q] = t0[q] + P.mu_k[q] * (t1[q] - t0[q]);
      UNP8(t0, R.vc); UNP8(t1, R.vq);
#pragma unroll
      for (int q = 0; q < 8; ++q) v[q] = t0[q] + P.mu_v[q] * (t1[q] - t0[q]); }
    UNP8(wl, R.wp); UNP8(a, R.ap); UNP8(g, R.gp);
#undef UNP8
    float ss = 0.f;
#pragma unroll
    for (int q = 0; q < 8; ++q) { wl[q] = -0.6065306597126334f * sigmoidf_(wl[q]); a[q] = sigmoidf_(a[q]); kkv[q] = k[q] * P.kk[q]; ss += kkv[q] * kkv[q]; }
    ss = red8(ss);
    const float inv = 1.0f / fmaxf(sqrtf(ss), 1e-12f);
    float bon = 0.f;
#pragma unroll
    for (int q = 0; q < 8; ++q) { const float kk = kkv[q] * inv; km[q] = k[q] * (1.0f + (a[q] - 1.0f) * P.ka[q]); av[q] = -kk; bv[q] = kk * a[q]; bon += r[q] * km[q] * P.rk[q]; }
    bon = red8(bon);
    const int o = stp * 64 + c8;
    *(LAS f32x4*)(LP + o) = (f32x4){wl[0], wl[1], wl[2], wl[3]}; *(LAS f32x4*)(LP + o + 4) = (f32x4){wl[4], wl[5], wl[6], wl[7]};
    LAS float* VV = (LAS float*)(Q + Q_VV); LAS float* GV = (LAS float*)(Q + Q_GV);
    *(LAS f32x4*)(VV + o) = (f32x4){v[0], v[1], v[2], v[3]}; *(LAS f32x4*)(VV + o + 4) = (f32x4){v[4], v[5], v[6], v[7]};
    *(LAS f32x4*)(GV + o) = (f32x4){g[0], g[1], g[2], g[3]}; *(LAS f32x4*)(GV + o + 4) = (f32x4){g[4], g[5], g[6], g[7]};
    if ((ptid & 7) == 0) ((LAS float*)(Q + Q_BON))[stp] = bon;
#pragma unroll
    for (int q = 0; q < 8; ++q) *(LAS bf16_t*)(Q + Q_VT + ((c8 + q) * 32 + stp) * 2) = f2bf(v[q]);
}
DI void scan3_s2(LAS float* LP, int ptid) {
    const int j = ptid >> 2, sg = ptid & 3;
    float cv[8]; float run = 0.f;
#pragma unroll
    for (int e = 0; e < 8; ++e) { run += LP[(8 * sg + e) * 64 + j]; cv[e] = run; }
    float tot = run;
#pragma unroll
    for (int d = 1; d < 4; d <<= 1) { const float up = __shfl_up(tot, d, 4); if (sg >= d) tot += up; }
    const float excl = tot - run;
#pragma unroll
    for (int e = 0; e < 8; ++e) LP[(8 * sg + e) * 64 + j] = excl + cv[e];
}
DI void scan3_s3(LAS unsigned char* Q, const LAS float* LP, int ptid, const float (&r)[8], const float (&km)[8], const float (&av)[8], const float (&bv)[8]) {
    const int stp = ptid >> 3, c8 = (ptid & 7) * 8;
    float lp[8], lpm[8];
    { const f32x4 a0 = *(const LAS f32x4*)(LP + stp * 64 + c8), a1 = *(const LAS f32x4*)(LP + stp * 64 + c8 + 4);
#pragma unroll
      for (int q = 0; q < 4; ++q) { lp[q] = a0[q]; lp[4 + q] = a1[q]; lpm[q] = 0.f; lpm[4 + q] = 0.f; }
      if (stp > 0) { const f32x4 b0 = *(const LAS f32x4*)(LP + (stp - 1) * 64 + c8), b1 = *(const LAS f32x4*)(LP + (stp - 1) * 64 + c8 + 4);
#pragma unroll
        for (int q = 0; q < 4; ++q) { lpm[q] = b0[q]; lpm[4 + q] = b1[q]; } } }
    float at[8], rt[8], bt[8], kt[8];
#pragma unroll
    for (int q = 0; q < 8; ++q) { const float Pq = __expf(lp[q]), Pm = __expf(lpm[q]), iP = __expf(-lp[q]); at[q] = Pm * av[q]; rt[q] = Pq * r[q]; bt[q] = bv[q] * iP; kt[q] = km[q] * iP; if (stp == 31) ((LAS float*)(Q + Q_PL))[c8 + q] = Pq; }
    const int ob = (stp * 64 + c8) * 2;
#define PK8(x) ((u32x4){cvt_pk_bf16(x[0], x[1]), cvt_pk_bf16(x[2], x[3]), cvt_pk_bf16(x[4], x[5]), cvt_pk_bf16(x[6], x[7])})
    *(LAS u32x4*)(Q + Q_AT + ob) = PK8(at); *(LAS u32x4*)(Q + Q_RT + ob) = PK8(rt); *(LAS u32x4*)(Q + Q_BT + ob) = PK8(bt); *(LAS u32x4*)(Q + Q_KT + ob) = PK8(kt);
#undef PK8
#pragma unroll
    for (int q = 0; q < 8; ++q) { *(LAS bf16_t*)(Q + Q_BK + ((c8 + q) * 32 + stp) * 2) = f2bf(bt[q]); *(LAS bf16_t*)(Q + Q_KK + ((c8 + q) * 32 + stp) * 2) = f2bf(kt[q]); }
}
DI void scan3_s4(LAS unsigned char* Q, int m, int n, int hh) {
    const LAS unsigned char* Xa = Q + ((m & 2) ? Q_RT : Q_AT) + n * 128 + 16 * hh;
    const LAS unsigned char* Xb = Q + ((m & 1) ? Q_KT : Q_BT) + n * 128 + 16 * hh;
    f32x16 acc = zero16();
#pragma unroll
    for (int st = 0; st < 4; ++st) acc = mfma32(lds_frag16(Xa + 32 * st), lds_frag16(Xb + 32 * st), acc);
    const bool incl = (m & 2) != 0;
#pragma unroll
    for (int r_ = 0; r_ < 16; ++r_) { const int tt = crow(r_, hh); const bool keep = incl ? (n <= tt) : (n < tt); const float val = keep ? acc[r_] : 0.f;
        if (m == 0) ((LAS float*)(Q + Q_MAB))[tt * 32 + n] = val; else *(LAS bf16_t*)(Q + (m == 1 ? Q_MKB : (m == 2 ? Q_MBR : Q_MKR)) + (tt * 32 + n) * 2) = f2bf(val); }
}
DI void scan3_s8(const Ctx& c, const LAS unsigned char* Q, const LAS float* YV, int b, int h, int chunk, int ptid) {
    const int stp = ptid >> 3, c8 = (ptid & 7) * 8, hc = h * 64 + c8, o = stp * 64 + c8; const size_t t = (size_t)b * SEQ + chunk * 32 + stp;
    float lng[8], lnb[8];
    { const LAS float* pr = (const LAS float*)(c.lds + Q_PRM) + c8;
#pragma unroll
      for (int q = 0; q < 8; ++q) { lng[q] = pr[384 + q]; lnb[q] = pr[448 + q]; } }
    const LAS float* VV = (const LAS float*)(Q + Q_VV); const LAS float* GV = (const LAS float*)(Q + Q_GV);
    float y[8], vv[8], gv[8];
#pragma unroll
    for (int hq = 0; hq < 2; ++hq) { const f32x4 a = *(const LAS f32x4*)(YV + o + hq * 4), bq = *(const LAS f32x4*)(VV + o + hq * 4), cq = *(const LAS f32x4*)(GV + o + hq * 4);
#pragma unroll
        for (int q = 0; q < 4; ++q) { y[hq * 4 + q] = a[q]; vv[hq * 4 + q] = bq[q]; gv[hq * 4 + q] = cq[q]; } }
    float sm = 0.f;
#pragma unroll
    for (int q = 0; q < 8; ++q) sm += y[q];
    sm = red8(sm);
    const float mean = sm * (1.0f / 64.0f);
    float vr = 0.f;
#pragma unroll
    for (int q = 0; q < 8; ++q) { const float d = y[q] - mean; vr += d * d; }
    vr = red8(vr);
    const float rstd = rsqrtf(vr * (1.0f / 64.0f) + 64e-5f), bon = (ABL & 64) ? 0.f : ((const LAS float*)(Q + Q_BON))[stp];
    float ov[8];
#pragma unroll
    for (int q = 0; q < 8; ++q) ov[q] = ((y[q] - mean) * rstd * lng[q] + lnb[q] + bon * vv[q]) * gv[q];
    u32x4 wv; wv.x = cvt_pk_bf16(ov[0], ov[1]); wv.y = cvt_pk_bf16(ov[2], ov[3]); wv.z = cvt_pk_bf16(ov[4], ov[5]); wv.w = cvt_pk_bf16(ov[6], ov[7]);
    if (ABL & 1) wv = (u32x4){0u, 0u, 0u, 0u};
    *(u32x4*)(c.xn() + t * DM + hc) = wv;
}
DI void scan_chain3(const Ctx& c, int chain) {
    const int b = chain >> 3, h = chain & 7, tid = c.tid, lane = c.lane, w = c.wave;
    LAS unsigned char* L = c.lds;
    LAS float* LP = (LAS float*)(L + Q_LP); LAS float* YV = (LAS float*)(L + Q_YV); LAS float* CL = (LAS float*)(L + Q_CL);
    const bool prep = tid >= 256; const int ptid = tid & 255, n = lane & 31, hh = lane >> 5;
    LAS float* TT = (LAS float*)(L + Q_TT) + (w & 1) * 2048 + lane;
    if (w < 2) {
#pragma unroll
        for (int q = 0; q < 32; ++q) TT[q * 64] = 0.f;
    }
    float r_[8], km_[8], av_[8], bv_[8];
    Scan3Raw R;
    if (tid < 64) { LAS float* pr = (LAS float*)(L + Q_PRM); const int hc = h * 64 + tid;
        pr[tid] = c.in(I_MURKV)[hc]; pr[64 + tid] = c.in(I_MURKV)[512 + hc]; pr[128 + tid] = c.in(I_MURKV)[1024 + hc]; pr[192 + tid] = c.in(I_KK)[hc]; pr[256 + tid] = c.in(I_KA)[hc]; pr[320 + tid] = c.in(I_RK)[hc];
        pr[384 + tid] = c.in(I_LNXG)[hc]; pr[448 + tid] = c.in(I_LNXB)[hc]; }
    if (prep) scan3_load(c, R, b, h, 0, ptid);
    __syncthreads();
    if (prep) { scan3_s1(c, h, L, LP, R, ptid, r_, km_, av_, bv_); scan3_load(c, R, b, h, 1, ptid); }
    __syncthreads();
    if (prep) scan3_s2(LP, ptid);
    __syncthreads();
    if (prep) scan3_s3(L, LP, ptid, r_, km_, av_, bv_);
    __syncthreads();
    if (prep) scan3_s4(L, w - 4, n, hh);
    __syncthreads();
#pragma unroll 1
    for (int chunk = 0; chunk < SEQ / 32; ++chunk) {
        LAS unsigned char* Qc = L + (chunk & 1) * Q_SET;
        LAS unsigned char* Qn = L + ((chunk + 1) & 1) * Q_SET;
        const bool more = chunk + 1 < SEQ / 32;
        if (prep) {
            if (more) scan3_s1(c, h, Qn, LP, R, ptid, r_, km_, av_, bv_);
        } else if (w < 2) {
            f32x16 cacc = zero16(), yacc = zero16();
            const LAS unsigned char* vt = Qc + Q_VT + (32 * w + n) * 64 + 16 * hh;
#pragma unroll
            for (int st = 0; st < 2; ++st) { const bf16x8 vb_ = lds_frag16(vt + 32 * st);
                cacc = mfma32(lds_frag16(Qc + Q_MKB + n * 64 + 16 * hh + 32 * st), vb_, cacc); yacc = mfma32(lds_frag16(Qc + Q_MKR + n * 64 + 16 * hh + 32 * st), vb_, yacc); }
#pragma unroll
            for (int jb = 0; jb < 2; ++jb)
#pragma unroll
                for (int st = 0; st < 2; ++st) {
                    u32x4 tp_;
#pragma unroll
                    for (int e = 0; e < 4; ++e) tp_[e] = cvt_pk_bf16(TT[(jb * 16 + 8 * st + 2 * e) * 64], TT[(jb * 16 + 8 * st + 2 * e + 1) * 64]);
                    const bf16x8 tb = __builtin_bit_cast(bf16x8, tp_);
                    const int ko = (32 * jb + 16 * st + 4 * hh) * 2;
                    cacc = mfma32(lds_frag8x2(Qc + Q_AT + n * 128 + ko), tb, cacc); yacc = mfma32(lds_frag8x2(Qc + Q_RT + n * 128 + ko), tb, yacc);
                }
#pragma unroll
            for (int q = 0; q < 16; ++q) { CL[crow(q, hh) * 64 + 32 * w + n] = cacc[q]; YV[crow(q, hh) * 64 + 32 * w + n] = yacc[q]; }
        }
        __syncthreads();
        if (prep) { if (chunk + 2 < SEQ / 32) scan3_load(c, R, b, h, chunk + 2, ptid); if (more) scan3_s2(LP, ptid); }
        else {
            const int i = tid >> 2, l = tid & 3;
            const LAS float* MAB = (const LAS float*)(Qc + Q_MAB);
            float u[8];
#pragma unroll
            for (int e = 0; e < 8; ++e) u[e] = 0.f;
            float up1 = 0.f, up2 = 0.f;
#pragma unroll 1
            for (int to = 0; to < 4; ++to) {
#pragma unroll
                for (int te = 0; te < 8; ++te) {
                    const int tt = to * 8 + te;
                    if (te >= 2) { if (l == to) u[te - 2] = up2; } else { if (l == to - 1) u[te + 6] = up2; }
                    const f32x4 m0 = *(const LAS f32x4*)(MAB + tt * 32 + 8 * l), m1 = *(const LAS f32x4*)(MAB + tt * 32 + 8 * l + 4);
                    const float mlate = tt > 0 ? MAB[tt * 32 + tt - 1] : 0.f;
                    float sa_ = 0.f, sb_ = 0.f;
#pragma unroll
                    for (int e = 0; e < 4; ++e) { sa_ += u[e] * m0[e]; sb_ += u[4 + e] * m1[e]; }
                    sa_ += sb_; sa_ += dppmov<0xB1>(sa_); sa_ += dppmov<0x4E>(sa_);
                    const float ut = (CL[tt * 64 + i] + sa_) + mlate * up1;
                    up2 = up1; up1 = ut;
                }
            }
            if (l == 3) { u[6] = up2; u[7] = up1; }
            u32x4 x; x.x = cvt_pk_bf16(u[0], u[1]); x.y = cvt_pk_bf16(u[2], u[3]); x.z = cvt_pk_bf16(u[4], u[5]); x.w = cvt_pk_bf16(u[6], u[7]);
            *(LAS u32x4*)(L + Q_UT + (i * 32 + 8 * l) * 2) = x;
        }
        __syncthreads();
        if (prep) { if (more) scan3_s3(Qn, LP, ptid, r_, km_, av_, bv_); }
        else if (w < 2) {
            const LAS unsigned char* ut = L + Q_UT + (32 * w + n) * 64 + 16 * hh;
            const LAS unsigned char* vt = Qc + Q_VT + (32 * w + n) * 64 + 16 * hh;
            f32x16 T0, T1, yacc;
#pragma unroll
            for (int q = 0; q < 16; ++q) { T0[q] = TT[q * 64]; T1[q] = TT[(16 + q) * 64]; yacc[q] = YV[crow(q, hh) * 64 + 32 * w + n]; }
#pragma unroll
            for (int st = 0; st < 2; ++st) {
                const bf16x8 ub = lds_frag16(ut + 32 * st), vb_ = lds_frag16(vt + 32 * st);
                yacc = mfma32(lds_frag16(Qc + Q_MBR + n * 64 + 16 * hh + 32 * st), ub, yacc);
                T0 = mfma32(lds_frag16(Qc + Q_BK + n * 64 + 16 * hh + 32 * st), ub, T0); T1 = mfma32(lds_frag16(Qc + Q_BK + (32 + n) * 64 + 16 * hh + 32 * st), ub, T1);
                T0 = mfma32(lds_frag16(Qc + Q_KK + n * 64 + 16 * hh + 32 * st), vb_, T0); T1 = mfma32(lds_frag16(Qc + Q_KK + (32 + n) * 64 + 16 * hh + 32 * st), vb_, T1);
            }
            const LAS float* PL = (const LAS float*)(Qc + Q_PL);
#pragma unroll
            for (int q = 0; q < 16; ++q) { const int kr = crow(q, hh); TT[q * 64] = T0[q] * PL[kr]; TT[(16 + q) * 64] = T1[q] * PL[32 + kr]; YV[kr * 64 + 32 * w + n] = yacc[q]; }
        }
        __syncthreads();
        if (prep) { if (more) scan3_s4(Qn, w - 4, n, hh); scan3_s8(c, Qc, YV, b, h, chunk, ptid); }
        __syncthreads();
    }
}


DI float pair_max(float x) { const u32x2 r = __builtin_amdgcn_permlane32_swap(__float_as_uint(x), __float_as_uint(x), false, false); return fmaxf(__uint_as_float(r.x), __uint_as_float(r.y)); }
DI float pair_sum(float x) { const u32x2 r = __builtin_amdgcn_permlane32_swap(__float_as_uint(x), __float_as_uint(x), false, false); return __uint_as_float(r.x) + __uint_as_float(r.y); }
DI float fexp2(float x) { return __builtin_amdgcn_exp2f(x); }
constexpr float M_FLOOR = -30000.0f, NEGBIG = -1e30f;
DI bf16x8 att_vf(const LAS unsigned char* vr, int g, int ksw) { const u32x2 lo_ = *(const LAS u32x2*)(vr + ((g ^ ksw) << 4)), hi_ = *(const LAS u32x2*)(vr + (((g + 1) ^ ksw) << 4)); return __builtin_bit_cast(bf16x8, (u32x4){lo_.x, lo_.y, hi_.x, hi_.y}); }
constexpr int ATT_RING_OFF = 16384, ATT_SLOT = 16384;

template <int MODE>
DI void flash_lds(const Ctx& c, const bf16_t* Kb, const bf16_t* Vt, unsigned blkmask, const bf16x8 (&q)[4], int tq, int qb, unsigned selmask, int n, int hh, int half, float gate, f32x16 (&out)[2]) {
    LAS unsigned char* ring = c.lds + ATT_RING_OFF;
    const int row = c.tid >> 3, gsw = (c.tid & 7) ^ ((row >> 1) & 7);
    const bf16_t* ksrc = Kb + (size_t)row * 64 + gsw * 8;
    const bf16_t* vsrc = Vt + (size_t)row * SEQ + gsw * 8;
    const unsigned wofs = (unsigned)c.wave * 1024u;
#define ATT_ISSUE(j, slot) do { \
        __builtin_amdgcn_global_load_lds((const unsigned*)(ksrc + (size_t)(j) * 4096), (LAS unsigned*)(ring + (slot) * ATT_SLOT + wofs), 16, 0, 0); \
        __builtin_amdgcn_global_load_lds((const unsigned*)(vsrc + (size_t)(j) * 64), (LAS unsigned*)(ring + (slot) * ATT_SLOT + 8192 + wofs), 16, 0, 0); } while (0)
    unsigned m = blkmask; const int nb = __builtin_popcount(m);
    int j0 = -1, j1 = -1;
    if (nb > 0) { j0 = __builtin_ctz(m); m &= m - 1; ATT_ISSUE(j0, 0); }
    if (nb > 1) { j1 = __builtin_ctz(m); m &= m - 1; ATT_ISSUE(j1, 1); }
    float lrun = 0.f; f32x16 o[2]; o[0] = zero16(); o[1] = zero16();
    const int ksw = (n >> 1) & 7;
    int slot = 0;
#pragma unroll 1
    for (int i = 0; i < nb; ++i) {
        if (i + 1 < nb) asm volatile("s_waitcnt vmcnt(2)" ::: "memory"); else asm volatile("s_waitcnt vmcnt(0)" ::: "memory");
        __builtin_amdgcn_s_barrier();
        asm volatile("" ::: "memory");
        int j2 = -1;
        if (i + 2 < nb) { j2 = __builtin_ctz(m); m &= m - 1; const int s2 = slot >= 1 ? slot - 1 : 2; ATT_ISSUE(j2, s2); }
        const LAS unsigned char* kb = ring + slot * ATT_SLOT; const LAS unsigned char* vb = kb + 8192;
        const bool bit = (MODE == 0) ? ((selmask >> j0) & 1u) : true;
        if (__ballot(bit) != 0ull) {
            int cls0 = 1, cls1 = 1;
            if (j0 == qb) { cls0 = (0 < half) ? 1 : 2; cls1 = (1 == half) ? 2 : 0; }
            if (MODE == 1 && j0 == qb - 4) { cls0 = (0 == half) ? 3 : 0; cls1 = (1 > half) ? 1 : 3; }
            f32x16 s0 = zero16(), s1 = zero16();
            const LAS unsigned char* kr0 = kb + n * 128; const LAS unsigned char* kr1 = kr0 + 32 * 128;
            if (cls0 && cls1) {
#pragma unroll
                for (int s = 0; s < 4; ++s) { const bf16x8 ka = *(const LAS bf16x8*)(kr0 + (((2 * s + hh) ^ ksw) << 4)), kc = *(const LAS bf16x8*)(kr1 + (((2 * s + hh) ^ ksw) << 4)); s0 = mfma32(ka, q[s], s0); s1 = mfma32(kc, q[s], s1); }
            } else if (cls0) {
#pragma unroll
                for (int s = 0; s < 4; ++s) { const bf16x8 ka = *(const LAS bf16x8*)(kr0 + (((2 * s + hh) ^ ksw) << 4)); s0 = mfma32(ka, q[s], s0); }
            } else {
#pragma unroll
                for (int s = 0; s < 4; ++s) { const bf16x8 kc = *(const LAS bf16x8*)(kr1 + (((2 * s + hh) ^ ksw) << 4)); s1 = mfma32(kc, q[s], s1); }
            }
            const int tl = tq & 31;
            if (cls0 >= 2) {
#pragma unroll
                for (int r = 0; r < 16; ++r) { const int kl = crow(r, hh); const bool v = (cls0 == 2) ? (kl <= tl) : (kl > tl); s0[r] = v ? s0[r] : NEGBIG; }
            }
            if (cls1 >= 2) {
#pragma unroll
                for (int r = 0; r < 16; ++r) { const int kl = crow(r, hh); const bool v = (cls1 == 2) ? (kl <= tl) : (kl > tl); s1[r] = v ? s1[r] : NEGBIG; }
            }
            if (MODE == 0) {
#pragma unroll
                for (int r = 0; r < 16; ++r) { s0[r] = bit ? s0[r] : NEGBIG; s1[r] = bit ? s1[r] : NEGBIG; }
            }
            float psa = 0.f, psb = 0.f;
            if (cls0) {
#pragma unroll
                for (int r = 0; r < 16; ++r) { s0[r] = fexp2(s0[r]); psa += s0[r]; }
            }
            if (cls1) {
#pragma unroll
                for (int r = 0; r < 16; ++r) { s1[r] = fexp2(s1[r]); psb += s1[r]; }
            }
            const unsigned bitw = bit ? 0xffffffffu : 0u;
            lrun += psa + psb;
#define ATT_PK(x, h_) ({ u32x4 p_ = __builtin_bit_cast(u32x4, pack8(x, h_));  __builtin_bit_cast(bf16x8, p_); })
            const LAS unsigned char* vr0 = vb + n * 128 + 8 * hh; const LAS unsigned char* vr1 = vr0 + 32 * 128;
#define ATT_VF(vr, g) att_vf((vr), (g), ksw)
            if (cls0) {
                const bf16x8 pa = ATT_PK(s0, 0), pb = ATT_PK(s0, 1);
                o[0] = mfma32(ATT_VF(vr0, 0), pa, o[0]); o[1] = mfma32(ATT_VF(vr1, 0), pa, o[1]);
                o[0] = mfma32(ATT_VF(vr0, 2), pb, o[0]); o[1] = mfma32(ATT_VF(vr1, 2), pb, o[1]);
            }
            if (cls1) {
                const bf16x8 pa = ATT_PK(s1, 0), pb = ATT_PK(s1, 1);
                o[0] = mfma32(ATT_VF(vr0, 4), pa, o[0]); o[1] = mfma32(ATT_VF(vr1, 4), pa, o[1]);
                o[0] = mfma32(ATT_VF(vr0, 6), pb, o[0]); o[1] = mfma32(ATT_VF(vr1, 6), pb, o[1]);
            }
#undef ATT_VF
#undef ATT_PK
        }
        j0 = j1; j1 = j2; slot = slot == 2 ? 0 : slot + 1;
    }
    __builtin_amdgcn_s_barrier();
    asm volatile("" ::: "memory");
#undef ATT_ISSUE
    const float lt = pair_sum(lrun), sc = lt > 0.f ? gate / lt : 0.f;
#pragma unroll
    for (int r = 0; r < 16; ++r) { out[0][r] += o[0][r] * sc; out[1][r] += o[1][r] * sc; }
}

template <bool ROT>
DI void load_q(const Ctx& c, const bf16_t* qp, int pos, int hh, bf16x8 (&qf)[4]) {
    float y[4][8]; float ss = 0.f;
#pragma unroll
    for (int s = 0; s < 4; ++s) { const u32x4 raw = *(const u32x4*)(qp + 16 * s);
#pragma unroll
        for (int e = 0; e < 4; ++e) { y[s][2 * e] = bflo(raw[e]); y[s][2 * e + 1] = bfhi(raw[e]); ss += y[s][2 * e] * y[s][2 * e] + y[s][2 * e + 1] * y[s][2 * e + 1]; } }
    ss += __shfl_xor(ss, 32);
    const float rs = rsqrtf(ss * (1.0f / 64.0f) + 1e-6f) * (0.125f * 1.4426950408889634f);
    const float* qg = c.in(I_QNG) + 8 * hh;
#pragma unroll
    for (int s = 0; s < 4; ++s)
#pragma unroll
        for (int e = 0; e < 8; ++e) y[s][e] *= rs * qg[16 * s + e];
    if (!ROT) {
#pragma unroll
        for (int s = 0; s < 4; ++s) { u32x4 p; for (int e = 0; e < 4; ++e) p[e] = cvt_pk_bf16(y[s][2 * e], y[s][2 * e + 1]); qf[s] = __builtin_bit_cast(bf16x8, p); }
    } else {
        const float* rp = c.rope() + (size_t)pos * 64 + 16 * hh;
#pragma unroll
        for (int s = 0; s < 2; ++s) {
            float lo[8], hi[8];
#pragma unroll
            for (int e = 0; e < 8; ++e) { const float cs = rp[32 * s + 2 * e], sn = rp[32 * s + 2 * e + 1]; lo[e] = y[s][e] * cs - y[s + 2][e] * sn; hi[e] = y[s + 2][e] * cs + y[s][e] * sn; }
            u32x4 pl, ph; for (int e = 0; e < 4; ++e) { pl[e] = cvt_pk_bf16(lo[2 * e], lo[2 * e + 1]); ph[e] = cvt_pk_bf16(hi[2 * e], hi[2 * e + 1]); }
            qf[s] = __builtin_bit_cast(bf16x8, pl); qf[s + 2] = __builtin_bit_cast(bf16x8, ph);
        }
    }
}

DI void attn_item(const Ctx& c, int item) {
    const int qb = (item + 4 * (item >> 8)) & 31, kvh = (item >> 5) & 1, b = item >> 6;
    const int w = c.wave, g = w >> 1, head = kvh * 4 + g, n = c.lane & 31, hh = c.lane >> 5;
    const int tokw0 = qb * 64 + (w & 1) * 32, pos = tokw0 + n, tq = (w & 1) * 32 + n;
    LAS float* IMP = (LAS float*)c.lds;
    LAS unsigned* SEL = (LAS unsigned*)(c.lds + 8192);
    for (int i = c.tid; i < 64 * 32; i += NTHREADS) IMP[i] = 0.f;
    if (c.tid == 0) SEL[64] = 0u;
    const bf16_t* prow = c.proj() + ((size_t)b * SEQ + pos) * NPROJ;
    const bf16_t* qp = prow + C_Q + head * 64 + 8 * hh;
    float gate[3];
    { const bf16_t* gp = prow + C_GL + head * 3; for (int i = 0; i < 3; ++i) gate[i] = ((ABL >> (3 + i)) & 1) ? 0.f : sigmoidf_(bf2f(gp[i])); }
    f32x16 out[2]; out[0] = zero16(); out[1] = zero16();
    {
        LAS unsigned char* ring = c.lds + ATT_RING_OFF;
        {
            const int row = c.tid >> 3, gsw = (c.tid & 7) ^ ((row >> 1) & 7); const unsigned wofs = (unsigned)c.wave * 1024u;
            const bf16_t* kc = c.kcmp() + (size_t)(b * 2 + kvh) * 128 * 64 + (size_t)row * 64 + gsw * 8;
            const bf16_t* vc = c.vcmpt() + (size_t)(b * 2 + kvh) * 64 * 128 + (size_t)row * 128 + gsw * 8;
#pragma unroll
            for (int j = 0; j < 2; ++j) {
                __builtin_amdgcn_global_load_lds((const unsigned*)(kc + j * 4096), (LAS unsigned*)(ring + j * ATT_SLOT + wofs), 16, 0, 0);
                __builtin_amdgcn_global_load_lds((const unsigned*)(vc + j * 64), (LAS unsigned*)(ring + j * ATT_SLOT + 8192 + wofs), 16, 0, 0);
            }
        }
        bf16x8 qn[4]; load_q<false>(c, qp, pos, hh, qn);
        asm volatile("s_waitcnt vmcnt(0)" ::: "memory");
        __syncthreads();
        const int ksw = (n >> 1) & 7;
        float mrun = -1e30f, lrun = 0.f;
#pragma unroll 1
        for (int t = 0; t < 4; ++t) {
            const LAS unsigned char* kr = ring + (t >> 1) * ATT_SLOT + (32 * (t & 1) + n) * 128;
            f32x16 sc = zero16();
#pragma unroll
            for (int s = 0; s < 4; ++s) { const bf16x8 kf = *(const LAS bf16x8*)(kr + (((2 * s + hh) ^ ksw) << 4)); sc = mfma32(kf, qn[s], sc); }
            float mx = -1e30f;
#pragma unroll
            for (int r = 0; r < 16; ++r) { const int key = t * 32 + crow(r, hh); const bool v = key <= 126 && key * 16 + 31 <= pos; mx = v ? fmaxf(mx, sc[r]) : mx; }
            const float mnew = fmaxf(mrun, mx); float ps = 0.f;
#pragma unroll
            for (int r = 0; r < 16; ++r) { const int key = t * 32 + crow(r, hh); const bool v = key <= 126 && key * 16 + 31 <= pos; ps += v ? fexp2(sc[r] - mnew) : 0.f; }
            lrun = lrun * fexp2(mrun - mnew) + ps; mrun = mnew;
        }
        {
            const float mo = __shfl_xor(mrun, 32), lo_ = __shfl_xor(lrun, 32), mm = fmaxf(mrun, mo);
            lrun = lrun * fexp2(mrun - mm) + lo_ * fexp2(mo - mm); mrun = mm;
        }
        const float inv = lrun > 0.f ? 1.0f / lrun : 0.f;
        float carry = 0.f;
#pragma unroll 1
        for (int t = 0; t < 4; ++t) {
            const LAS unsigned char* kr = ring + (t >> 1) * ATT_SLOT + (32 * (t & 1) + n) * 128;
            const LAS unsigned char* vb = ring + (t >> 1) * ATT_SLOT + 8192;
            const int tt = t & 1;
            f32x16 sc = zero16();
#pragma unroll
            for (int s = 0; s < 4; ++s) { const bf16x8 kf = *(const LAS bf16x8*)(kr + (((2 * s + hh) ^ ksw) << 4)); sc = mfma32(kf, qn[s], sc); }
#pragma unroll
            for (int r = 0; r < 16; ++r) { const int key = t * 32 + crow(r, hh); const bool v = key <= 126 && key * 16 + 31 <= pos; sc[r] = v ? fexp2(sc[r] - mrun) * inv : 0.f; }
            const bf16x8 pf0 = pack8(sc, 0), pf1 = pack8(sc, 1);
#pragma unroll
            for (int rb = 0; rb < 2; ++rb) {
                const LAS unsigned char* vr = vb + (32 * rb + n) * 128 + 8 * hh;
                const u32x2 l0 = *(const LAS u32x2*)(vr + (((4 * tt) ^ ksw) << 4)), h0 = *(const LAS u32x2*)(vr + (((4 * tt + 1) ^ ksw) << 4));
                const u32x2 l1 = *(const LAS u32x2*)(vr + (((4 * tt + 2) ^ ksw) << 4)), h1 = *(const LAS u32x2*)(vr + (((4 * tt + 3) ^ ksw) << 4));
                const bf16x8 v0 = __builtin_bit_cast(bf16x8, (u32x4){l0.x, l0.y, h0.x, h0.y}), v1 = __builtin_bit_cast(bf16x8, (u32x4){l1.x, l1.y, h1.x, h1.y});
                out[rb] = mfma32(v0, pf0, out[rb]); out[rb] = mfma32(v1, pf1, out[rb]);
            }
            float Ep[4];
#pragma unroll
            for (int q = 0; q < 4; ++q) Ep[q] = __shfl_xor(sc[4 * q + 3], 32);
#pragma unroll
            for (int q = 0; q < 4; ++q) {
                const float Gs = sc[4 * q] + sc[4 * q + 1] + sc[4 * q + 2] + sc[4 * q + 3];
                const float prev0 = q > 0 ? Ep[q - 1] : carry;
                const float add = hh ? Ep[q] : prev0;
                __hip_atomic_fetch_add(IMP + tq * 32 + 8 * t + 2 * q + hh, Gs + add, __ATOMIC_RELAXED, __HIP_MEMORY_SCOPE_WORKGROUP);
            }
            carry = Ep[3];
        }
#pragma unroll
        for (int r = 0; r < 16; ++r) { out[0][r] *= gate[0]; out[1][r] *= gate[0]; }
    }
    __syncthreads();
    {
        const int tkn = c.tid >> 3, sub = c.tid & 7;
        unsigned mask;
        if (qb < 8) mask = (1u << (qb + 1)) - 1u;
        else {
            mask = 1u | (1u << qb) | (1u << (qb - 1));
            const f32x4 iv = *(const LAS f32x4*)(IMP + tkn * 32 + sub * 4);
            float v[4];
#pragma unroll
            for (int e = 0; e < 4; ++e) { const int j = sub * 4 + e; v[e] = (j >= 1 && j <= qb - 2) ? iv[e] : -1.0f; }
#pragma unroll 1
            for (int pick = 0; pick < 5; ++pick) {
                float bv = v[0]; int bj = sub * 4;
#pragma unroll
                for (int e = 1; e < 4; ++e) if (v[e] > bv) { bv = v[e]; bj = sub * 4 + e; }
#define TOPK_STEP(CTRL) { const float pv_ = dppmov<CTRL>(bv); const int pj_ = __builtin_amdgcn_update_dpp(0, bj, CTRL, 0xf, 0xf, true); const bool t_ = pv_ > bv || (pv_ == bv && pj_ < bj); bv = t_ ? pv_ : bv; bj = t_ ? pj_ : bj; }
                TOPK_STEP(0xB1) TOPK_STEP(0x4E) TOPK_STEP(0x141)
#undef TOPK_STEP
                if (bv < 0.f) break;
                mask |= 1u << bj;
#pragma unroll
                for (int e = 0; e < 4; ++e) if (sub * 4 + e == bj) v[e] = -1.0f;
            }
        }
        if (sub == 0) { SEL[tkn] = mask; __hip_atomic_fetch_or(SEL + 64, mask, __ATOMIC_RELAXED, __HIP_MEMORY_SCOPE_WORKGROUP); }
    }
    __syncthreads();
    const unsigned selmask = SEL[tq];
    const unsigned anysel = SEL[64] & ((2u << qb) - 1u);
    {
        bf16x8 qr[4]; load_q<true>(c, qp, pos, hh, qr);
        flash_lds<0>(c, c.ksr() + (size_t)(b * 2 + kvh) * SEQ * 64, c.vst() + (size_t)(b * 2 + kvh) * 64 * SEQ, anysel, qr, tq, qb, selmask, n, hh, w & 1, gate[1], out);
        const unsigned wmask = ((2u << qb) - 1u) & ~((qb >= 4) ? ((1u << (qb - 4)) - 1u) : 0u);
        flash_lds<1>(c, c.kwr() + (size_t)(b * 2 + kvh) * SEQ * 64, c.vwt() + (size_t)(b * 2 + kvh) * 64 * SEQ, wmask, qr, tq, qb, 0xffffffffu, n, hh, w & 1, gate[2], out);
    }
    bf16_t* yp = c.xn() + ((size_t)b * SEQ + pos) * DM + 512 + head * 64 + 4 * hh;
#pragma unroll
    for (int rb = 0; rb < 2; ++rb)
#pragma unroll
        for (int q = 0; q < 4; ++q) { u32x2 wv; wv.x = cvt_pk_bf16(out[rb][4 * q], out[rb][4 * q + 1]); wv.y = cvt_pk_bf16(out[rb][4 * q + 2], out[rb][4 * q + 3]); if (ABL & 2) wv = (u32x2){0u, 0u}; *(u32x2*)(yp + 32 * rb + 8 * q) = wv; }
    __syncthreads();
}

DI void p5_moe_weights(const Ctx& c) {
    const float* w1 = c.in(I_MW1); const float* w2 = c.in(I_MW2);
    for (int it = c.bid; it < 4096 + 2048; it += c.G) {
        if (it < 4096) {
            const int e = it >> 7, r = it & 127, ntile = r >> 4, kt = r & 15;
            tconv_big_fp8(c, w1 + (size_t)e * DM * 2048, 2048, c.w1t() + (size_t)e * 2048 * DM, DM, kt * 64, ntile * 256,
                          [](int nn) { const int half = nn >> 10, jn = nn & 1023; return (jn >> 7) * 256 + half * 128 + (jn & 127); }, 32.0f);
        } else {
            const int j = it - 4096, e = j >> 6, r = j & 63, ntile = r >> 4, kt = r & 15;
            tconv_big_fp8(c, w2 + (size_t)e * DFF * DM, DM, c.w2t() + (size_t)e * DM * DFF, DFF, kt * 64, ntile * 256, [](int nn) { return nn; }, 32.0f);
        }
    }
}

DI void p6_router(const Ctx& c, int dry) {
    LAS float* LN2 = (LAS float*)c.lds;
    for (int i = c.tid; i < DM; i += NTHREADS) LN2[i] = c.in(I_LN2)[i];
    __syncthreads();
    const float* x1 = c.out; unsigned char* hb = c.h8(); const bf16_t* wt = c.wrt();
    int* cnt = c.ctl(); int* ids = c.ids(); float* rsl = c.rsl(); unsigned* tp = (unsigned*)(c.ws + WS_TP); float* tg = (float*)(c.ws + WS_TG);
    const int n = c.lane & 31, hh = c.lane >> 5;
    const float* br = c.in(I_MBR);
    const int gw = c.bid * 8 + c.wave, nw = c.G * 8;
    LAS int* LCNT = (LAS int*)(c.lds + 8192); LAS int* LBASE = LCNT + 32;
    if (c.tid < NEXP) LCNT[c.tid] = 0;
    __syncthreads();
    for (int t0b = c.bid * 256; t0b < T_TOK; t0b += c.G * 256) {
        const int t0 = t0b + c.wave * 32; const bool live = t0 < T_TOK; const int tok = live ? t0 + n : n;
        const float* xp = x1 + (size_t)tok * DM + 8 * hh; unsigned char* hp = hb + (size_t)tok * DM + 8 * hh;
        const bf16_t* wp = wt + (size_t)n * DM + 8 * hh;
        f32x16 acc = zero16(); float ss = 0.f;
#pragma unroll 4
        for (int s = 0; s < 64; ++s) {
            const f32x4 xa = __builtin_nontemporal_load((const f32x4*)(xp + 16 * s)), xb = __builtin_nontemporal_load((const f32x4*)(xp + 16 * s + 4));
            const f32x4 ga = *(const LAS f32x4*)(LN2 + 16 * s + 8 * hh), gb = *(const LAS f32x4*)(LN2 + 16 * s + 8 * hh + 4);
            float v[8];
#pragma unroll
            for (int j = 0; j < 4; ++j) { v[j] = xa[j] * ga[j]; v[4 + j] = xb[j] * gb[j]; }
            u32x4 ph, pl;
#pragma unroll
            for (int j = 0; j < 4; ++j) { ss += v[2 * j] * v[2 * j] + v[2 * j + 1] * v[2 * j + 1]; ph[j] = cvt_pk_bf16(v[2 * j], v[2 * j + 1]); pl[j] = cvt_pk_bf16(v[2 * j] - bflo(ph[j]), v[2 * j + 1] - bfhi(ph[j])); }
            { u32x2 w8; w8.x = cvt4_fp8(v[0], v[1], v[2], v[3]); w8.y = cvt4_fp8(v[4], v[5], v[6], v[7]); *(u32x2*)(hp + 16 * s) = w8; }
            const bf16x8 whi = *(const bf16x8*)(wp + 16 * s), wlo = *(const bf16x8*)(wp + NEXP * DM + 16 * s);
            const bf16x8 xhi = __builtin_bit_cast(bf16x8, ph), xlo = __builtin_bit_cast(bf16x8, pl);
            acc = mfma32(whi, xhi, acc); acc = mfma32(wlo, xhi, acc); acc = mfma32(whi, xlo, acc);
        }
        ss = pair_sum(ss);
        const float rs = rsqrtf(ss * (1.0f / DM) + 1e-6f);
        float tv[4] = {-3.0e38f, -3.0e38f, -3.0e38f, -3.0e38f}; int te[4] = {0, 0, 0, 0};
#pragma unroll
        for (int r = 0; r < 16; ++r) {
            const int e = crow(r, hh); const float lg = acc[r] * rs + br[e];
            const bool b0 = lg > tv[0], b1 = lg > tv[1], b2 = lg > tv[2], b3 = lg > tv[3];
            tv[3] = b2 ? tv[2] : (b3 ? lg : tv[3]); te[3] = b2 ? te[2] : (b3 ? e : te[3]);
            tv[2] = b1 ? tv[1] : (b2 ? lg : tv[2]); te[2] = b1 ? te[1] : (b2 ? e : te[2]);
            tv[1] = b0 ? tv[0] : (b1 ? lg : tv[1]); te[1] = b0 ? te[0] : (b1 ? e : te[1]);
            tv[0] = b0 ? lg : tv[0]; te[0] = b0 ? e : te[0];
        }
        float pv[4]; int pe[4];
#pragma unroll
        for (int k = 0; k < 4; ++k) { pv[k] = __shfl_xor(tv[k], 32); pe[k] = __shfl_xor(te[k], 32); }
#pragma unroll
        for (int k = 0; k < 4; ++k) {
            const float lg = pv[k]; const int e = pe[k];
            const bool b0 = lg > tv[0] || (lg == tv[0] && e < te[0]), b1 = lg > tv[1] || (lg == tv[1] && e < te[1]), b2 = lg > tv[2] || (lg == tv[2] && e < te[2]), b3 = lg > tv[3] || (lg == tv[3] && e < te[3]);
            tv[3] = b2 ? tv[2] : (b3 ? lg : tv[3]); te[3] = b2 ? te[2] : (b3 ? e : te[3]);
            tv[2] = b1 ? tv[1] : (b2 ? lg : tv[2]); te[2] = b1 ? te[1] : (b2 ? e : te[2]);
            tv[1] = b0 ? tv[0] : (b1 ? lg : tv[1]); te[1] = b0 ? te[0] : (b1 ? e : te[1]);
            tv[0] = b0 ? lg : tv[0]; te[0] = b0 ? e : te[0];
        }
        const float e1 = __expf(tv[1] - tv[0]), e2 = __expf(tv[2] - tv[0]), e3 = __expf(tv[3] - tv[0]), inv = 1.0f / (1.0f + e1 + e2 + e3);
        int exs[2], lps[2]; float gvs[2];
#pragma unroll
        for (int kk = 0; kk < 2; ++kk) {
            exs[kk] = hh ? (kk ? te[3] : te[2]) : (kk ? te[1] : te[0]);
            gvs[kk] = (hh ? (kk ? e3 : e2) : (kk ? e1 : 1.0f)) * inv;
            lps[kk] = (live && !dry) ? __hip_atomic_fetch_add(LCNT + exs[kk], 1, __ATOMIC_RELAXED, __HIP_MEMORY_SCOPE_WORKGROUP) : 0;
        }
        __syncthreads();
        if (c.tid < NEXP) { const int nloc = LCNT[c.tid]; LBASE[c.tid] = nloc > 0 ? atomicAdd(cnt + c.tid, nloc) : 0; }
        __syncthreads();
        if (live && !dry) {
#pragma unroll
            for (int kk = 0; kk < 2; ++kk) {
                const int k = 2 * hh + kk, li = exs[kk], ps = LBASE[li] + lps[kk];
                ids[(size_t)li * T_TOK + ps] = tok; rsl[(size_t)li * T_TOK + ps] = rs;
                tp[(size_t)tok * 4 + k] = ((unsigned)li << 24) | (unsigned)ps; tg[(size_t)tok * 4 + k] = gvs[kk];
            }
        }
        __syncthreads();
        if (c.tid < NEXP) LCNT[c.tid] = 0;
        __syncthreads();
    }
    __syncthreads();
}

constexpr int DIR_OFF = STAGE_BYTES;
DI MoeDir moe_dir_build(const Ctx& c) {
    LAS int* pref = (LAS int*)(c.lds + DIR_OFF); LAS int* cn = pref + 160; LAS int* rpref = pref + 320;
    if (c.tid < NLIST) cn[c.tid] = c.ctl()[c.tid];
    __syncthreads();
    if (c.tid == 0) { int s = 0; for (int l = 0; l < NLIST; ++l) { pref[l] = s; s += (cn[l] + BM - 1) / BM; } pref[NLIST] = s; }
    __syncthreads();
    MoeDir d; d.pref = pref; d.cnt = cn; d.rpref = rpref; return d;
}

DI void p9_combine(const Ctx& c, const MoeDir& dir, float gmul) {
    const unsigned* tp = (const unsigned*)(c.ws + WS_TP); const float* tg = (const float*)(c.ws + WS_TG);
    const int gw = c.bid * 8 + c.wave, nw = c.G * 8;
    for (int tok = gw; tok < T_TOK; tok += nw) {
        const u32x4 pv = *(const u32x4*)(tp + (size_t)tok * 4); const f32x4 gv = *(const f32x4*)(tg + (size_t)tok * 4);
        const bf16_t* yr[4];
#pragma unroll
        for (int k = 0; k < 4; ++k) { const int li = pv[k] >> 24, ps = pv[k] & 0xffffff; yr[k] = (const bf16_t*)(c.ws + y_row_off(dir.pref[li] * BM + ps)); }
        float* op = c.out + (size_t)tok * DM;
#pragma unroll
        for (int i = 0; i < 4; ++i) {
            const int col = (c.lane + 64 * i) * 4;
            f32x4 a = __builtin_nontemporal_load((const f32x4*)(op + col));
#pragma unroll
            for (int k = 0; k < 4; ++k) { const u32x2 y = __builtin_nontemporal_load((const u32x2*)(yr[k] + col)); const float g = gv[k] * gmul; a[0] += g * bflo(y.x); a[1] += g * bfhi(y.x); a[2] += g * bflo(y.y); a[3] += g * bfhi(y.y); }
            __builtin_nontemporal_store(a, (f32x4*)(op + col));
        }
    }
}

#define XB_TMO      128
#define XB_XCNT(j)  (256  + 64 * (j))
#define XB_XSUB(j)  (1280 + 64 * (j))
#define XB_XGEN(j)  (2304 + 64 * (j))
#define XB_TOP      3328
#define XB_TOPGEN   3392
#define XCD_BAR_WORDS 3456
#define XB_SPIN_CAP (1u << 20)
DI unsigned xb_ld(unsigned* p) { return __hip_atomic_load(p, __ATOMIC_RELAXED, __HIP_MEMORY_SCOPE_AGENT); }
DI unsigned xb_add(unsigned* p, unsigned v) { return __hip_atomic_fetch_add(p, v, __ATOMIC_RELAXED, __HIP_MEMORY_SCOPE_AGENT); }
DI unsigned xb_xcc_id() { return (unsigned)__builtin_amdgcn_s_getreg((3 << 11) | 20) & 0xFu; }
#define XB_SPIN(cond, bar) do { unsigned _sp = 0; while (cond) { __builtin_amdgcn_s_sleep(1); \
    if ((++_sp & 255u) == 0u) { if (xb_ld(&(bar)[XB_TMO])) break; if (_sp > XB_SPIN_CAP) { atomicAdd(&(bar)[XB_TMO], 1u); break; } } } } while (0)
struct XcdBarrier { unsigned* bar; unsigned x; volatile LAS unsigned* st; };
DI XcdBarrier xcd_barrier_post(unsigned* bar, volatile LAS unsigned* st) {
    XcdBarrier b; b.bar = bar; b.x = xb_xcc_id(); b.st = st;
    if (threadIdx.x == 0) (void)xb_add(&bar[XB_XCNT(b.x)], 1u);
    return b;
}
DI void xcd_barrier_complete(unsigned* bar, unsigned x, unsigned& nloc, unsigned& nx) {
    const unsigned G = gridDim.x * gridDim.y * gridDim.z;
    unsigned sum, cnt, mine, sp = 0u;
    for (;;) {
        sum = 0u; cnt = 0u; mine = 0u;
#pragma unroll
        for (unsigned j = 0; j < 16; ++j) { const unsigned cc = xb_ld(&bar[XB_XCNT(j)]); sum += cc; cnt += (cc > 0u) ? 1u : 0u; mine = (j == x) ? cc : mine; }
        if (sum == G) break;
        __builtin_amdgcn_s_sleep(1);
        if ((++sp & 255u) == 0u) { if (xb_ld(&bar[XB_TMO])) break; if (sp > XB_SPIN_CAP) { atomicAdd(&bar[XB_TMO], 1u); break; } }
    }
    nloc = mine > 0u ? mine : 1u; nx = cnt > 0u ? cnt : 1u;
}
DI void xcd_barrier(const XcdBarrier& b) {
    asm volatile("s_waitcnt vmcnt(0)" ::: "memory");
    __syncthreads();
    if (threadIdx.x == 0) {
        unsigned* bar = b.bar;
        __builtin_amdgcn_s_waitcnt(0);
        unsigned nloc = b.st[0], nx = b.st[1];
        if (nloc == 0u) { xcd_barrier_complete(bar, b.x, nloc, nx); b.st[0] = nloc; b.st[1] = nx; }
        const unsigned old = xb_add(&bar[XB_XSUB(b.x)], 1u);
        const unsigned gen = old / nloc;
        if (old + 1u == (gen + 1u) * nloc) {
            __builtin_amdgcn_fence(__ATOMIC_RELEASE, "agent");
            asm volatile("s_waitcnt vmcnt(0)" ::: "memory");
            const unsigned og = xb_add(&bar[XB_TOP], 1u);
            const unsigned tg = og / nx;
            if (og + 1u == (tg + 1u) * nx) xb_add(&bar[XB_TOPGEN], 1u);
            else XB_SPIN(xb_ld(&bar[XB_TOPGEN]) == tg, bar);
            __builtin_amdgcn_fence(__ATOMIC_ACQUIRE, "agent");
            xb_add(&bar[XB_XGEN(b.x)], 1u);
            asm volatile("s_waitcnt vmcnt(0)" ::: "memory");
        } else {
            XB_SPIN(xb_ld(&bar[XB_XGEN(b.x)]) == gen, bar);
            __builtin_amdgcn_fence(__ATOMIC_ACQUIRE, "agent");
            asm volatile("s_waitcnt vmcnt(0)" ::: "memory");
        }
    }
    __syncthreads();
}

__global__ void __launch_bounds__(NTHREADS, 2) fwd_kernel(Args a) {
    extern __shared__ __attribute__((aligned(16))) unsigned char lds_raw[];
    Ctx c;
#if defined(__HIP_DEVICE_COMPILE__)
    c.kargs = __builtin_amdgcn_kernarg_segment_ptr();
#endif
    c.out = a.out; c.ws = a.ws; c.lds = (LAS unsigned char*)lds_raw;
    c.tid = threadIdx.x; c.lane = c.tid & 63; c.wave = __builtin_amdgcn_readfirstlane(c.tid >> 6); c.G = gridDim.x; c.bid = blockIdx.x;
    cg::grid_group grid = cg::this_grid();
    volatile LAS unsigned* xbst = (volatile LAS unsigned*)(c.lds + LDS_BYTES - 16);
    if (c.tid == 0) { xbst[0] = 0u; xbst[1] = 0u; }
    __syncthreads();
    XcdBarrier xbar; xbar.bar = (unsigned*)(c.ws + WS_BAR); xbar.x = 0; xbar.st = xbst;
    if (a.coop) xbar = xcd_barrier_post((unsigned*)(c.ws + WS_BAR), xbst);
    const int lo = a.ph_lo, hi = a.ph_hi;
#ifndef PH_MASK
#define PH_MASK 0x303ff
#endif
#define IN(k) (((PH_MASK >> (k)) & 1) && lo <= (k) && (k) < hi)
#define SEAM(k) do { if (a.coop && IN(k) && IN((k) + 1)) { if ((k) == 0) grid.sync(); else xcd_barrier(xbar); } } while (0)
    if (IN(0)) p0_prologue(c);
    SEAM(0);
    if (IN(1)) {
        DenseBf16<14, 0> g{}; g.nt = 16; g.kstepA = 128; g.ldb = DM; g.G = c.G; g.c = c.bid; g.n_rt = T_TOK / BM;
        g.A = c.xn(); g.lda = DM; g.Bt = c.wcat(); g.O = c.proj(); g.ldo = NPROJ; g.bias0 = nullptr; g.bias1 = nullptr; g.bsplit = 0; g.bend = 0;
        gemm_phase(c.lds, g);
    }
    SEAM(1);
    if (IN(2)) {
        p2_prep(c);
        CmpGemm g{}; g.nt = 32; g.kstepA = NPROJ * 2; g.ldb = 2048; g.G = c.G; g.c = c.bid;
        g.proj = c.proj(); g.cw1t = c.cw1t(); g.hid = c.hid(); g.biasc = c.biasc();
        gemm_phase(c.lds, g);
    }
    SEAM(2);
    if (IN(3)) {
        DenseBf16<6, 0> g{}; g.nt = 4; g.kstepA = 128; g.ldb = 256; g.G = c.G; g.c = c.bid; g.n_rt = T_TOK / BM;
        g.A = c.lact(); g.lda = 256; g.Bt = c.wl2t(); g.O = c.lout(); g.ldo = 1536; g.bias0 = c.in(I_W0); g.bias1 = c.in(I_A0); g.bsplit = 512; g.bend = 1024;
        gemm_phase(c.lds, g);
        p3_cmp_finish(c);
    }
    SEAM(3);
    if (IN(4)) {
        for (int rep = 0; rep < 1 + ((REP >> 16) & 1); ++rep) if ((PH_MASK >> 16) & 1) for (int ch = c.bid; ch < NBATCH * 8; ch += c.G) { if (SCAN_V2 == 2) scan_chain3(c, ch); else if (SCAN_V2 == 1) scan_chain2(c, ch); else scan_chain(c, ch); }
        for (int rep = 0; rep < 1 + ((REP >> 17) & 1); ++rep) if ((PH_MASK >> 17) & 1) for (int it = c.bid; it < NBATCH * 2 * 32; it += c.G) attn_item(c, it);
    }
    SEAM(4);
    if (IN(5)) {
        p5_moe_weights(c);
        OutProj g{}; g.nt = 16; g.kstepA = 128; g.ldb = DM; g.G = c.G; g.c = c.bid; g.A = c.xn(); g.Bt = c.woutt(); g.x = c.in(I_X); g.out = c.out;
        gemm_phase(c.lds, g);
    }
    SEAM(5);
    if (IN(6)) p6_router(c, a.dry);
    SEAM(6);
    if (IN(7)) {
        Moe1 g{}; g.nt = 8; g.kstepA = 128; g.ldb = DM / 2; g.G = c.G; g.c = c.bid; g.dir = moe_dir_build(c);
        g.h = c.h8(); g.w1t = c.w1t(); g.b1 = c.in(I_MB1); g.ids = c.ids(); g.rsl = c.rsl(); g.act = c.act();
        gemm_phase_gather(c.lds, g);
    }
    SEAM(7);
    if (IN(8)) {
        Moe2 g{}; g.nt = 8; g.kstepA = 128; g.ldb = DFF / 2; g.G = c.G; g.c = c.bid; g.dir = moe_dir_build(c);
        g.act = c.act(); g.w2t = c.w2t(); g.b2 = c.in(I_MB2); g.ws = c.ws;
        gemm_phase(c.lds, g);
    }
    SEAM(8);
    if (IN(9)) { const MoeDir d = moe_dir_build(c); p9_combine(c, d, (a.dry || (ABL & 4)) ? 0.f : 1.f); }
#undef IN
#undef SEAM
}

#ifndef HOST_SEQ
#define HOST_SEQ 0,1,2,3,4,5,6,7,8,9
#endif
#ifndef MK_MULTI
#define MK_MULTI 0
#endif
#ifndef HOST_REP
#define HOST_REP 0x8
#endif
constexpr int N_PHASES = 10;
extern "C" void kernel_launch(void* const* d_in, const int* in_sizes, int n_in, void* d_out, int out_size, void* d_ws, size_t ws_size, hipStream_t stream) {
    static int grid = 0;
    if (grid == 0) {
        if (n_in != 31 || out_size != T_TOK * DM || ws_size < WS_END) { fprintf(stderr, "kernel_launch: unexpected shapes: n_in %d out %d ws %zu (need %zu)\n", n_in, out_size, ws_size, (size_t)WS_END); grid = -1; return; }
        int dev = 0, cus = 0, per_cu = 0;
        (void)hipGetDevice(&dev); (void)hipDeviceGetAttribute(&cus, hipDeviceAttributeMultiprocessorCount, dev);
        if (hipFuncSetAttribute((const void*)fwd_kernel, hipFuncAttributeMaxDynamicSharedMemorySize, LDS_BYTES) != hipSuccess) { fprintf(stderr, "kernel_launch: hipFuncSetAttribute failed\n"); grid = -1; return; }
        if (hipOccupancyMaxActiveBlocksPerMultiprocessor(&per_cu, (const void*)fwd_kernel, NTHREADS, LDS_BYTES) != hipSuccess || per_cu < 1) { fprintf(stderr, "kernel_launch: occupancy query says %d blocks per CU\n", per_cu); grid = -1; return; }
        grid = cus * 1;
        fprintf(stderr, "kernel_launch: cus %d per_cu %d grid %d\n", cus, per_cu, grid);
    }
    if (grid < 0) return;
    Args a{};
    for (int i = 0; i < 31; ++i) a.in[i] = (const float*)d_in[i];
    a.out = (float*)d_out; a.ws = (unsigned char*)d_ws; a.dry = 0;
#if MK_MULTI
    static const int seq[] = {HOST_SEQ};
    for (unsigned i = 0; i < sizeof(seq) / sizeof(seq[0]); ++i) { const int p = seq[i] % 100; a.ph_lo = p; a.ph_hi = p + 1; a.coop = 0; a.dry = seq[i] >= 100; hipLaunchKernelGGL(fwd_kernel, dim3(grid), dim3(NTHREADS), LDS_BYTES, stream, a); }
#else
    a.ph_lo = 0; a.ph_hi = N_PHASES; a.coop = 1;
    if (hipMemsetAsync((char*)d_ws + WS_BAR, 0, XCD_BAR_WORDS * sizeof(unsigned), stream) != hipSuccess) { fprintf(stderr, "kernel_launch: hipMemsetAsync of the barrier words failed\n"); return; }
    void* args[] = {&a};
    hipError_t e = hipLaunchCooperativeKernel((const void*)fwd_kernel, dim3(grid), dim3(NTHREADS), args, LDS_BYTES, stream);
    if (e != hipSuccess) fprintf(stderr, "kernel_launch: cooperative launch failed: %s (grid %d)\n", hipGetErrorString(e), grid);
#endif
}
```

```cpp
#include <hip/hip_runtime.h>
#include <hip/hip_cooperative_groups.h>
#include <cstdio>
#include <cstdint>
namespace cg = cooperative_groups;

#define LAS __attribute__((address_space(3)))
#define DI __device__ __forceinline__
typedef unsigned short bf16_t;
typedef short bf16x8 __attribute__((ext_vector_type(8)));
typedef float f32x4 __attribute__((ext_vector_type(4)));
typedef float f32x2 __attribute__((ext_vector_type(2)));
typedef float f32x16 __attribute__((ext_vector_type(16)));
typedef unsigned u32x4 __attribute__((ext_vector_type(4)));
typedef unsigned u32x2 __attribute__((ext_vector_type(2)));

#ifndef ABL
#define ABL 0
#endif
#ifndef SCAN_V2
#define SCAN_V2 2
#endif
#ifndef REP
#define REP 0
#endif
constexpr int T_TOK = 65536, SEQ = 2048, NBATCH = 32, DM = 1024;
constexpr int NPROJ = 3584;
constexpr int C_R = 0, C_K = 512, C_V = 1024, C_Q = 1536, C_KC = 2048, C_VC = 2176, C_KS = 2304, C_VS = 2432, C_KW = 2560, C_VW = 2688, C_GL = 2816;
constexpr int N_IN_REAL = 2840, C_L1 = 2840, C_L2 = 3096, C_LEND = 3352;
constexpr int NEXP = 32, DFF = 1024;
constexpr int NTHREADS = 512;
constexpr int LDS_BYTES = 160 * 1024;

constexpr size_t MiB = 1ull << 20;
constexpr size_t WS_XN = 0;
constexpr size_t WS_PROJ = 128 * MiB;
constexpr size_t WS_KSR = 576 * MiB;
constexpr size_t WS_KWR = 592 * MiB;
constexpr size_t WS_VST = 608 * MiB;
constexpr size_t WS_VWT = 624 * MiB;
constexpr size_t WS_LOUT = 640 * MiB;
constexpr size_t WS_LACT = 832 * MiB;
constexpr size_t WS_WCAT = 864 * MiB;
constexpr size_t WS_WOUT = 871 * MiB;
constexpr size_t WS_CW1 = 873 * MiB;
constexpr size_t WS_WL2 = 875 * MiB;
constexpr size_t WS_HID = 876 * MiB;
constexpr size_t WS_KCMP = 884 * MiB;
constexpr size_t WS_VCMPT = 885 * MiB;
constexpr size_t WS_ROPE = 886 * MiB;
constexpr size_t WS_BIASC = 887 * MiB;
constexpr size_t WS_RSL = 968 * MiB;
constexpr size_t WS_CTL = 1000 * MiB;
constexpr size_t WS_WRT = 886 * MiB + 524288;
constexpr size_t WS_IDS = 904 * MiB;
constexpr size_t WS_GTS = 936 * MiB;
constexpr size_t WS_X1B = 640 * MiB;
constexpr size_t WS_W1T = 128 * MiB;
constexpr size_t WS_W2T = 192 * MiB;
constexpr size_t WS_ACT = 320 * MiB;
constexpr size_t WS_TP = 1001 * MiB;
constexpr size_t WS_TG = 1002 * MiB;
constexpr size_t WS_BAR = 1003 * MiB;
constexpr size_t WS_END = 1004 * MiB;
#define DI_EARLY __device__ __forceinline__
constexpr float YSCALE = 16.0f;
DI_EARLY size_t y8_row_off(int r) { return r < 196608 ? (size_t)r * 1024 : 224 * MiB + (size_t)(r - 196608) * 1024; }
DI_EARLY size_t y_row_off(int r) { return r < 98304 ? (size_t)r * 2048 : (r < 147456 ? 224 * MiB + (size_t)(r - 98304) * 2048 : 608 * MiB + (size_t)(r - 147456) * 2048); }

struct Args {
    const float* in[31];
    float* out;
    unsigned char* ws;
    int ph_lo, ph_hi, coop, dry;
};

DI float bf2f(bf16_t b) { return __uint_as_float(((unsigned)b) << 16); }
typedef __bf16 bf16v2_t __attribute__((ext_vector_type(2)));
DI unsigned cvt_pk_bf16(float lo, float hi) { f32x2 v = {lo, hi}; bf16v2_t r = __builtin_convertvector(v, bf16v2_t); return __builtin_bit_cast(unsigned, r); }
DI bf16_t f2bf(float f) { return (bf16_t)(cvt_pk_bf16(f, 0.f) & 0xffffu); }
DI float bflo(unsigned u) { return __uint_as_float(u << 16); }
DI float bfhi(unsigned u) { return __uint_as_float(u & 0xffff0000u); }
DI float wave_sum(float v) { for (int o = 32; o > 0; o >>= 1) v += __shfl_xor(v, o); return v; }
template <int CTRL> DI float dppmov(float x) { return __int_as_float(__builtin_amdgcn_update_dpp(0, __float_as_int(x), CTRL, 0xf, 0xf, true)); }
DI float red8(float x) { x += dppmov<0xB1>(x); x += dppmov<0x4E>(x); x += dppmov<0x141>(x); return x; }
DI float red16(float x) { x = red8(x); x += dppmov<0x140>(x); return x; }
DI float sigmoidf_(float x) { return __builtin_amdgcn_rcpf(1.0f + __expf(-x)); }
DI float tanhf_(float x) { float e = __expf(2.0f * x); return 1.0f - 2.0f * __builtin_amdgcn_rcpf(e + 1.0f); }
DI float gelu_tanh(float x) { float u = 0.7978845608028654f * (x + 0.044715f * x * x * x); return 0.5f * x * (1.0f + tanhf_(u)); }

constexpr int BM = 256, BK = 64, HALF = 128, HTB = HALF * BK * 2, STAGE_BYTES = 8 * HTB;
constexpr int AUX_OFF = STAGE_BYTES + 4096, AUX_SLOT = 3072;
DI int lds_byte(int r, int c) { const int st = (r >> 4) * 2 + (c >> 5), rr = r & 15, cc = c & 31, ob = rr * 64 + cc * 2; return st * 1024 + (ob ^ (((ob >> 9) & 1) << 5)); }
DI void stage_rc(int b, int& R, int& C) { const int st = b / 1024, sb = b % 1024, swz = sb ^ (((sb >> 9) & 1) << 5); R = (st >> 1) * 16 + swz / 64; C = (st & 1) * 32 + (swz % 64) / 2; }
DI int perm32(int rho) { const int n = rho >> 4, i = rho & 15; return 8 * (i >> 2) + 4 * n + (i & 3); }

typedef int v8i_t __attribute__((ext_vector_type(8)));
typedef int v4i_t __attribute__((ext_vector_type(4)));
template <bool FP8> struct FragT;
template <> struct FragT<false> { bf16x8 k[2]; };
template <> struct FragT<true> { v8i_t v; };
DI void ld_frag(FragT<false>& f, const LAS unsigned char* p0, const LAS unsigned char* p1) { f.k[0] = *(const LAS bf16x8*)p0; f.k[1] = *(const LAS bf16x8*)p1; }
DI void ld_frag(FragT<true>& f, const LAS unsigned char* p0, const LAS unsigned char* p1) { const v4i_t lo = *(const LAS v4i_t*)p0, hi = *(const LAS v4i_t*)p1; f.v = __builtin_shufflevector(lo, hi, 0, 1, 2, 3, 4, 5, 6, 7); }
DI f32x4 mma_frag(const FragT<false>& b, const FragT<false>& a, f32x4 cacc) { cacc = __builtin_amdgcn_mfma_f32_16x16x32_bf16(b.k[0], a.k[0], cacc, 0, 0, 0); return __builtin_amdgcn_mfma_f32_16x16x32_bf16(b.k[1], a.k[1], cacc, 0, 0, 0); }
DI f32x4 mma_frag(const FragT<true>& b, const FragT<true>& a, f32x4 cacc) {
    const int sc = 0x7f7f7f7f;
    asm volatile("v_mfma_scale_f32_16x16x128_f8f6f4 %0, %1, %2, %0, %3, %3 op_sel_hi:[0,0,0]" : "+v"(cacc) : "v"(b.v), "v"(a.v), "v"(sc));
    return cacc;
}
DI unsigned cvt4_fp8(float a, float b, float cc, float d) { unsigned w = 0; w = __builtin_amdgcn_cvt_pk_fp8_f32(a, b, w, false); w = __builtin_amdgcn_cvt_pk_fp8_f32(cc, d, w, true); return w; }
struct Unit { int rt, pn, e, rl; };

template <class P>
DI void gemm_phase(LAS unsigned char* lds, const P& S) {
    const int tid = threadIdx.x, wid = __builtin_amdgcn_readfirstlane(tid >> 6), lane = tid & 63, wr = wid >> 2, wc = wid & 3, fr = lane & 15, fq = lane >> 4;
    const int nt = S.nt;
    int R[2], C[2]; unsigned voffB[2];
#pragma unroll
    for (int i = 0; i < 2; ++i) { stage_rc(tid * 16 + i * 8192, R[i], C[i]); const int Rb = P::PERM ? ((R[i] & ~31) + perm32(R[i] & 31)) : R[i]; voffB[i] = (unsigned)(Rb * S.ldb + C[i]) * 2u; }
    const size_t kstepA = (size_t)S.kstepA, kstepB = (size_t)(BK * 2);
    const size_t hstepB = (size_t)HALF * S.ldb * 2;
    const unsigned ldsw = (unsigned)wid * 1024u;
    const int aoff0 = lds_byte(wr * 64 + fr, fq * 8), aoff1 = aoff0 + 1024;
    const int boff0 = lds_byte(wc * 32 + fr, fq * 8), boff1 = boff0 + 1024;
#define G_SA(b, h) (((b) * 2 + (h)) * HTB)
#define G_SB(b, h) ((4 + (b) * 2 + (h)) * HTB)
#define G_STAGE(bufoff, gbase, voff) do { _Pragma("unroll") for (int _i = 0; _i < 2; ++_i) \
        __builtin_amdgcn_global_load_lds((const unsigned*)((const char*)(gbase) + (voff)[_i]), (LAS unsigned*)(lds + (bufoff) + ldsw + _i * 8192), 16, 0, 0); } while (0)
#define G_LDA(dst, b, h) do { _Pragma("unroll") for (int m = 0; m < 4; ++m) ld_frag(dst[m], lds + G_SA(b, h) + aoff0 + m * 2048, lds + G_SA(b, h) + aoff1 + m * 2048); } while (0)
#define G_LDB(dst, b, h) do { _Pragma("unroll") for (int n = 0; n < 2; ++n) ld_frag(dst[n], lds + G_SB(b, h) + boff0 + n * 2048, lds + G_SB(b, h) + boff1 + n * 2048); } while (0)
#define G_MMA(ai, bj, At, Bt) do { __builtin_amdgcn_s_setprio(1); _Pragma("unroll") for (int m = 0; m < 4; ++m) _Pragma("unroll") for (int n = 0; n < 2; ++n) \
        acc[ai][bj][m][n] = mma_frag(Bt[n], At[m], acc[ai][bj][m][n]); __builtin_amdgcn_s_setprio(0); } while (0)
#define G_WAIT_V(n) asm volatile("s_waitcnt vmcnt(" #n ")" ::: "memory")
#define G_WAIT_L(n) asm volatile("s_waitcnt lgkmcnt(" #n ")" ::: "memory")
#define G_BAR __builtin_amdgcn_s_barrier()
#define G_SCHED __builtin_amdgcn_sched_barrier(0)
    Unit cur, nxt; int ui = 0;
    if (!S.next(0, cur)) return;
    f32x4 acc[2][2][4][2];
#pragma unroll
    for (int a = 0; a < 2; ++a)
#pragma unroll
        for (int b = 0; b < 2; ++b)
#pragma unroll
            for (int m = 0; m < 4; ++m)
#pragma unroll
                for (int n = 0; n < 2; ++n) acc[a][b][m][n] = (f32x4){0.f, 0.f, 0.f, 0.f};
    FragT<P::FP8> At[4], B0[2], B1[2];
    const char* cA; unsigned coff[2][2];
    S.a_src(cur, R, C, cA, coff);
    const char* cB = S.b_src(cur);
    if constexpr (P::AUX) S.aux_issue(cur, lds + AUX_OFF, lane);
    G_STAGE(G_SB(0, 0), cB, voffB); G_STAGE(G_SB(0, 1), cB + hstepB, voffB); G_STAGE(G_SA(0, 0), cA, coff[0]); G_STAGE(G_SA(0, 1), cA, coff[1]);
    if (wr == 1) G_BAR;
    G_WAIT_V(2); G_BAR;
    G_STAGE(G_SB(1, 0), cB + kstepB, voffB); G_STAGE(G_SA(1, 0), cA + kstepA, coff[0]); G_STAGE(G_SB(1, 1), cB + hstepB + kstepB, voffB);
    G_WAIT_V(6); G_BAR;
    for (;;) {
        const bool has_next = S.next(ui + 1, nxt);
        const char* nA = cA; unsigned noff[2][2] = {{coff[0][0], coff[0][1]}, {coff[1][0], coff[1][1]}}; const char* nB = cB;
        if (has_next) { S.a_src(nxt, R, C, nA, noff); nB = S.b_src(nxt); }
        for (int t = 0; t < nt; t += 2) {
            const bool last = (t == nt - 2);
            const char* a1 = cA + (size_t)(t + 1) * kstepA;
            const char* a2 = last ? nA : cA + (size_t)(t + 2) * kstepA; const char* b2 = last ? nB : cB + (size_t)(t + 2) * kstepB;
            const char* a3 = a2 + kstepA; const char* b3 = b2 + kstepB;
            unsigned o2[2][2]; const unsigned lmask = last ? 0xffffffffu : 0u;
#pragma unroll
            for (int h = 0; h < 2; ++h)
#pragma unroll
                for (int i = 0; i < 2; ++i) o2[h][i] = coff[h][i] ^ ((coff[h][i] ^ noff[h][i]) & lmask);
            G_LDB(B0, 0, 0); G_LDB(B1, 0, 1); G_SCHED; G_LDA(At, 0, 0); G_STAGE(G_SA(1, 1), a1, coff[1]);
            G_WAIT_V(8); G_WAIT_L(0); G_BAR; G_MMA(0, 0, At, B0); G_MMA(0, 1, At, B1); G_BAR; G_SCHED;
            G_LDA(At, 0, 1); G_STAGE(G_SB(0, 0), b2, voffB); G_STAGE(G_SB(0, 1), b2 + hstepB, voffB); G_STAGE(G_SA(0, 0), a2, o2[0]);
            G_WAIT_V(8); G_WAIT_L(0); G_BAR; G_MMA(1, 0, At, B0); G_MMA(1, 1, At, B1); G_BAR; G_SCHED;
            G_LDB(B0, 1, 0); G_LDB(B1, 1, 1); G_SCHED; G_LDA(At, 1, 0); G_STAGE(G_SA(0, 1), a2, o2[1]);
            G_WAIT_V(8); G_WAIT_L(0); G_BAR; G_MMA(0, 0, At, B0); G_MMA(0, 1, At, B1); G_BAR; G_SCHED;
            G_LDA(At, 1, 1); G_STAGE(G_SB(1, 0), b3, voffB); G_STAGE(G_SB(1, 1), b3 + hstepB, voffB); G_STAGE(G_SA(1, 0), a3, o2[0]);
            G_WAIT_V(8); G_WAIT_L(0); G_BAR; G_MMA(1, 0, At, B0); G_MMA(1, 1, At, B1); G_BAR; G_SCHED;
        }
        if (wr == 0) G_BAR;
        if (P::FP8) asm volatile("s_nop 15\n\ts_nop 15" ::: "memory");
        S.epi(acc, cur, wr, wc, fr, fq, lds + AUX_OFF + (ui & 1) * AUX_SLOT);
        if (!has_next) break;
#pragma unroll
        for (int a = 0; a < 2; ++a)
#pragma unroll
            for (int b = 0; b < 2; ++b)
#pragma unroll
                for (int m = 0; m < 4; ++m)
#pragma unroll
                    for (int n = 0; n < 2; ++n) acc[a][b][m][n] = (f32x4){0.f, 0.f, 0.f, 0.f};
        if (P::FP8) asm volatile("s_nop 7" ::: "memory");
        cur = nxt; cA = nA; cB = nB; ++ui;
        if constexpr (P::AUX) S.aux_issue(cur, lds + AUX_OFF + (ui & 1) * AUX_SLOT, lane);
        if (wr == 1) G_BAR;
#pragma unroll
        for (int h = 0; h < 2; ++h)
#pragma unroll
            for (int i = 0; i < 2; ++i) coff[h][i] = noff[h][i];
    }
    G_WAIT_V(0);
    G_BAR;
#undef G_SA
#undef G_SB
#undef G_STAGE
#undef G_LDA
#undef G_LDB
#undef G_MMA
#undef G_WAIT_V
#undef G_WAIT_L
#undef G_BAR
#undef G_SCHED
}

template <class P>
DI void gemm_phase_gather(LAS unsigned char* lds, const P& S) {
    const int tid = threadIdx.x, wid = __builtin_amdgcn_readfirstlane(tid >> 6), lane = tid & 63, wr = wid >> 2, wc = wid & 3, fr = lane & 15, fq = lane >> 4;
    const int nt = S.nt;
    int R[2], C[2]; unsigned voffB[2];
#pragma unroll
    for (int i = 0; i < 2; ++i) { stage_rc(tid * 16 + i * 8192, R[i], C[i]); const int Rb = P::PERM ? ((R[i] & ~31) + perm32(R[i] & 31)) : R[i]; voffB[i] = (unsigned)(Rb * S.ldb + C[i]) * 2u; }
    const size_t kstepA = (size_t)S.kstepA, kstepB = (size_t)(BK * 2);
    const size_t hstepB = (size_t)HALF * S.ldb * 2;
    const unsigned ldsw = (unsigned)wid * 1024u;
    const int aoff0 = lds_byte(wr * 64 + fr, fq * 8), aoff1 = aoff0 + 1024;
    const int boff0 = lds_byte(wc * 32 + fr, fq * 8), boff1 = boff0 + 1024;
#define G_SA(b, h) (((b) * 2 + (h)) * HTB)
#define G_SB(b, h) ((4 + (b) * 2 + (h)) * HTB)
#define G_STAGE(bufoff, gbase, voff) do { _Pragma("unroll") for (int _i = 0; _i < 2; ++_i) \
        __builtin_amdgcn_global_load_lds((const unsigned*)((const char*)(gbase) + (voff)[_i]), (LAS unsigned*)(lds + (bufoff) + ldsw + _i * 8192), 16, 0, 0); } while (0)
#define G_LDA(dst, b, h) do { _Pragma("unroll") for (int m = 0; m < 4; ++m) ld_frag(dst[m], lds + G_SA(b, h) + aoff0 + m * 2048, lds + G_SA(b, h) + aoff1 + m * 2048); } while (0)
#define G_LDB(dst, b, h) do { _Pragma("unroll") for (int n = 0; n < 2; ++n) ld_frag(dst[n], lds + G_SB(b, h) + boff0 + n * 2048, lds + G_SB(b, h) + boff1 + n * 2048); } while (0)
#define G_MMA(ai, bj, At, Bt) do { __builtin_amdgcn_s_setprio(1); _Pragma("unroll") for (int m = 0; m < 4; ++m) _Pragma("unroll") for (int n = 0; n < 2; ++n) \
        acc[ai][bj][m][n] = mma_frag(Bt[n], At[m], acc[ai][bj][m][n]); __builtin_amdgcn_s_setprio(0); } while (0)
#define G_WAIT_V(n) asm volatile("s_waitcnt vmcnt(" #n ")" ::: "memory")
#define G_WAIT_L(n) asm volatile("s_waitcnt lgkmcnt(" #n ")" ::: "memory")
#define G_BAR __builtin_amdgcn_s_barrier()
#define G_SCHED __builtin_amdgcn_sched_barrier(0)
    Unit cur, nxt; int ui = 0;
    if (!S.next(0, cur)) return;
    f32x4 acc[2][2][4][2];
#pragma unroll
    for (int a = 0; a < 2; ++a)
#pragma unroll
        for (int b = 0; b < 2; ++b)
#pragma unroll
            for (int m = 0; m < 4; ++m)
#pragma unroll
                for (int n = 0; n < 2; ++n) acc[a][b][m][n] = (f32x4){0.f, 0.f, 0.f, 0.f};
    FragT<P::FP8> At[4], B0[2], B1[2];
    const char* cA = S.a_base(cur);
    const char* cB = S.b_src(cur);
    S.ids_issue(cur, lds + AUX_OFF + 2048, lane); S.aux_issue(cur, lds + AUX_OFF, lane);
    G_WAIT_V(0);
    int crl = cur.rl, ccn = S.dir.cnt[cur.e];
#define G_AOFF(dst, slot_, rl_, cn_, h_) do { _Pragma("unroll") for (int _i = 0; _i < 2; ++_i) { const int _r = (h_) * HALF + R[_i]; int _t = ((const LAS int*)(slot_))[_r]; _t = ((rl_) * BM + _r) < (cn_) ? _t : 0; dst[_i] = (unsigned)(_t * DM + C[_i] * 2); } } while (0)
    unsigned ao[2];
    { const LAS unsigned char* s0 = lds + AUX_OFF + 2048; G_STAGE(G_SB(0, 0), cB, voffB); G_STAGE(G_SB(0, 1), cB + hstepB, voffB); G_AOFF(ao, s0, crl, ccn, 0); G_STAGE(G_SA(0, 0), cA, ao); G_AOFF(ao, s0, crl, ccn, 1); G_STAGE(G_SA(0, 1), cA, ao); }
    if (wr == 1) G_BAR;
    G_WAIT_V(2); G_BAR;
    { const LAS unsigned char* s0 = lds + AUX_OFF + 2048; G_STAGE(G_SB(1, 0), cB + kstepB, voffB); G_AOFF(ao, s0, crl, ccn, 0); G_STAGE(G_SA(1, 0), cA + kstepA, ao); G_STAGE(G_SB(1, 1), cB + hstepB + kstepB, voffB); }
    G_WAIT_V(6); G_BAR;
    for (;;) {
        const bool has_next = S.next(ui + 1, nxt);
        const char* nA = cA; const char* nB = cB; int nrl = crl, ncn = ccn;
        const LAS unsigned char* slc = lds + AUX_OFF + (ui & 1) * AUX_SLOT + 2048; const LAS unsigned char* sln = lds + AUX_OFF + ((ui + 1) & 1) * AUX_SLOT + 2048;
        if (has_next) { nA = S.a_base(nxt); nB = S.b_src(nxt); nrl = nxt.rl; ncn = S.dir.cnt[nxt.e]; S.ids_issue(nxt, lds + AUX_OFF + ((ui + 1) & 1) * AUX_SLOT + 2048, lane); }
        for (int t = 0; t < nt; t += 2) {
            const bool last = (t == nt - 2);
            const char* a1 = cA + (size_t)(t + 1) * kstepA;
            const char* a2 = last ? nA : cA + (size_t)(t + 2) * kstepA; const char* b2 = last ? nB : cB + (size_t)(t + 2) * kstepB;
            const char* a3 = a2 + kstepA; const char* b3 = b2 + kstepB;
            const LAS unsigned char* sl2 = (last && has_next) ? sln : slc; const int rl2 = (last && has_next) ? nrl : crl, cn2 = (last && has_next) ? ncn : ccn;
            G_LDB(B0, 0, 0); G_LDB(B1, 0, 1); G_SCHED; G_LDA(At, 0, 0); G_AOFF(ao, slc, crl, ccn, 1); G_STAGE(G_SA(1, 1), a1, ao);
            G_WAIT_V(8); G_WAIT_L(0); G_BAR; G_MMA(0, 0, At, B0); G_MMA(0, 1, At, B1); G_BAR; G_SCHED;
            G_LDA(At, 0, 1); G_STAGE(G_SB(0, 0), b2, voffB); G_STAGE(G_SB(0, 1), b2 + hstepB, voffB); G_AOFF(ao, sl2, rl2, cn2, 0); G_STAGE(G_SA(0, 0), a2, ao);
            G_WAIT_V(8); G_WAIT_L(0); G_BAR; G_MMA(1, 0, At, B0); G_MMA(1, 1, At, B1); G_BAR; G_SCHED;
            G_LDB(B0, 1, 0); G_LDB(B1, 1, 1); G_SCHED; G_LDA(At, 1, 0); G_AOFF(ao, sl2, rl2, cn2, 1); G_STAGE(G_SA(0, 1), a2, ao);
            G_WAIT_V(8); G_WAIT_L(0); G_BAR; G_MMA(0, 0, At, B0); G_MMA(0, 1, At, B1); G_BAR; G_SCHED;
            G_LDA(At, 1, 1); G_STAGE(G_SB(1, 0), b3, voffB); G_STAGE(G_SB(1, 1), b3 + hstepB, voffB); G_AOFF(ao, sl2, rl2, cn2, 0); G_STAGE(G_SA(1, 0), a3, ao);
            G_WAIT_V(8); G_WAIT_L(0); G_BAR; G_MMA(1, 0, At, B0); G_MMA(1, 1, At, B1); G_BAR; G_SCHED;
        }
        if (wr == 0) G_BAR;
        if (P::FP8) asm volatile("s_nop 15\n\ts_nop 15" ::: "memory");
        S.epi(acc, cur, wr, wc, fr, fq, lds + AUX_OFF + (ui & 1) * AUX_SLOT);
        if (!has_next) break;
#pragma unroll
        for (int a = 0; a < 2; ++a)
#pragma unroll
            for (int b = 0; b < 2; ++b)
#pragma unroll
                for (int m = 0; m < 4; ++m)
#pragma unroll
                    for (int n = 0; n < 2; ++n) acc[a][b][m][n] = (f32x4){0.f, 0.f, 0.f, 0.f};
        if (P::FP8) asm volatile("s_nop 7" ::: "memory");
        cur = nxt; cA = nA; cB = nB; ++ui;
        if constexpr (P::AUX) S.aux_issue(cur, lds + AUX_OFF + (ui & 1) * AUX_SLOT, lane);
        if (wr == 1) G_BAR;
        crl = nrl; ccn = ncn;
    }
    G_WAIT_V(0);
    G_BAR;
#undef G_AOFF
#undef G_SA
#undef G_SB
#undef G_STAGE
#undef G_LDA
#undef G_LDB
#undef G_MMA
#undef G_WAIT_V
#undef G_WAIT_L
#undef G_BAR
#undef G_SCHED
}

template <int NPN> DI bool unit_map(int i, int G, int c, int n_rt, Unit& u) {
    const int L = i * G + c, x = L & 7, q = L >> 3;
    u.rt = (q / NPN) * 8 + x; u.pn = q % NPN; u.e = 0; u.rl = 0;
    return u.rt < n_rt;
}

DI void store8_bf16(bf16_t* p, const f32x4& v0, const f32x4& v1) {
    u32x4 w; w.x = cvt_pk_bf16(v0[0], v0[1]); w.y = cvt_pk_bf16(v0[2], v0[3]); w.z = cvt_pk_bf16(v1[0], v1[1]); w.w = cvt_pk_bf16(v1[2], v1[3]);
    __builtin_nontemporal_store(w, (u32x4*)p);
}

template <int NPN, int ACT> struct DenseBf16 {
    static constexpr bool PERM = true, FP8 = false, AUX = false;
    int nt, kstepA, ldb; int G, c, n_rt;
    const bf16_t* A; int lda; const bf16_t* Bt; bf16_t* O; int ldo;
    const float* bias0; const float* bias1; int bsplit, bend;
    DI bool next(int i, Unit& u) const { return unit_map<NPN>(i, G, c, n_rt, u); }
    DI void a_src(const Unit& u, const int (&R)[2], const int (&C)[2], const char*& base, unsigned (&off)[2][2]) const {
        base = (const char*)(A + (size_t)u.rt * BM * lda);
#pragma unroll
        for (int h = 0; h < 2; ++h)
#pragma unroll
            for (int i = 0; i < 2; ++i) off[h][i] = (unsigned)((h * HALF + R[i]) * lda + C[i]) * 2u;
    }
    DI const char* b_src(const Unit& u) const { return (const char*)(Bt + (size_t)u.pn * BM * ldb); }
    DI float bias_at(int col) const { if (col < bsplit) return bias0 ? bias0[col] : 0.f; if (col < bend) return bias1 ? bias1[col - bsplit] : 0.f; return 0.f; }
    DI void epi(const f32x4 (&acc)[2][2][4][2], const Unit& u, int wr, int wc, int fr, int fq, const LAS unsigned char* aux) const {
        const int row0 = u.rt * BM + wr * 64 + fr, col0 = u.pn * BM + wc * 32 + 8 * fq;
#pragma unroll
        for (int bj = 0; bj < 2; ++bj) {
            f32x4 b0, b1;
#pragma unroll
            for (int j = 0; j < 4; ++j) { b0[j] = bias_at(col0 + bj * HALF + j); b1[j] = bias_at(col0 + bj * HALF + 4 + j); }
#pragma unroll
            for (int ai = 0; ai < 2; ++ai)
#pragma unroll
                for (int m = 0; m < 4; ++m) {
                    f32x4 v0 = acc[ai][bj][m][0] + b0, v1 = acc[ai][bj][m][1] + b1;
                    if (ACT == 1) {
#pragma unroll
                        for (int j = 0; j < 4; ++j) { v0[j] = gelu_tanh(v0[j]); v1[j] = gelu_tanh(v1[j]); }
                    }
                    store8_bf16(O + (size_t)(row0 + ai * HALF + m * 16) * ldo + col0 + bj * HALF, v0, v1);
                }
        }
    }
};

struct CmpGemm {
    static constexpr bool PERM = true, FP8 = false, AUX = false;
    int nt, kstepA, ldb; int G, c;
    const bf16_t* proj; const bf16_t* cw1t; bf16_t* hid; const float* biasc;
    DI bool next(int i, Unit& u) const { const int L = i * G + c; u.e = L & 1; u.rt = L >> 1; u.pn = 0; u.rl = 0; return L < 64; }
    DI void a_src(const Unit& u, const int (&R)[2], const int (&C)[2], const char*& base, unsigned (&off)[2][2]) const {
        base = (const char*)proj;
#pragma unroll
        for (int h = 0; h < 2; ++h)
#pragma unroll
            for (int i = 0; i < 2; ++i) {
                const int m = u.rt * BM + h * HALF + R[i], b = m >> 8, kvh = (m >> 7) & 1; int n = m & 127; n = n > 126 ? 126 : n;
                off[h][i] = (unsigned)(((size_t)(b * SEQ + n * 16) * NPROJ + (u.e ? C_VC : C_KC) + kvh * 64 + C[i]) * 2u);
            }
    }
    DI const char* b_src(const Unit& u) const { return (const char*)(cw1t + (size_t)u.e * 256 * 2048); }
    DI void epi(const f32x4 (&acc)[2][2][4][2], const Unit& u, int wr, int wc, int fr, int fq, const LAS unsigned char* aux) const {
        const int row0 = u.rt * BM + wr * 64 + fr, col0 = wc * 32 + 8 * fq;
        bf16_t* O = hid + (size_t)u.e * 8192 * 256; const float* bs = biasc + u.e * 256;
#pragma unroll
        for (int bj = 0; bj < 2; ++bj) {
            f32x4 b0 = *(const f32x4*)(bs + col0 + bj * HALF), b1 = *(const f32x4*)(bs + col0 + bj * HALF + 4);
#pragma unroll
            for (int ai = 0; ai < 2; ++ai)
#pragma unroll
                for (int m = 0; m < 4; ++m) {
                    f32x4 v0 = acc[ai][bj][m][0] + b0, v1 = acc[ai][bj][m][1] + b1;
#pragma unroll
                    for (int j = 0; j < 4; ++j) { v0[j] = gelu_tanh(v0[j]); v1[j] = gelu_tanh(v1[j]); }
                    store8_bf16(O + (size_t)(row0 + ai * HALF + m * 16) * 256 + col0 + bj * HALF, v0, v1);
                }
        }
    }
};

struct OutProj {
    static constexpr bool PERM = true, FP8 = false, AUX = false;
    int nt, kstepA, ldb; int G, c;
    const bf16_t* A; const bf16_t* Bt; const float* x; bf16_t* x1b;
    DI bool next(int i, Unit& u) const { u.rt = (i >> 2) * G + c; u.pn = i & 3; u.e = 0; u.rl = 0; return u.rt < T_TOK / BM; }
    DI void a_src(const Unit& u, const int (&R)[2], const int (&C)[2], const char*& base, unsigned (&off)[2][2]) const {
        base = (const char*)(A + (size_t)u.rt * BM * DM);
#pragma unroll
        for (int h = 0; h < 2; ++h)
#pragma unroll
            for (int i = 0; i < 2; ++i) off[h][i] = (unsigned)((h * HALF + R[i]) * DM + C[i]) * 2u;
    }
    DI const char* b_src(const Unit& u) const { return (const char*)(Bt + (size_t)u.pn * BM * DM); }
    DI void epi(const f32x4 (&acc)[2][2][4][2], const Unit& u, int wr, int wc, int fr, int fq, const LAS unsigned char* aux) const {
        const int row0 = u.rt * BM + wr * 64 + fr, col0 = u.pn * BM + wc * 32 + 8 * fq;
#pragma unroll
        for (int ai = 0; ai < 2; ++ai)
#pragma unroll
            for (int m = 0; m < 4; ++m) {
                const size_t ro = (size_t)(row0 + ai * HALF + m * 16) * DM + col0;
#pragma unroll
                for (int bj = 0; bj < 2; ++bj) {
                    const f32x4 x0 = *(const f32x4*)(x + ro + bj * HALF), x1 = *(const f32x4*)(x + ro + bj * HALF + 4);
                    const f32x4 v0 = acc[ai][bj][m][0] + x0, v1 = acc[ai][bj][m][1] + x1;
                    u32x4 w; w.x = cvt_pk_bf16(v0[0], v0[1]); w.y = cvt_pk_bf16(v0[2], v0[3]); w.z = cvt_pk_bf16(v1[0], v1[1]); w.w = cvt_pk_bf16(v1[2], v1[3]);
                    *(u32x4*)(x1b + ro + bj * HALF) = w;
                }
            }
    }
};

constexpr int NLIST = NEXP;
struct MoeDir { const LAS int* pref; const LAS int* cnt; const LAS int* rpref; };
DI int dir_search(const LAS int* p, int n, int v) { int lo = 0, hi = n;
#pragma unroll 1
    while (hi - lo > 1) { const int mid = (lo + hi) >> 1; if (p[mid] <= v) lo = mid; else hi = mid; }
    return lo; }

struct Moe1 {
    static constexpr bool PERM = true, FP8 = true, AUX = true;
    int nt, kstepA, ldb; int G, c;
    MoeDir dir; const unsigned char* h; const unsigned char* w1t; const float* b1; const int* ids; const float* rsl; unsigned char* act;
    DI bool next(int i, Unit& u) const { if (!unit_map<8>(i, G, c, dir.pref[NLIST], u)) return false; u.e = dir_search(dir.pref, NLIST, u.rt); u.rl = u.rt - dir.pref[u.e]; return true; }
    DI void a_src(const Unit& u, const int (&R)[2], const int (&C)[2], const char*& base, unsigned (&off)[2][2]) const {
        base = (const char*)h; const int cn = dir.cnt[u.e];
#pragma unroll
        for (int hh = 0; hh < 2; ++hh)
#pragma unroll
            for (int i = 0; i < 2; ++i) { const int idx = u.rl * BM + hh * HALF + R[i]; const int tok = idx < cn ? ids[(size_t)u.e * T_TOK + idx] : 0; off[hh][i] = (unsigned)(tok * DM + C[i] * 2); }
    }
    DI const char* b_src(const Unit& u) const { return (const char*)(w1t + ((size_t)u.e * 2048 + (size_t)u.pn * BM) * DM); }
    DI const char* a_base(const Unit&) const { return (const char*)h; }
    DI void ids_issue(const Unit& u, LAS unsigned char* dst, int lane) const {
        __builtin_amdgcn_global_load_lds((const unsigned*)(ids + (size_t)u.e * T_TOK + (size_t)u.rl * BM + lane * 4), (LAS unsigned*)dst, 16, 0, 0);
    }
    DI void aux_issue(const Unit& u, LAS unsigned char* slot, int lane) const {
        const float* rsrc = rsl + (size_t)u.e * T_TOK + (size_t)u.rl * BM + lane * 4;
        const float* bsrc = b1 + (size_t)u.e * 2048 + (lane >> 5) * 1024 + u.pn * 128 + (lane & 31) * 4;
        __builtin_amdgcn_global_load_lds((const unsigned*)rsrc, (LAS unsigned*)slot, 16, 0, 0);
        __builtin_amdgcn_global_load_lds((const unsigned*)bsrc, (LAS unsigned*)(slot + 1024), 16, 0, 0);
    }
    DI void epi(const f32x4 (&acc)[2][2][4][2], const Unit& u, int wr, int wc, int fr, int fq, const LAS unsigned char* aux) const {
        const int row0 = u.rt * BM + wr * 64 + fr, cl = wc * 32 + 8 * fq;
        const LAS float* ars = (const LAS float*)aux; const LAS float* ab = ars + 256 + cl;
        const f32x4 g0 = *(const LAS f32x4*)ab, g1 = *(const LAS f32x4*)(ab + 4), l0 = *(const LAS f32x4*)(ab + 128), l1 = *(const LAS f32x4*)(ab + 132);
#pragma unroll
        for (int ai = 0; ai < 2; ++ai)
#pragma unroll
            for (int m = 0; m < 4; ++m) {
                f32x4 v[2];
                const float rs32 = ars[ai * HALF + wr * 64 + m * 16 + fr] * (1.0f / 32.0f);
#pragma unroll
                for (int n = 0; n < 2; ++n)
#pragma unroll
                    for (int j = 0; j < 4; ++j) {
                        float glu = acc[ai][0][m][n][j] * rs32 + (n ? g1[j] : g0[j]), lin = acc[ai][1][m][n][j] * rs32 + (n ? l1[j] : l0[j]);
                        glu = fminf(glu, 7.0f); lin = fminf(fmaxf(lin, -7.0f), 7.0f);
                        v[n][j] = glu * __builtin_amdgcn_rcpf(1.0f + __builtin_amdgcn_exp2f(-1.702f * 1.4426950408889634f * glu)) * (lin + 1.0f);
                    }
                { u32x2 w8; w8.x = cvt4_fp8(v[0][0], v[0][1], v[0][2], v[0][3]); w8.y = cvt4_fp8(v[1][0], v[1][1], v[1][2], v[1][3]); *(u32x2*)(act + (size_t)(row0 + ai * HALF + m * 16) * DFF + u.pn * 128 + cl) = w8; }
            }
    }
};

struct Moe2 {
    static constexpr bool PERM = true, FP8 = true, AUX = true;
    int nt, kstepA, ldb; int G, c;
    MoeDir dir; const unsigned char* act; const unsigned char* w2t; const float* b2; unsigned char* ws;
    DI bool next(int i, Unit& u) const { if (!unit_map<4>(i, G, c, dir.pref[NLIST], u)) return false; u.e = dir_search(dir.pref, NLIST, u.rt); u.rl = u.rt - dir.pref[u.e]; return true; }
    DI void a_src(const Unit& u, const int (&R)[2], const int (&C)[2], const char*& base, unsigned (&off)[2][2]) const {
        base = (const char*)(act + (size_t)u.rt * BM * DFF);
#pragma unroll
        for (int h = 0; h < 2; ++h)
#pragma unroll
            for (int i = 0; i < 2; ++i) off[h][i] = (unsigned)((h * HALF + R[i]) * DFF + C[i] * 2);
    }
    DI const char* b_src(const Unit& u) const { return (const char*)(w2t + ((size_t)u.e * 1024 + (size_t)u.pn * BM) * DFF); }
    DI void aux_issue(const Unit& u, LAS unsigned char* slot, int lane) const {
        __builtin_amdgcn_global_load_lds((const unsigned*)(b2 + (size_t)u.e * DM + u.pn * BM + lane * 4), (LAS unsigned*)slot, 16, 0, 0);
    }
    DI void epi(const f32x4 (&acc)[2][2][4][2], const Unit& u, int wr, int wc, int fr, int fq, const LAS unsigned char* aux) const {
        const int row0 = u.rt * BM + wr * 64 + fr, col0 = u.pn * BM + wc * 32 + 8 * fq;
#pragma unroll
        for (int bj = 0; bj < 2; ++bj) {
            const LAS float* ab = (const LAS float*)aux + wc * 32 + 8 * fq + bj * HALF; const f32x4 b0 = *(const LAS f32x4*)ab, b1 = *(const LAS f32x4*)(ab + 4);
#pragma unroll
            for (int ai = 0; ai < 2; ++ai)
#pragma unroll
                for (int mp = 0; mp < 2; ++mp) {
                    u32x2 wr2[2];
#pragma unroll
                    for (int e = 0; e < 2; ++e) {
                        const int m = 2 * mp + e;
                        const f32x4 v0 = (acc[ai][bj][m][0] * (1.0f / 32.0f) + b0) * YSCALE, v1 = (acc[ai][bj][m][1] * (1.0f / 32.0f) + b1) * YSCALE;
                        wr2[e].x = cvt4_fp8(v0[0], v0[1], v0[2], v0[3]); wr2[e].y = cvt4_fp8(v1[0], v1[1], v1[2], v1[3]);
                    }
                    const u32x2 sx = __builtin_amdgcn_permlane16_swap(wr2[0].x, wr2[1].x, false, false), sy = __builtin_amdgcn_permlane16_swap(wr2[0].y, wr2[1].y, false, false);
                    const int row = row0 + ai * HALF + (2 * mp + (fq & 1)) * 16, col = u.pn * BM + wc * 32 + 8 * (fq & ~1) + bj * HALF;
                    *(u32x4*)(ws + y8_row_off(row) + col) = (u32x4){sx.x, sy.x, sx.y, sy.y};
                }
        }
    }
};

struct Ctx {
#if defined(__HIP_DEVICE_COMPILE__)
    const __constant__ void* kargs;
#else
    const void* kargs;
#endif
    float* out; unsigned char* ws;
    LAS unsigned char* lds; int tid, lane, wave, G, bid;
    DI const float* in(int k) const {
#if defined(__HIP_DEVICE_COMPILE__)
        return ((const float* const __constant__*)kargs)[k];
#else
        return nullptr;
#endif
    }
    DI bf16_t* xn() const { return (bf16_t*)(ws + WS_XN); }
    DI bf16_t* proj() const { return (bf16_t*)(ws + WS_PROJ); }
    DI bf16_t* ksr() const { return (bf16_t*)(ws + WS_KSR); }
    DI bf16_t* kwr() const { return (bf16_t*)(ws + WS_KWR); }
    DI bf16_t* vst() const { return (bf16_t*)(ws + WS_VST); }
    DI bf16_t* vwt() const { return (bf16_t*)(ws + WS_VWT); }
    DI bf16_t* lout() const { return (bf16_t*)(ws + WS_LOUT); }
    DI bf16_t* lact() const { return (bf16_t*)(ws + WS_LACT); }
    DI bf16_t* wcat() const { return (bf16_t*)(ws + WS_WCAT); }
    DI bf16_t* woutt() const { return (bf16_t*)(ws + WS_WOUT); }
    DI bf16_t* cw1t() const { return (bf16_t*)(ws + WS_CW1); }
    DI bf16_t* wl2t() const { return (bf16_t*)(ws + WS_WL2); }
    DI bf16_t* hid() const { return (bf16_t*)(ws + WS_HID); }
    DI bf16_t* kcmp() const { return (bf16_t*)(ws + WS_KCMP); }
    DI bf16_t* vcmpt() const { return (bf16_t*)(ws + WS_VCMPT); }
    DI float* rope() const { return (float*)(ws + WS_ROPE); }
    DI float* biasc() const { return (float*)(ws + WS_BIASC); }
    DI int* ctl() const { return (int*)(ws + WS_CTL); }
    DI int* ids() const { return (int*)(ws + WS_IDS); }
    DI float* gts() const { return (float*)(ws + WS_GTS); }
    DI float* rsl() const { return (float*)(ws + WS_RSL); }
    DI bf16_t* wrt() const { return (bf16_t*)(ws + WS_WRT); }
    DI unsigned char* w1t() const { return ws + WS_W1T; }
    DI unsigned char* w2t() const { return ws + WS_W2T; }
    DI unsigned char* act() const { return ws + WS_ACT; }
    DI unsigned char* h8() const { return ws + WS_XN; }
};
enum { I_X = 0, I_LN1, I_WIN, I_MURKV, I_MUWAG, I_W0, I_W1, I_W2, I_A0, I_A1, I_A2, I_G1, I_G2, I_KK, I_KA, I_RK, I_LNXG, I_LNXB, I_QNG, I_KNG, I_PE, I_CW1, I_CW2, I_WOUT, I_LN2, I_MWR, I_MBR, I_MW1, I_MB1, I_MW2, I_MB2 };

template <class F>
DI void tconv_tile(const Ctx& c, F src, bf16_t* dst, size_t ld_dst, int k0, int nsrc0, int ndst0) {
    LAS float* tile = (LAS float*)c.lds;
    const int tk = c.tid >> 6, tn = c.tid & 63;
#pragma unroll
    for (int j = 0; j < 8; ++j) { const int k = tk + 8 * j; tile[k * 65 + tn] = src(k0 + k, nsrc0 + tn); }
    __syncthreads();
    const int n = c.tid >> 3, kq = c.tid & 7;
    float v[8];
#pragma unroll
    for (int jj = 0; jj < 8; ++jj) v[jj] = tile[(kq * 8 + jj) * 65 + n];
    u32x4 w; w.x = cvt_pk_bf16(v[0], v[1]); w.y = cvt_pk_bf16(v[2], v[3]); w.z = cvt_pk_bf16(v[4], v[5]); w.w = cvt_pk_bf16(v[6], v[7]);
    *(u32x4*)(dst + (size_t)(ndst0 + n) * ld_dst + k0 + kq * 8) = w;
    __syncthreads();
}

template <class F>
DI void tconv_tile_fp8(const Ctx& c, F src, unsigned char* dst, size_t ld_dst, int k0, int nsrc0, int ndst0, float scale) {
    LAS float* tile = (LAS float*)c.lds;
    const int tk = c.tid >> 6, tn = c.tid & 63;
#pragma unroll
    for (int j = 0; j < 8; ++j) { const int k = tk + 8 * j; tile[k * 65 + tn] = src(k0 + k, nsrc0 + tn); }
    __syncthreads();
    const int n = c.tid >> 3, kq = c.tid & 7;
    float v[8];
#pragma unroll
    for (int jj = 0; jj < 8; ++jj) v[jj] = tile[(kq * 8 + jj) * 65 + n] * scale;
    u32x2 w; w.x = cvt4_fp8(v[0], v[1], v[2], v[3]); w.y = cvt4_fp8(v[4], v[5], v[6], v[7]);
    *(u32x2*)(dst + (size_t)(ndst0 + n) * ld_dst + k0 + kq * 8) = w;
    __syncthreads();
}

template <class D>
DI void tconv_big_fp8(const Ctx& c, const float* src, size_t ld_src, unsigned char* dst, size_t ld_dst, int k0, int n0, D drow, float scale) {
    LAS float* tile = (LAS float*)c.lds;
    const int tk = c.tid >> 6, tn = c.tid & 63;
    f32x4 v[8];
#pragma unroll
    for (int j = 0; j < 8; ++j) v[j] = *(const f32x4*)(src + (size_t)(k0 + tk + 8 * j) * ld_src + n0 + tn * 4);
#pragma unroll
    for (int j = 0; j < 8; ++j) *(LAS f32x4*)(tile + (tk + 8 * j) * 260 + tn * 4) = v[j];
    __syncthreads();
    const int n = c.tid >> 1, kh = c.tid & 1;
    u32x4 w[2];
#pragma unroll
    for (int q = 0; q < 8; ++q) { const LAS float* t = tile + (kh * 32 + q * 4) * 260 + n; w[q >> 2][q & 3] = cvt4_fp8(t[0] * scale, t[260] * scale, t[520] * scale, t[780] * scale); }
    unsigned char* d = dst + (size_t)drow(n0 + n) * ld_dst + k0 + kh * 32;
    *(u32x4*)d = w[0]; *(u32x4*)(d + 16) = w[1];
    __syncthreads();
}

DI void p0_prologue(const Ctx& c) {
    const float* x = c.in(I_X); const float* ln1 = c.in(I_LN1);
    if (c.bid == 0 && c.tid < 256) c.ctl()[c.tid] = 0;
    if (c.bid == 0) { unsigned* bw = (unsigned*)(c.ws + WS_BAR); for (int i = c.tid; i < 3456  ; i += NTHREADS) bw[i] = 0u; }
    {
        bf16_t* xn = c.xn();
        const int gw = c.bid * 8 + c.wave, nw = c.G * 8;
        f32x4 g[4];
#pragma unroll
        for (int i = 0; i < 4; ++i) g[i] = ((const f32x4*)ln1)[c.lane + 64 * i];
        for (int row = gw; row < T_TOK; row += 2 * nw) {
            const int row2 = row + nw; const bool two = row2 < T_TOK;
            const f32x4* xr = (const f32x4*)(x + (size_t)row * DM); const f32x4* xr2 = (const f32x4*)(x + (size_t)(two ? row2 : row) * DM);
            f32x4 v[4], u[4]; float ss = 0.f, ss2 = 0.f;
#pragma unroll
            for (int i = 0; i < 4; ++i) { v[i] = __builtin_nontemporal_load(xr + c.lane + 64 * i); u[i] = __builtin_nontemporal_load(xr2 + c.lane + 64 * i); }
#pragma unroll
            for (int i = 0; i < 4; ++i) { ss += v[i][0] * v[i][0] + v[i][1] * v[i][1] + v[i][2] * v[i][2] + v[i][3] * v[i][3]; ss2 += u[i][0] * u[i][0] + u[i][1] * u[i][1] + u[i][2] * u[i][2] + u[i][3] * u[i][3]; }
            ss = wave_sum(ss); ss2 = wave_sum(ss2);
            const float sc = rsqrtf(ss * (1.0f / DM) + 1e-6f), sc2 = rsqrtf(ss2 * (1.0f / DM) + 1e-6f);
#pragma unroll
            for (int i = 0; i < 4; ++i) {
                u32x2 w; w.x = cvt_pk_bf16(v[i][0] * sc * g[i][0], v[i][1] * sc * g[i][1]); w.y = cvt_pk_bf16(v[i][2] * sc * g[i][2], v[i][3] * sc * g[i][3]);
                *(u32x2*)(xn + (size_t)row * DM + (c.lane + 64 * i) * 4) = w;
            }
            if (two) {
#pragma unroll
                for (int i = 0; i < 4; ++i) {
                    u32x2 w; w.x = cvt_pk_bf16(u[i][0] * sc2 * g[i][0], u[i][1] * sc2 * g[i][1]); w.y = cvt_pk_bf16(u[i][2] * sc2 * g[i][2], u[i][3] * sc2 * g[i][3]);
                    *(u32x2*)(xn + (size_t)row2 * DM + (c.lane + 64 * i) * 4) = w;
                }
            }
        }
    }
    {
        const float* w_in = c.in(I_WIN); const float* w1 = c.in(I_W1); const float* a1 = c.in(I_A1); const float* g1 = c.in(I_G1); const float* mu = c.in(I_MUWAG);
        auto src_cat = [=](int k, int n) -> float {
            if (n < N_IN_REAL) return w_in[(size_t)k * N_IN_REAL + n];
            if (n >= C_LEND) return 0.f;
            int cc = n - C_L1; const bool second = cc >= 256; cc &= 255;
            float w, m;
            if (cc < 64) { w = w1[k * 64 + cc]; m = mu[k]; }
            else if (cc < 128) { w = a1[k * 64 + cc - 64]; m = mu[DM + k]; }
            else { w = g1[k * 128 + cc - 128]; m = mu[2 * DM + k]; }
            return w * (second ? m : 1.0f - m);
        };
        const float* w_out = c.in(I_WOUT); const float* cw1 = c.in(I_CW1);
        for (int it = c.bid; it < 1408; it += c.G) {
            if (it < 896) { const int nt_ = it >> 4, kt = it & 15; tconv_tile(c, src_cat, c.wcat(), DM, kt * 64, nt_ * 64, nt_ * 64); }
            else if (it < 1152) { const int j = it - 896, nt_ = j >> 4, kt = j & 15; tconv_tile(c, [=](int k, int n) { return w_out[(size_t)k * DM + n]; }, c.woutt(), DM, kt * 64, nt_ * 64, nt_ * 64); }
            else { const int j = it - 1152, i = j >> 7, r = j & 127, nt_ = r >> 5, kt = r & 31; const float* s = cw1 + (size_t)i * 2048 * 256;
                tconv_tile(c, [=](int k, int n) { return s[(size_t)k * 256 + n]; }, c.cw1t() + (size_t)i * 256 * 2048, 2048, kt * 64, nt_ * 64, nt_ * 64); }
        }
    }
    {
        const int gt = c.bid * NTHREADS + c.tid, ngt = c.G * NTHREADS;
        float* rp = c.rope();
        for (int i = gt; i < SEQ * 32; i += ngt) { const int s = i >> 5, d = i & 31; const float inv = exp2f(-(float)d * (13.287712379549449f / 32.0f)); const float ang = (float)s * inv; rp[2 * i] = cosf(ang); rp[2 * i + 1] = sinf(ang); }
        { const float* wr = c.in(I_MWR); const float* ln2w = c.in(I_LN2); bf16_t* wt = c.wrt();
          for (int i = gt; i < NEXP * DM; i += ngt) { const int e = i >> 10, k = i & 1023; const float w = wr[k * NEXP + e] * ln2w[k]; const bf16_t hi = f2bf(w);   wt[i] = hi; wt[NEXP * DM + i] = f2bf(w - bf2f(hi)); } }
        const float* w2 = c.in(I_W2); const float* a2 = c.in(I_A2); const float* g2 = c.in(I_G2); bf16_t* wl = c.wl2t();
        for (int i = gt; i < 1536 * 256; i += ngt) { const int n = i >> 8, k = i & 255; float v = 0.f;
            if (n < 512) { if (k < 64) v = w2[k * 512 + n]; }
            else if (n < 1024) { if (k >= 64 && k < 128) v = a2[(k - 64) * 512 + n - 512]; }
            else { if (k >= 128) v = g2[(k - 128) * 512 + n - 1024]; }
            wl[i] = f2bf(v); }
    }
    if (c.bid >= 128 && c.bid < 256) {
        LAS float* red = (LAS float*)c.lds;
        const int fo = (c.bid - 128) * 4 + (c.tid & 3), ch = c.tid >> 2, i = fo >> 8, f = fo & 255;
        const float* pe = c.in(I_PE) + (size_t)i * 2048 + ch * 16; const float* w = c.in(I_CW1) + (size_t)i * 2048 * 256 + (size_t)ch * 16 * 256 + f;
        float s = 0.f;
#pragma unroll
        for (int ld = 0; ld < 16; ++ld) s += pe[ld] * w[(size_t)ld * 256];
        s += __shfl_xor(s, 4); s += __shfl_xor(s, 8); s += __shfl_xor(s, 16); s += __shfl_xor(s, 32);
        if (c.lane < 4) red[c.wave * 4 + c.lane] = s;
        __syncthreads();
        if (c.tid < 4) { float t = 0.f; for (int k = 0; k < 8; ++k) t += red[k * 4 + c.tid]; c.biasc()[(c.bid - 128) * 4 + c.tid] = t; }
        __syncthreads();
    }
}

DI void p2_prep(const Ctx& c, int vb, int nvb) {
    const bf16_t* proj = c.proj();
    const int gt = vb * NTHREADS + c.tid, ngt = nvb * NTHREADS;
    {
        bf16_t* la = c.lact();
        const int cg8 = (gt & 31) * 8;
        for (int i0 = gt; i0 < T_TOK * 32; i0 += 4 * ngt) {
            u32x4 p1[4], p2[4];
#pragma unroll
            for (int u = 0; u < 4; ++u) {
                const int iu = i0 + u * ngt, t = (iu < T_TOK * 32 ? iu : i0) >> 5;
                p1[u] = *(const u32x4*)(proj + (size_t)t * NPROJ + C_L1 + cg8);
                p2[u] = (u32x4){0u, 0u, 0u, 0u};
                if ((t & (SEQ - 1)) != 0) p2[u] = *(const u32x4*)(proj + (size_t)(t - 1) * NPROJ + C_L2 + cg8);
            }
#pragma unroll
            for (int u = 0; u < 4; ++u) {
                if (i0 + u * ngt >= T_TOK * 32) break;
                const int t = (i0 + u * ngt) >> 5;
                float z[8];
#pragma unroll
                for (int q = 0; q < 4; ++q) { z[2 * q] = bflo(p1[u][q]) + bflo(p2[u][q]); z[2 * q + 1] = bfhi(p1[u][q]) + bfhi(p2[u][q]); }
                if (cg8 < 64) {
#pragma unroll
                    for (int q = 0; q < 8; ++q) z[q] = tanhf_(z[q]);
                } else if (cg8 >= 128) {
#pragma unroll
                    for (int q = 0; q < 8; ++q) z[q] = sigmoidf_(z[q]);
                }
                u32x4 w; w.x = cvt_pk_bf16(z[0], z[1]); w.y = cvt_pk_bf16(z[2], z[3]); w.z = cvt_pk_bf16(z[4], z[5]); w.w = cvt_pk_bf16(z[6], z[7]);
                *(u32x4*)(la + (size_t)t * 256 + cg8) = w;
            }
        }
    }
    {
        const float* kng = c.in(I_KNG); const float* rp = c.rope();
        const int j = gt & 7, kvh = (gt >> 3) & 1, which = (gt >> 4) & 1;
        const float* g = kng + (1 + which) * 64;
        const f32x4 gl = *(const f32x4*)(g + 4 * j), gh = *(const f32x4*)(g + 32 + 4 * j);
        bf16_t* dbase = which ? c.kwr() : c.ksr();
        for (int i0 = gt; i0 < T_TOK * 4 * 8; i0 += 4 * ngt) {
            u32x2 lo[4], hi[4]; f32x4 r0[4], r1[4];
#pragma unroll
            for (int u = 0; u < 4; ++u) {
                const int iu = i0 + u * ngt, t = (iu < T_TOK * 32 ? iu : i0) >> 5, s = t & (SEQ - 1);
                const bf16_t* src = proj + (size_t)t * NPROJ + (which ? C_KW : C_KS) + kvh * 64;
                lo[u] = *(const u32x2*)(src + 4 * j); hi[u] = *(const u32x2*)(src + 32 + 4 * j);
                r0[u] = *(const f32x4*)(rp + (s * 32 + 4 * j) * 2); r1[u] = *(const f32x4*)(rp + (s * 32 + 4 * j) * 2 + 4);
            }
#pragma unroll
            for (int u = 0; u < 4; ++u) {
                const int iu = i0 + u * ngt, t = (iu < T_TOK * 32 ? iu : i0) >> 5, b = t >> 11, s = t & (SEQ - 1);
                float vl[4] = {bflo(lo[u].x), bfhi(lo[u].x), bflo(lo[u].y), bfhi(lo[u].y)}, vh[4] = {bflo(hi[u].x), bfhi(hi[u].x), bflo(hi[u].y), bfhi(hi[u].y)};
                float ss = 0.f;
#pragma unroll
                for (int q = 0; q < 4; ++q) ss += vl[q] * vl[q] + vh[q] * vh[q];
                ss += __shfl_xor(ss, 1); ss += __shfl_xor(ss, 2); ss += __shfl_xor(ss, 4);
                const float rs = rsqrtf(ss * (1.0f / 64.0f) + 1e-6f);
                const float csv[4] = {r0[u][0], r0[u][2], r1[u][0], r1[u][2]}, snv[4] = {r0[u][1], r0[u][3], r1[u][1], r1[u][3]};
                float ol[4], oh[4];
#pragma unroll
                for (int q = 0; q < 4; ++q) {
                    const float a = vl[q] * rs * gl[q], bb = vh[q] * rs * gh[q];
                    ol[q] = a * csv[q] - bb * snv[q]; oh[q] = bb * csv[q] + a * snv[q];
                }
                bf16_t* dst = dbase + ((size_t)(b * 2 + kvh) * SEQ + s) * 64;
                u32x2 wl, wh; wl.x = cvt_pk_bf16(ol[0], ol[1]); wl.y = cvt_pk_bf16(ol[2], ol[3]); wh.x = cvt_pk_bf16(oh[0], oh[1]); wh.y = cvt_pk_bf16(oh[2], oh[3]);
                if (iu < T_TOK * 32) { *(u32x2*)(dst + 4 * j) = wl; *(u32x2*)(dst + 32 + 4 * j) = wh; }
            }
        }
    }
    for (int it0 = vb; it0 < 4096; it0 += 4 * nvb) {
        u32x4 raw[4];
        const int tk = c.tid >> 3, pc = c.tid & 7;
#pragma unroll
        for (int u = 0; u < 4; ++u) {
            const int itr = it0 + u * nvb, it = itr < 4096 ? itr : it0, st = it & 31, kvh = (it >> 5) & 1, b = (it >> 6) & 31, which = it >> 11;
            raw[u] = *(const u32x4*)(proj + ((size_t)b * SEQ + st * 64 + tk) * NPROJ + (which ? C_VW : C_VS) + kvh * 64 + pc * 8);
        }
#pragma unroll
        for (int u = 0; u < 4; ++u) {
            LAS float* tile = (LAS float*)c.lds + u * (64 * 65) + tk * 65 + pc * 8;
#pragma unroll
            for (int e = 0; e < 4; ++e) { tile[2 * e] = bflo(raw[u][e]); tile[2 * e + 1] = bfhi(raw[u][e]); }
        }
        __syncthreads();
        const int n = c.tid >> 3, kq = c.tid & 7;
#pragma unroll
        for (int u = 0; u < 4; ++u) {
            const int it = it0 + u * nvb, st = it & 31, kvh = (it >> 5) & 1, b = (it >> 6) & 31, which = it >> 11;
            if (it >= 4096) break;
            const LAS float* tile = (const LAS float*)c.lds + u * (64 * 65);
            float v[8];
#pragma unroll
            for (int jj = 0; jj < 8; ++jj) v[jj] = tile[(kq * 8 + jj) * 65 + n];
            u32x4 w; w.x = cvt_pk_bf16(v[0], v[1]); w.y = cvt_pk_bf16(v[2], v[3]); w.z = cvt_pk_bf16(v[4], v[5]); w.w = cvt_pk_bf16(v[6], v[7]);
            bf16_t* dst = (which ? c.vwt() : c.vst()) + (size_t)(b * 2 + kvh) * 64 * SEQ;
            *(u32x4*)(dst + (size_t)n * SEQ + st * 64 + kq * 8) = w;
        }
        __syncthreads();
    }
}

DI f32x16 mfma32(const bf16x8& a, const bf16x8& b, const f32x16& cacc) { return __builtin_amdgcn_mfma_f32_32x32x16_bf16(a, b, cacc, 0, 0, 0); }
DI int crow(int reg, int hh) { return (reg & 3) + 8 * (reg >> 2) + 4 * hh; }
DI bf16x8 pack8(const f32x16& x, int s) {
    u32x4 p; p.x = cvt_pk_bf16(x[8 * s], x[8 * s + 1]); p.y = cvt_pk_bf16(x[8 * s + 2], x[8 * s + 3]); p.z = cvt_pk_bf16(x[8 * s + 4], x[8 * s + 5]); p.w = cvt_pk_bf16(x[8 * s + 6], x[8 * s + 7]);
    return __builtin_bit_cast(bf16x8, p);
}
DI f32x16 zero16() { f32x16 z; for (int i = 0; i < 16; ++i) z[i] = 0.f; return z; }

DI float pair_sum(float x);
DI void p3_cmp_finish(const Ctx& c) {
    if (c.wave >= 2) return;
    const int task = c.bid + 256 * c.wave;
    if (task >= 512) return;
    const int i = task >> 8, rg = task & 255, n = c.lane & 31, hh = c.lane >> 5;
    const bf16_t* hrow = c.hid() + ((size_t)i * 8192 + rg * 32 + n) * 256 + 8 * hh;
    const float* w2 = c.in(I_CW2) + (size_t)i * 256 * 64 + (size_t)(8 * hh) * 64 + n;
    f32x16 acc0 = zero16(), acc1 = zero16();
#pragma unroll 4
    for (int s = 0; s < 16; ++s) {
        const bf16x8 hb = *(const bf16x8*)(hrow + 16 * s);
        float wa[8], wb[8];
#pragma unroll
        for (int e = 0; e < 8; ++e) { wa[e] = w2[(size_t)(16 * s + e) * 64]; wb[e] = w2[(size_t)(16 * s + e) * 64 + 32]; }
        u32x4 pa, pb;
#pragma unroll
        for (int e = 0; e < 4; ++e) { pa[e] = cvt_pk_bf16(wa[2 * e], wa[2 * e + 1]); pb[e] = cvt_pk_bf16(wb[2 * e], wb[2 * e + 1]); }
        acc0 = mfma32(__builtin_bit_cast(bf16x8, pa), hb, acc0); acc1 = mfma32(__builtin_bit_cast(bf16x8, pb), hb, acc1);
    }
    const int m = rg * 32 + n;
    if (i == 0) {
        float ss = 0.f;
#pragma unroll
        for (int r = 0; r < 16; ++r) ss += acc0[r] * acc0[r] + acc1[r] * acc1[r];
        ss = pair_sum(ss);
        const float rs = rsqrtf(ss * (1.0f / 64.0f) + 1e-6f);
        const float* kng0 = c.in(I_KNG);
        bf16_t* dst = c.kcmp() + (size_t)m * 64;
#pragma unroll
        for (int q = 0; q < 4; ++q) {
            const int n0 = 8 * q + 4 * hh;
            const f32x4 g0 = *(const f32x4*)(kng0 + n0), g1 = *(const f32x4*)(kng0 + 32 + n0);
            u32x2 w0, w1;
            w0.x = cvt_pk_bf16(acc0[4 * q] * rs * g0[0], acc0[4 * q + 1] * rs * g0[1]); w0.y = cvt_pk_bf16(acc0[4 * q + 2] * rs * g0[2], acc0[4 * q + 3] * rs * g0[3]);
            w1.x = cvt_pk_bf16(acc1[4 * q] * rs * g1[0], acc1[4 * q + 1] * rs * g1[1]); w1.y = cvt_pk_bf16(acc1[4 * q + 2] * rs * g1[2], acc1[4 * q + 3] * rs * g1[3]);
            *(u32x2*)(dst + n0) = w0; *(u32x2*)(dst + 32 + n0) = w1;
        }
    } else {
        const int bk = m >> 7, nn = m & 127;
        bf16_t* dst = c.vcmpt() + (size_t)bk * 64 * 128 + nn;
#pragma unroll
        for (int r = 0; r < 16; ++r) { const int nc = crow(r, hh); dst[(size_t)nc * 128] = f2bf(acc0[r]); dst[(size_t)(nc + 32) * 128] = f2bf(acc1[r]); }
    }
}

constexpr int SCAN_BUF_FLOATS = 8 * 2048 + 64;
struct ScanPrm { float mu_r[8], mu_k[8], mu_v[8], kk[8], ka[8], rk[8]; };
DI void scan_prepare(const Ctx& c, LAS float* L, int b, int h, int chunk, int ptid, const ScanPrm& P) {
    const int stp = ptid >> 3, c8 = (ptid & 7) * 8, hc = h * 64 + c8, s = chunk * 32 + stp; const size_t t = (size_t)b * SEQ + s;
    const bf16_t* cur = c.proj() + t * NPROJ + hc;
    const u32x4 rc = *(const u32x4*)(cur + C_R), kc = *(const u32x4*)(cur + C_K), vc = *(const u32x4*)(cur + C_V);
    u32x4 rq = (u32x4){0u, 0u, 0u, 0u}, kq = rq, vq = rq;
    if (s > 0) { rq = *(const u32x4*)(cur - NPROJ + C_R); kq = *(const u32x4*)(cur - NPROJ + C_K); vq = *(const u32x4*)(cur - NPROJ + C_V); }
    const bf16_t* lo = c.lout() + t * 1536 + hc;
    const u32x4 wp = *(const u32x4*)lo, ap = *(const u32x4*)(lo + 512), gp = *(const u32x4*)(lo + 1024);
    float r[8], k[8], v[8], w[8], a[8], g[8], kkv[8];
#define UNP8(dst, src) { _Pragma("unroll") for (int e_ = 0; e_ < 4; ++e_) { dst[2 * e_] = bflo(src[e_]); dst[2 * e_ + 1] = bfhi(src[e_]); } }
    { float t0[8], t1[8];
      UNP8(t0, rc); UNP8(t1, rq);
#pragma unroll
      for (int q = 0; q < 8; ++q) r[q] = t0[q] + P.mu_r[q] * (t1[q] - t0[q]);
      UNP8(t0, kc); UNP8(t1, kq);
#pragma unroll
      for (int q = 0; q < 8; ++q) k[q] = t0[q] + P.mu_k[q] * (t1[q] - t0[q]);
      UNP8(t0, vc); UNP8(t1, vq);
#pragma unroll
      for (int q = 0; q < 8; ++q) v[q] = t0[q] + P.mu_v[q] * (t1[q] - t0[q]); }
    UNP8(w, wp); UNP8(a, ap); UNP8(g, gp);
#undef UNP8
    float ss = 0.f;
#pragma unroll
    for (int q = 0; q < 8; ++q) { w[q] = __expf(-0.6065306597126334f * sigmoidf_(w[q])); a[q] = sigmoidf_(a[q]); kkv[q] = k[q] * P.kk[q]; ss += kkv[q] * kkv[q]; }
    ss = red8(ss);
    const float inv = 1.0f / fmaxf(sqrtf(ss), 1e-12f);
    float bon = 0.f; const int o = stp * 64 + c8;
#pragma unroll
    for (int hq = 0; hq < 2; ++hq) {
        f32x4 av, bv, kv, wv, rv, vv, gv;
#pragma unroll
        for (int q4 = 0; q4 < 4; ++q4) { const int q = hq * 4 + q4;
            const float kk = kkv[q] * inv, km = k[q] * (1.0f + (a[q] - 1.0f) * P.ka[q]);
            av[q4] = -kk; bv[q4] = kk * a[q]; kv[q4] = km; wv[q4] = w[q]; rv[q4] = r[q]; vv[q4] = v[q]; gv[q4] = g[q];
            bon += r[q] * km * P.rk[q]; }
        const int oo = o + hq * 4;
        *(LAS f32x4*)(L + oo) = av; *(LAS f32x4*)(L + 2048 + oo) = bv; *(LAS f32x4*)(L + 4096 + oo) = kv; *(LAS f32x4*)(L + 6144 + oo) = wv; *(LAS f32x4*)(L + 8192 + oo) = rv;
        *(LAS f32x4*)(L + 10240 + oo) = vv; *(LAS f32x4*)(L + 12288 + oo) = gv;
    }
    bon = red8(bon);
    if ((ptid & 7) == 0) L[16384 + stp] = bon;
}
DI void scan_finish(const Ctx& c, const LAS float* L, int b, int h, int chunk, int ptid, const float (&lng)[8], const float (&lnb)[8]) {
    const int stp = ptid >> 3, c8 = (ptid & 7) * 8, hc = h * 64 + c8, o = stp * 64 + c8; const size_t t = (size_t)b * SEQ + chunk * 32 + stp;
    float y[8], vv[8], gv[8];
#pragma unroll
    for (int hq = 0; hq < 2; ++hq) { const f32x4 a = *(const LAS f32x4*)(L + 14336 + o + hq * 4), bq = *(const LAS f32x4*)(L + 10240 + o + hq * 4), cq = *(const LAS f32x4*)(L + 12288 + o + hq * 4);
#pragma unroll
        for (int q = 0; q < 4; ++q) { y[hq * 4 + q] = a[q]; vv[hq * 4 + q] = bq[q]; gv[hq * 4 + q] = cq[q]; } }
    float sm = 0.f;
#pragma unroll
    for (int q = 0; q < 8; ++q) sm += y[q];
    sm = red8(sm);
    const float mean = sm * (1.0f / 64.0f);
    float vr = 0.f;
#pragma unroll
    for (int q = 0; q < 8; ++q) { const float d = y[q] - mean; vr += d * d; }
    vr = red8(vr);
    const float rstd = rsqrtf(vr * (1.0f / 64.0f) + 64e-5f), bon = (ABL & 64) ? 0.f : L[16384 + stp];
    float ov[8];
#pragma unroll
    for (int q = 0; q < 8; ++q) ov[q] = ((y[q] - mean) * rstd * lng[q] + lnb[q] + bon * vv[q]) * gv[q];
    u32x4 wv; wv.x = cvt_pk_bf16(ov[0], ov[1]); wv.y = cvt_pk_bf16(ov[2], ov[3]); wv.z = cvt_pk_bf16(ov[4], ov[5]); wv.w = cvt_pk_bf16(ov[6], ov[7]);
    if (ABL & 1) wv = (u32x4){0u, 0u, 0u, 0u};
    *(u32x4*)(c.xn() + t * DM + hc) = wv;
}
struct ScanOps { f32x4 a0, a1, b0, b1, k0, k1, w0, w1, r0, r1; f32x2 vv; };
DI void scan_load_ops(ScanOps& o, const LAS float* L, int st, int j8, int rp) {
    const int q = st * 64 + j8;
    o.a0 = *(const LAS f32x4*)(L + q); o.a1 = *(const LAS f32x4*)(L + q + 4); o.b0 = *(const LAS f32x4*)(L + 2048 + q); o.b1 = *(const LAS f32x4*)(L + 2048 + q + 4);
    o.k0 = *(const LAS f32x4*)(L + 4096 + q); o.k1 = *(const LAS f32x4*)(L + 4096 + q + 4); o.w0 = *(const LAS f32x4*)(L + 6144 + q); o.w1 = *(const LAS f32x4*)(L + 6144 + q + 4);
    o.r0 = *(const LAS f32x4*)(L + 8192 + q); o.r1 = *(const LAS f32x4*)(L + 8192 + q + 4); o.vv = *(const LAS f32x2*)(L + 10240 + st * 64 + 2 * rp);
}
DI void scan_chain(const Ctx& c, int chain) {
    const int b = chain >> 3, h = chain & 7, tid = c.tid;
    LAS float* LB0 = (LAS float*)c.lds; LAS float* LB1 = LB0 + SCAN_BUF_FLOATS;
    const bool prep = tid >= 256; const int ptid = tid & 255;
    ScanPrm P; float lng[8], lnb[8];
    { const int hc = h * 64 + (ptid & 7) * 8;
#pragma unroll
      for (int q = 0; q < 8; ++q) {
        P.mu_r[q] = c.in(I_MURKV)[hc + q]; P.mu_k[q] = c.in(I_MURKV)[512 + hc + q]; P.mu_v[q] = c.in(I_MURKV)[1024 + hc + q];
        P.kk[q] = c.in(I_KK)[hc + q]; P.ka[q] = c.in(I_KA)[hc + q]; P.rk[q] = c.in(I_RK)[hc + q]; lng[q] = c.in(I_LNXG)[hc + q]; lnb[q] = c.in(I_LNXB)[hc + q]; } }
    const int rp = tid >> 3, j8 = (tid & 7) * 8;
    f32x2 S0[4], S1[4];
#pragma unroll
    for (int q = 0; q < 4; ++q) { S0[q] = (f32x2){0.f, 0.f}; S1[q] = (f32x2){0.f, 0.f}; }
    if (prep) scan_prepare(c, LB0, b, h, 0, ptid, P);
    __syncthreads();
#pragma unroll 1
    for (int chunk = 0; chunk < SEQ / 32; ++chunk) {
        LAS float* Lc = (chunk & 1) ? LB1 : LB0; LAS float* Lo = (chunk & 1) ? LB0 : LB1;
        if (prep) {
            if (chunk >= 1) scan_finish(c, Lo, b, h, chunk - 1, ptid, lng, lnb);
            if (chunk + 1 < SEQ / 32) scan_prepare(c, Lo, b, h, chunk + 1, ptid, P);
        } else {
            ScanOps cur, nxt; scan_load_ops(cur, Lc, 0, j8, rp);
#pragma unroll 2
            for (int st = 0; st < 32; ++st) {
                scan_load_ops(nxt, Lc, st < 31 ? st + 1 : 31, j8, rp);
                const f32x2 A[4] = {{cur.a0[0], cur.a0[1]}, {cur.a0[2], cur.a0[3]}, {cur.a1[0], cur.a1[1]}, {cur.a1[2], cur.a1[3]}};
                const f32x2 Bv[4] = {{cur.b0[0], cur.b0[1]}, {cur.b0[2], cur.b0[3]}, {cur.b1[0], cur.b1[1]}, {cur.b1[2], cur.b1[3]}};
                const f32x2 Kv[4] = {{cur.k0[0], cur.k0[1]}, {cur.k0[2], cur.k0[3]}, {cur.k1[0], cur.k1[1]}, {cur.k1[2], cur.k1[3]}};
                const f32x2 Wv[4] = {{cur.w0[0], cur.w0[1]}, {cur.w0[2], cur.w0[3]}, {cur.w1[0], cur.w1[1]}, {cur.w1[2], cur.w1[3]}};
                const f32x2 Rv[4] = {{cur.r0[0], cur.r0[1]}, {cur.r0[2], cur.r0[3]}, {cur.r1[0], cur.r1[1]}, {cur.r1[2], cur.r1[3]}};
                f32x2 p0 = S0[0] * A[0], p1 = S1[0] * A[0];
#pragma unroll
                for (int q = 1; q < 4; ++q) { p0 = S0[q] * A[q] + p0; p1 = S1[q] * A[q] + p1; }
                const float sa0 = red8(p0.x + p0.y), sa1 = red8(p1.x + p1.y);
                const f32x2 sa0v = {sa0, sa0}, sa1v = {sa1, sa1}, v0v = {cur.vv.x, cur.vv.x}, v1v = {cur.vv.y, cur.vv.y};
                f32x2 y0v = {0.f, 0.f}, y1v = {0.f, 0.f};
#pragma unroll
                for (int q = 0; q < 4; ++q) {
                    S0[q] = S0[q] * Wv[q] + (sa0v * Bv[q] + v0v * Kv[q]);
                    S1[q] = S1[q] * Wv[q] + (sa1v * Bv[q] + v1v * Kv[q]);
                    y0v = S0[q] * Rv[q] + y0v; y1v = S1[q] * Rv[q] + y1v;
                }
                const float y0 = red8(y0v.x + y0v.y), y1 = red8(y1v.x + y1v.y);
                if ((tid & 7) == 0) *(LAS f32x2*)(Lc + 14336 + st * 64 + 2 * rp) = (f32x2){y0, y1};
                cur = nxt;
            }
        }
        __syncthreads();
    }
    if (prep) scan_finish(c, LB1, b, h, SEQ / 32 - 1, ptid, lng, lnb);
    __syncthreads();
}

constexpr int S2_LW = 0, S2_LP = 8192, S2_VV = 16384, S2_GV = 24576, S2_YV = 32768, S2_CL = 40960, S2_MAB = 49152, S2_BON = 53248, S2_PL = 53376,
              S2_AT = 53760, S2_RT = 57856, S2_BT = 61952, S2_KT = 66048, S2_BK = 70144, S2_KK = 74240, S2_VT = 78336, S2_UT = 82432, S2_MKB = 86528, S2_MBR = 88576, S2_MKR = 90624;
DI bf16x8 lds_frag16(const LAS unsigned char* p) { return *(const LAS bf16x8*)p; }
DI bf16x8 lds_frag8x2(const LAS unsigned char* p) { const u32x2 lo = *(const LAS u32x2*)p, hi = *(const LAS u32x2*)(p + 16); return __builtin_bit_cast(bf16x8, (u32x4){lo.x, lo.y, hi.x, hi.y}); }
DI void scan_chain2(const Ctx& c, int chain) {
    const int b = chain >> 3, h = chain & 7, tid = c.tid, lane = c.lane, w = c.wave;
    LAS unsigned char* L = c.lds;
    LAS float* LW = (LAS float*)(L + S2_LW); LAS float* LP = (LAS float*)(L + S2_LP); LAS float* VV = (LAS float*)(L + S2_VV); LAS float* GV = (LAS float*)(L + S2_GV);
    LAS float* YV = (LAS float*)(L + S2_YV); LAS float* CL = (LAS float*)(L + S2_CL); LAS float* MAB = (LAS float*)(L + S2_MAB); LAS float* BON = (LAS float*)(L + S2_BON); LAS float* PL = (LAS float*)(L + S2_PL);
    const int stp = tid >> 4, c4 = (tid & 15) * 4, hc = h * 64 + c4;
    float mu_r[4], mu_k[4], mu_v[4], kk_[4], ka_[4], rk_[4], lng[4], lnb[4];
#pragma unroll
    for (int q = 0; q < 4; ++q) {
        mu_r[q] = c.in(I_MURKV)[hc + q]; mu_k[q] = c.in(I_MURKV)[512 + hc + q]; mu_v[q] = c.in(I_MURKV)[1024 + hc + q];
        kk_[q] = c.in(I_KK)[hc + q]; ka_[q] = c.in(I_KA)[hc + q]; rk_[q] = c.in(I_RK)[hc + q]; lng[q] = c.in(I_LNXG)[hc + q]; lnb[q] = c.in(I_LNXB)[hc + q];
    }
    const int n = lane & 31, hh = lane >> 5;
    f32x16 T0 = zero16(), T1 = zero16();
    const bf16_t* proj = c.proj(); const bf16_t* lout = c.lout(); bf16_t* ymix = c.xn();
#pragma unroll 1
    for (int chunk = 0; chunk < SEQ / 32; ++chunk) {
        const int s = chunk * 32 + stp; const size_t t = (size_t)b * SEQ + s;
        float r[4], km[4], av[4], bv[4];
        {
            const bf16_t* cur = proj + t * NPROJ + hc;
            const u32x2 rc = *(const u32x2*)(cur + C_R), kc = *(const u32x2*)(cur + C_K), vc = *(const u32x2*)(cur + C_V);
            u32x2 rq = (u32x2){0u, 0u}, kq = rq, vq = rq;
            if (s > 0) { rq = *(const u32x2*)(cur - NPROJ + C_R); kq = *(const u32x2*)(cur - NPROJ + C_K); vq = *(const u32x2*)(cur - NPROJ + C_V); }
            const bf16_t* lo = lout + t * 1536 + hc;
            const u32x2 wp = *(const u32x2*)lo, ap = *(const u32x2*)(lo + 512), gp = *(const u32x2*)(lo + 1024);
            float k[4], v[4], wl[4], a[4], g[4], kkv[4];
#define UNP(dst, src) dst[0] = bflo(src.x); dst[1] = bfhi(src.x); dst[2] = bflo(src.y); dst[3] = bfhi(src.y)
            float t0[4], t1[4];
            UNP(t0, rc); UNP(t1, rq);
#pragma unroll
            for (int q = 0; q < 4; ++q) r[q] = t0[q] + mu_r[q] * (t1[q] - t0[q]);
            UNP(t0, kc); UNP(t1, kq);
#pragma unroll
            for (int q = 0; q < 4; ++q) k[q] = t0[q] + mu_k[q] * (t1[q] - t0[q]);
            UNP(t0, vc); UNP(t1, vq);
#pragma unroll
            for (int q = 0; q < 4; ++q) v[q] = t0[q] + mu_v[q] * (t1[q] - t0[q]);
            UNP(wl, wp); UNP(a, ap); UNP(g, gp);
#undef UNP
            float ss = 0.f;
#pragma unroll
            for (int q = 0; q < 4; ++q) { wl[q] = -0.6065306597126334f * sigmoidf_(wl[q]); a[q] = sigmoidf_(a[q]); kkv[q] = k[q] * kk_[q]; ss += kkv[q] * kkv[q]; }
            ss = red16(ss);
            const float inv = 1.0f / fmaxf(sqrtf(ss), 1e-12f);
            float bon = 0.f; f32x4 vv, gv, lw4;
#pragma unroll
            for (int q = 0; q < 4; ++q) { const float kk = kkv[q] * inv; km[q] = k[q] * (1.0f + (a[q] - 1.0f) * ka_[q]); av[q] = -kk; bv[q] = kk * a[q]; vv[q] = v[q]; gv[q] = g[q]; lw4[q] = wl[q]; bon += r[q] * km[q] * rk_[q]; }
            bon = red16(bon);
            const int o = stp * 64 + c4;
            *(LAS f32x4*)(LW + o) = lw4; *(LAS f32x4*)(VV + o) = vv; *(LAS f32x4*)(GV + o) = gv;
            if ((tid & 15) == 0) BON[stp] = bon;
#pragma unroll
            for (int q = 0; q < 4; ++q) *(LAS bf16_t*)(L + S2_VT + ((c4 + q) * 32 + stp) * 2) = f2bf(v[q]);
        }
        __syncthreads();
        {
            const int j = tid >> 3, sg = tid & 7;
            float c0 = LW[(4 * sg) * 64 + j], c1 = c0 + LW[(4 * sg + 1) * 64 + j], c2 = c1 + LW[(4 * sg + 2) * 64 + j], c3 = c2 + LW[(4 * sg + 3) * 64 + j];
            float run = c3;
#pragma unroll
            for (int d = 1; d < 8; d <<= 1) { const float up = __shfl_up(run, d, 8); if (sg >= d) run += up; }
            const float excl = run - c3;
            LP[(4 * sg) * 64 + j] = excl + c0; LP[(4 * sg + 1) * 64 + j] = excl + c1; LP[(4 * sg + 2) * 64 + j] = excl + c2; LP[(4 * sg + 3) * 64 + j] = excl + c3;
        }
        __syncthreads();
        {
            const f32x4 lp = *(const LAS f32x4*)(LP + stp * 64 + c4);
            f32x4 lpm = (f32x4){0.f, 0.f, 0.f, 0.f}; if (stp > 0) lpm = *(const LAS f32x4*)(LP + (stp - 1) * 64 + c4);
            float at[4], rt[4], bt[4], kt[4];
#pragma unroll
            for (int q = 0; q < 4; ++q) { const float P = __expf(lp[q]), Pm = __expf(lpm[q]), iP = __expf(-lp[q]); at[q] = Pm * av[q]; rt[q] = P * r[q]; bt[q] = bv[q] * iP; kt[q] = km[q] * iP; if (stp == 31) PL[c4 + q] = P; }
            const int ob = (stp * 64 + c4) * 2;
            { u32x2 x; x.x = cvt_pk_bf16(at[0], at[1]); x.y = cvt_pk_bf16(at[2], at[3]); *(LAS u32x2*)(L + S2_AT + ob) = x; }
            { u32x2 x; x.x = cvt_pk_bf16(rt[0], rt[1]); x.y = cvt_pk_bf16(rt[2], rt[3]); *(LAS u32x2*)(L + S2_RT + ob) = x; }
            { u32x2 x; x.x = cvt_pk_bf16(bt[0], bt[1]); x.y = cvt_pk_bf16(bt[2], bt[3]); *(LAS u32x2*)(L + S2_BT + ob) = x; }
            { u32x2 x; x.x = cvt_pk_bf16(kt[0], kt[1]); x.y = cvt_pk_bf16(kt[2], kt[3]); *(LAS u32x2*)(L + S2_KT + ob) = x; }
#pragma unroll
            for (int q = 0; q < 4; ++q) { *(LAS bf16_t*)(L + S2_BK + ((c4 + q) * 32 + stp) * 2) = f2bf(bt[q]); *(LAS bf16_t*)(L + S2_KK + ((c4 + q) * 32 + stp) * 2) = f2bf(kt[q]); }
        }
        __syncthreads();
        if (w < 4) {
            const LAS unsigned char* Xa = L + ((w & 2) ? S2_RT : S2_AT) + n * 128 + 16 * hh;
            const LAS unsigned char* Xb = L + ((w & 1) ? S2_KT : S2_BT) + n * 128 + 16 * hh;
            f32x16 m = zero16();
#pragma unroll
            for (int st = 0; st < 4; ++st) m = mfma32(lds_frag16(Xa + 32 * st), lds_frag16(Xb + 32 * st), m);
            const bool incl = (w & 2) != 0;
#pragma unroll
            for (int r_ = 0; r_ < 16; ++r_) { const int tt = crow(r_, hh); const bool keep = incl ? (n <= tt) : (n < tt); const float val = keep ? m[r_] : 0.f;
                if (w == 0) MAB[tt * 32 + n] = val; else *(LAS bf16_t*)(L + (w == 1 ? S2_MKB : (w == 2 ? S2_MBR : S2_MKR)) + (tt * 32 + n) * 2) = f2bf(val); }
        }
        __syncthreads();
        f32x16 yacc = zero16();
        if (w < 2) {
            f32x16 cacc = zero16();
            const LAS unsigned char* vt = L + S2_VT + (32 * w + n) * 64 + 16 * hh;
#pragma unroll
            for (int st = 0; st < 2; ++st) { const bf16x8 vb_ = lds_frag16(vt + 32 * st);
                cacc = mfma32(lds_frag16(L + S2_MKB + n * 64 + 16 * hh + 32 * st), vb_, cacc); yacc = mfma32(lds_frag16(L + S2_MKR + n * 64 + 16 * hh + 32 * st), vb_, yacc); }
#pragma unroll
            for (int jb = 0; jb < 2; ++jb)
#pragma unroll
                for (int st = 0; st < 2; ++st) {
                    const bf16x8 tb = pack8(jb ? T1 : T0, st);
                    const int ko = (32 * jb + 16 * st + 4 * hh) * 2;
                    cacc = mfma32(lds_frag8x2(L + S2_AT + n * 128 + ko), tb, cacc); yacc = mfma32(lds_frag8x2(L + S2_RT + n * 128 + ko), tb, yacc);
                }
#pragma unroll
            for (int r_ = 0; r_ < 16; ++r_) CL[crow(r_, hh) * 64 + 32 * w + n] = cacc[r_];
        }
        __syncthreads();
        if (tid < 256) {
            const int i = tid >> 2, l = tid & 3;
            float u[8];
#pragma unroll
            for (int e = 0; e < 8; ++e) u[e] = 0.f;
#pragma unroll
            for (int tt = 0; tt < 32; ++tt) {
                float acc_ = 0.f;
                if (tt > 0) {
                    const f32x4 m0 = *(const LAS f32x4*)(MAB + tt * 32 + 8 * l), m1 = *(const LAS f32x4*)(MAB + tt * 32 + 8 * l + 4);
#pragma unroll
                    for (int e = 0; e < 4; ++e) acc_ += u[e] * m0[e] + u[4 + e] * m1[e];
                    acc_ += dppmov<0xB1>(acc_); acc_ += dppmov<0x4E>(acc_);
                }
                const float ut = CL[tt * 64 + i] + acc_;
                if (l == (tt >> 3)) u[tt & 7] = ut;
            }
            u32x4 x; x.x = cvt_pk_bf16(u[0], u[1]); x.y = cvt_pk_bf16(u[2], u[3]); x.z = cvt_pk_bf16(u[4], u[5]); x.w = cvt_pk_bf16(u[6], u[7]);
            *(LAS u32x4*)(L + S2_UT + (i * 32 + 8 * l) * 2) = x;
        }
        __syncthreads();
        if (w < 2) {
            const LAS unsigned char* ut = L + S2_UT + (32 * w + n) * 64 + 16 * hh;
            const LAS unsigned char* vt = L + S2_VT + (32 * w + n) * 64 + 16 * hh;
#pragma unroll
            for (int st = 0; st < 2; ++st) {
                const bf16x8 ub = lds_frag16(ut + 32 * st), vb_ = lds_frag16(vt + 32 * st);
                yacc = mfma32(lds_frag16(L + S2_MBR + n * 64 + 16 * hh + 32 * st), ub, yacc);
                T0 = mfma32(lds_frag16(L + S2_BK + n * 64 + 16 * hh + 32 * st), ub, T0); T0 = mfma32(lds_frag16(L + S2_KK + n * 64 + 16 * hh + 32 * st), vb_, T0);
                T1 = mfma32(lds_frag16(L + S2_BK + (32 + n) * 64 + 16 * hh + 32 * st), ub, T1); T1 = mfma32(lds_frag16(L + S2_KK + (32 + n) * 64 + 16 * hh + 32 * st), vb_, T1);
            }
#pragma unroll
            for (int r_ = 0; r_ < 16; ++r_) { const int kr = crow(r_, hh); T0[r_] *= PL[kr]; T1[r_] *= PL[32 + kr]; YV[kr * 64 + 32 * w + n] = yacc[r_]; }
        }
        __syncthreads();
        {
            const int o = stp * 64 + c4;
            const f32x4 y = *(LAS f32x4*)(YV + o), vv = *(LAS f32x4*)(VV + o), gv = *(LAS f32x4*)(GV + o);
            float sm = y[0] + y[1] + y[2] + y[3]; sm = red16(sm);
            const float mean = sm * (1.0f / 64.0f);
            float vr = 0.f;
#pragma unroll
            for (int q = 0; q < 4; ++q) { const float d = y[q] - mean; vr += d * d; }
            vr = red16(vr);
            const float rstd = rsqrtf(vr * (1.0f / 64.0f) + 64e-5f), bon = BON[stp];
            float ov[4];
#pragma unroll
            for (int q = 0; q < 4; ++q) ov[q] = ((y[q] - mean) * rstd * lng[q] + lnb[q] + bon * vv[q]) * gv[q];
            u32x2 wv; wv.x = cvt_pk_bf16(ov[0], ov[1]); wv.y = cvt_pk_bf16(ov[2], ov[3]);
            *(u32x2*)(ymix + t * DM + hc) = wv;
        }
        __syncthreads();
    }
}

constexpr int Q_PITCH = 144, Q_AT = 0, Q_RT = 4608, Q_BT = 9216, Q_KT = 13824, Q_BK = 18432, Q_KK = 22528, Q_VT = 26624, Q_MAB = 30720, Q_MKB = 34816, Q_MBR = 36864, Q_MKR = 38912, Q_PL = 40960, Q_BON = 41216,
              Q_VV = 41472, Q_GV = 49664, Q_SET = 57856, Q_LP = 2 * Q_SET, Q_YV = Q_LP + 8192, Q_CL = Q_YV + 8192, Q_UT = Q_CL + 8192, Q_TT = Q_UT + 4096, Q_PRM = Q_TT + 16384;
#define QT_WOFS(stp_, ptid_) (((((stp_) >> 3) ^ ((ptid_) & 3)) << 4) + ((stp_) & 7) * 2)
#define QT_ROFS(n_, hh_, st_) (((((hh_) + 2 * (st_)) ^ (((n_) >> 3) & 3))) << 4)
struct Scan3Prm { float mu_r[8], mu_k[8], mu_v[8], kk[8], ka[8], rk[8]; };
struct Scan3Raw { u32x4 rc, kc, vc, rq, kq, vq, wp, ap, gp; };
DI void scan3_load(const Ctx& c, Scan3Raw& R, int b, int h, int chunk, int ptid) {
    const int stp = ptid >> 3, c8 = (ptid & 7) * 8, hc = h * 64 + c8, s = chunk * 32 + stp; const size_t t = (size_t)b * SEQ + s;
    const bf16_t* cur = c.proj() + t * NPROJ + hc;
    R.rc = *(const u32x4*)(cur + C_R); R.kc = *(const u32x4*)(cur + C_K); R.vc = *(const u32x4*)(cur + C_V);
    R.rq = (u32x4){0u, 0u, 0u, 0u}; R.kq = R.rq; R.vq = R.rq;
    if (s > 0) { R.rq = *(const u32x4*)(cur - NPROJ + C_R); R.kq = *(const u32x4*)(cur - NPROJ + C_K); R.vq = *(const u32x4*)(cur - NPROJ + C_V); }
    const bf16_t* lo = c.lout() + t * 1536 + hc;
    R.wp = *(const u32x4*)lo; R.ap = *(const u32x4*)(lo + 512); R.gp = *(const u32x4*)(lo + 1024);
}
DI void scan3_s1(const Ctx& c, int h, LAS unsigned char* Q, LAS float* LP, const Scan3Raw& R, int ptid, float (&r)[8], float (&km)[8], float (&av)[8], float (&bv)[8]) {
    const int stp = ptid >> 3, c8 = (ptid & 7) * 8;
    Scan3Prm P;
    { const LAS float* pr = (const LAS float*)(c.lds + Q_PRM) + c8;
#pragma unroll
      for (int q = 0; q < 8; ++q) { P.mu_r[q] = pr[q]; P.mu_k[q] = pr[64 + q]; P.mu_v[q] = pr[128 + q]; P.kk[q] = pr[192 + q]; P.ka[q] = pr[256 + q]; P.rk[q] = pr[320 + q]; } }
    float k[8], v[8], wl[8], a[8], g[8], kkv[8];
#define UNP8(dst, src) { _Pragma("unroll") for (int e_ = 0; e_ < 4; ++e_) { dst[2 * e_] = bflo(src[e_]); dst[2 * e_ + 1] = bfhi(src[e_]); } }
    { float t0[8], t1[8];
      UNP8(t0, R.rc); UNP8(t1, R.rq);
#pragma unroll
      for (int q = 0; q < 8; ++q) r[q] = t0[q] + P.mu_r[q] * (t1[q] - t0[q]);
      UNP8(t0, R.kc); UNP8(t1, R.kq);
#pragma unroll
      for (int q = 0; q < 8; ++q) k[q] = t0[q] + P.mu_k[q] * (t1[q] - t0[q]);
      UNP8(t0, R.vc); UNP8(t1, R.vq);
#pragma unroll
      for (int q = 0; q < 8; ++q) v[q] = t0[q] + P.mu_v[q] * (t1[q] - t0[q]); }
    UNP8(wl, R.wp); UNP8(a, R.ap); UNP8(g, R.gp);
#undef UNP8
    float ss = 0.f;
#pragma unroll
    for (int q = 0; q < 8; ++q) { wl[q] = -0.6065306597126334f * sigmoidf_(wl[q]); a[q] = sigmoidf_(a[q]); kkv[q] = k[q] * P.kk[q]; ss += kkv[q] * kkv[q]; }
    ss = red8(ss);
    const float inv = 1.0f / fmaxf(sqrtf(ss), 1e-12f);
    float bon = 0.f;
#pragma unroll
    for (int q = 0; q < 8; ++q) { const float kk = kkv[q] * inv; km[q] = k[q] * (1.0f + (a[q] - 1.0f) * P.ka[q]); av[q] = -kk; bv[q] = kk * a[q]; bon += r[q] * km[q] * P.rk[q]; }
    bon = red8(bon);
    const int o = stp * 64 + c8;
    *(LAS f32x4*)(LP + o) = (f32x4){wl[0], wl[1], wl[2], wl[3]}; *(LAS f32x4*)(LP + o + 4) = (f32x4){wl[4], wl[5], wl[6], wl[7]};
    LAS float* VV = (LAS float*)(Q + Q_VV); LAS float* GV = (LAS float*)(Q + Q_GV);
    *(LAS f32x4*)(VV + o) = (f32x4){v[0], v[1], v[2], v[3]}; *(LAS f32x4*)(VV + o + 4) = (f32x4){v[4], v[5], v[6], v[7]};
    *(LAS f32x4*)(GV + o) = (f32x4){g[0], g[1], g[2], g[3]}; *(LAS f32x4*)(GV + o + 4) = (f32x4){g[4], g[5], g[6], g[7]};
    if ((ptid & 7) == 0) ((LAS float*)(Q + Q_BON))[stp] = bon;
    int pq = ptid; asm volatile("" : "+v"(pq));
    const int wofs = QT_WOFS(pq >> 3, pq);
#pragma unroll
    for (int q = 0; q < 8; ++q) *(LAS bf16_t*)(Q + Q_VT + (c8 + q) * 64 + wofs) = f2bf(v[q]);
}
DI void scan3_s2(LAS float* LP, int ptid) {
    const int j = ptid >> 2, sg = ptid & 3;
    float cv[8]; float run = 0.f;
#pragma unroll
    for (int e = 0; e < 8; ++e) { run += LP[(8 * sg + e) * 64 + j]; cv[e] = run; }
    float tot = run;
#pragma unroll
    for (int d = 1; d < 4; d <<= 1) { const float up = __shfl_up(tot, d, 4); if (sg >= d) tot += up; }
    const float excl = tot - run;
#pragma unroll
    for (int e = 0; e < 8; ++e) LP[(8 * sg + e) * 64 + j] = excl + cv[e];
}
DI void scan3_s3(LAS unsigned char* Q, const LAS float* LP, int ptid, const float (&r)[8], const float (&km)[8], const float (&av)[8], const float (&bv)[8]) {
    const int stp = ptid >> 3, c8 = (ptid & 7) * 8;
    float lp[8], lpm[8];
    { const f32x4 a0 = *(const LAS f32x4*)(LP + stp * 64 + c8), a1 = *(const LAS f32x4*)(LP + stp * 64 + c8 + 4);
#pragma unroll
      for (int q = 0; q < 4; ++q) { lp[q] = a0[q]; lp[4 + q] = a1[q]; lpm[q] = 0.f; lpm[4 + q] = 0.f; }
      if (stp > 0) { const f32x4 b0 = *(const LAS f32x4*)(LP + (stp - 1) * 64 + c8), b1 = *(const LAS f32x4*)(LP + (stp - 1) * 64 + c8 + 4);
#pragma unroll
        for (int q = 0; q < 4; ++q) { lpm[q] = b0[q]; lpm[4 + q] = b1[q]; } } }
    float at[8], rt[8], bt[8], kt[8];
#pragma unroll
    for (int q = 0; q < 8; ++q) { const float Pq = __expf(lp[q]), Pm = __expf(lpm[q]), iP = __expf(-lp[q]); at[q] = Pm * av[q]; rt[q] = Pq * r[q]; bt[q] = bv[q] * iP; kt[q] = km[q] * iP; if (stp == 31) ((LAS float*)(Q + Q_PL))[c8 + q] = Pq; }
    const int ob = stp * Q_PITCH + c8 * 2;
#define PK8(x) ((u32x4){cvt_pk_bf16(x[0], x[1]), cvt_pk_bf16(x[2], x[3]), cvt_pk_bf16(x[4], x[5]), cvt_pk_bf16(x[6], x[7])})
    *(LAS u32x4*)(Q + Q_AT + ob) = PK8(at); *(LAS u32x4*)(Q + Q_RT + ob) = PK8(rt); *(LAS u32x4*)(Q + Q_BT + ob) = PK8(bt); *(LAS u32x4*)(Q + Q_KT + ob) = PK8(kt);
#undef PK8
    int pq = ptid; asm volatile("" : "+v"(pq));
    const int wofs = QT_WOFS(pq >> 3, pq);
#pragma unroll
    for (int q = 0; q < 8; ++q) { *(LAS bf16_t*)(Q + Q_BK + (c8 + q) * 64 + wofs) = f2bf(bt[q]); *(LAS bf16_t*)(Q + Q_KK + (c8 + q) * 64 + wofs) = f2bf(kt[q]); }
}
DI void scan3_s4(LAS unsigned char* Q, int m, int n, int hh) {
    const LAS unsigned char* Xa = Q + ((m & 2) ? Q_RT : Q_AT) + n * Q_PITCH + 16 * hh;
    const LAS unsigned char* Xb = Q + ((m & 1) ? Q_KT : Q_BT) + n * Q_PITCH + 16 * hh;
    f32x16 acc = zero16();
#pragma unroll
    for (int st = 0; st < 4; ++st) acc = mfma32(lds_frag16(Xa + 32 * st), lds_frag16(Xb + 32 * st), acc);
    const bool incl = (m & 2) != 0;
#pragma unroll
    for (int r_ = 0; r_ < 16; ++r_) { const int tt = crow(r_, hh); const bool keep = incl ? (n <= tt) : (n < tt); const float val = keep ? acc[r_] : 0.f;
        if (m == 0) ((LAS float*)(Q + Q_MAB))[n * 32 + (tt ^ (4 * (n & 7)))] = val; else *(LAS bf16_t*)(Q + (m == 1 ? Q_MKB : (m == 2 ? Q_MBR : Q_MKR)) + (tt * 32 + n) * 2) = f2bf(val); }
}
DI void scan3_s8(const Ctx& c, const LAS unsigned char* Q, const LAS float* YV, int b, int h, int chunk, int ptid) {
    const int stp = ptid >> 3, c8 = (ptid & 7) * 8, hc = h * 64 + c8, o = stp * 64 + c8; const size_t t = (size_t)b * SEQ + chunk * 32 + stp;
    float lng[8], lnb[8];
    { const LAS float* pr = (const LAS float*)(c.lds + Q_PRM) + c8;
#pragma unroll
      for (int q = 0; q < 8; ++q) { lng[q] = pr[384 + q]; lnb[q] = pr[448 + q]; } }
    const LAS float* VV = (const LAS float*)(Q + Q_VV); const LAS float* GV = (const LAS float*)(Q + Q_GV);
    float y[8], vv[8], gv[8];
#pragma unroll
    for (int hq = 0; hq < 2; ++hq) { const f32x4 a = *(const LAS f32x4*)(YV + o + hq * 4), bq = *(const LAS f32x4*)(VV + o + hq * 4), cq = *(const LAS f32x4*)(GV + o + hq * 4);
#pragma unroll
        for (int q = 0; q < 4; ++q) { y[hq * 4 + q] = a[q]; vv[hq * 4 + q] = bq[q]; gv[hq * 4 + q] = cq[q]; } }
    float sm = 0.f;
#pragma unroll
    for (int q = 0; q < 8; ++q) sm += y[q];
    sm = red8(sm);
    const float mean = sm * (1.0f / 64.0f);
    float vr = 0.f;
#pragma unroll
    for (int q = 0; q < 8; ++q) { const float d = y[q] - mean; vr += d * d; }
    vr = red8(vr);
    const float rstd = rsqrtf(vr * (1.0f / 64.0f) + 64e-5f), bon = (ABL & 64) ? 0.f : ((const LAS float*)(Q + Q_BON))[stp];
    float ov[8];
#pragma unroll
    for (int q = 0; q < 8; ++q) ov[q] = ((y[q] - mean) * rstd * lng[q] + lnb[q] + bon * vv[q]) * gv[q];
    u32x4 wv; wv.x = cvt_pk_bf16(ov[0], ov[1]); wv.y = cvt_pk_bf16(ov[2], ov[3]); wv.z = cvt_pk_bf16(ov[4], ov[5]); wv.w = cvt_pk_bf16(ov[6], ov[7]);
    if (ABL & 1) wv = (u32x4){0u, 0u, 0u, 0u};
    *(u32x4*)(c.xn() + t * DM + hc) = wv;
}
DI void scan_chain3(const Ctx& c, int chain) {
    const int b = chain >> 3, h = chain & 7, tid = c.tid, lane = c.lane, w = c.wave;
    LAS unsigned char* L = c.lds;
    LAS float* LP = (LAS float*)(L + Q_LP); LAS float* YV = (LAS float*)(L + Q_YV); LAS float* CL = (LAS float*)(L + Q_CL);
    const bool prep = tid >= 256; const int ptid = tid & 255, n = lane & 31, hh = lane >> 5;
    LAS float* TT = (LAS float*)(L + Q_TT) + (w & 1) * 2048 + lane;
    if (w < 2) {
#pragma unroll
        for (int q = 0; q < 32; ++q) TT[q * 64] = 0.f;
    }
    float r_[8], km_[8], av_[8], bv_[8];
    Scan3Raw R;
    if (tid < 64) { LAS float* pr = (LAS float*)(L + Q_PRM); const int hc = h * 64 + tid;
        pr[tid] = c.in(I_MURKV)[hc]; pr[64 + tid] = c.in(I_MURKV)[512 + hc]; pr[128 + tid] = c.in(I_MURKV)[1024 + hc]; pr[192 + tid] = c.in(I_KK)[hc]; pr[256 + tid] = c.in(I_KA)[hc]; pr[320 + tid] = c.in(I_RK)[hc];
        pr[384 + tid] = c.in(I_LNXG)[hc]; pr[448 + tid] = c.in(I_LNXB)[hc]; }
    if (prep) scan3_load(c, R, b, h, 0, ptid);
    __syncthreads();
    if (prep) { scan3_s1(c, h, L, LP, R, ptid, r_, km_, av_, bv_); scan3_load(c, R, b, h, 1, ptid); }
    __syncthreads();
    if (prep) scan3_s2(LP, ptid);
    __syncthreads();
    if (prep) scan3_s3(L, LP, ptid, r_, km_, av_, bv_);
    __syncthreads();
    if (prep) scan3_s4(L, w - 4, n, hh);
    __syncthreads();
#pragma unroll 1
    for (int chunk = 0; chunk < SEQ / 32; ++chunk) {
        LAS unsigned char* Qc = L + (chunk & 1) * Q_SET;
        LAS unsigned char* Qn = L + ((chunk + 1) & 1) * Q_SET;
        const bool more = chunk + 1 < SEQ / 32;
        if (prep) {
            if (more) scan3_s1(c, h, Qn, LP, R, ptid, r_, km_, av_, bv_);
        } else if (w < 2) {
            f32x16 cacc = zero16();
            int nq = n; asm volatile("" : "+v"(nq));
            const LAS unsigned char* vt = Qc + Q_VT + (32 * w + nq) * 64;
#pragma unroll
            for (int st = 0; st < 2; ++st) cacc = mfma32(lds_frag16(Qc + Q_MKB + nq * 64 + 16 * hh + 32 * st), lds_frag16(vt + QT_ROFS(nq, hh, st)), cacc);
#pragma unroll
            for (int jb = 0; jb < 2; ++jb)
#pragma unroll
                for (int st = 0; st < 2; ++st) {
                    u32x4 tp_;
#pragma unroll
                    for (int e = 0; e < 4; ++e) tp_[e] = cvt_pk_bf16(TT[(jb * 16 + 8 * st + 2 * e) * 64], TT[(jb * 16 + 8 * st + 2 * e + 1) * 64]);
                    const bf16x8 tb = __builtin_bit_cast(bf16x8, tp_);
                    const int ko = (32 * jb + 16 * st + 4 * hh) * 2;
                    cacc = mfma32(lds_frag8x2(Qc + Q_AT + nq * Q_PITCH + ko), tb, cacc);
                }
#pragma unroll
            for (int q = 0; q < 16; ++q) CL[crow(q, hh) * 64 + 32 * w + nq] = cacc[q];
        }
        __syncthreads();
        if (prep) {
            if (w < 6) {
                const int wc = w & 1;
                f32x16 yacc = zero16();
                int nq = n; asm volatile("" : "+v"(nq));
                const LAS unsigned char* vt = Qc + Q_VT + (32 * wc + nq) * 64;
#pragma unroll
                for (int st = 0; st < 2; ++st) yacc = mfma32(lds_frag16(Qc + Q_MKR + nq * 64 + 16 * hh + 32 * st), lds_frag16(vt + QT_ROFS(nq, hh, st)), yacc);
#pragma unroll
                for (int jb = 0; jb < 2; ++jb)
#pragma unroll
                    for (int st = 0; st < 2; ++st) {
                        u32x4 tp_;
#pragma unroll
                        for (int e = 0; e < 4; ++e) tp_[e] = cvt_pk_bf16(TT[(jb * 16 + 8 * st + 2 * e) * 64], TT[(jb * 16 + 8 * st + 2 * e + 1) * 64]);
                        const bf16x8 tb = __builtin_bit_cast(bf16x8, tp_);
                        const int ko = (32 * jb + 16 * st + 4 * hh) * 2;
                        yacc = mfma32(lds_frag8x2(Qc + Q_RT + nq * Q_PITCH + ko), tb, yacc);
                    }
#pragma unroll
                for (int q = 0; q < 16; ++q) YV[crow(q, hh) * 64 + 32 * wc + nq] = yacc[q];
            }
            if (chunk + 2 < SEQ / 32) scan3_load(c, R, b, h, chunk + 2, ptid); if (more) scan3_s2(LP, ptid);
        }
        else {
            int tq_ = tid; asm volatile("" : "+v"(tq_));
            const int i = tq_ >> 2, l = tq_ & 3;
            const LAS float* MT = (const LAS float*)(Qc + Q_MAB);
            float u[8];
#pragma unroll
            for (int e = 0; e < 8; ++e) u[e] = CL[(8 * l + e) * 64 + i];
            int l8 = l << 3;
            f32x4 mlo[2], mhi[2];
#define SUB_LOAD(t_) { const int g_ = 4 * ((t_) & 7); const LAS float* mp_ = MT + (t_) * 32 + (l8 ^ (g_ & 24)); mlo[(t_) & 1] = *(const LAS f32x4*)(mp_ + (g_ & 4)); mhi[(t_) & 1] = *(const LAS f32x4*)(mp_ + (4 ^ (g_ & 4))); }
#define SUB_STEP(t_, CTRL_) { float ut_ = dppmov<CTRL_>(u[(t_) & 7]); asm volatile("" : "+v"(l8), "+v"(ut_)); if ((t_) + 1 < 31) SUB_LOAD((t_) + 1) \
                _Pragma("unroll") for (int e = 0; e < 4; ++e) { u[e] += mlo[(t_) & 1][e] * ut_; u[4 + e] += mhi[(t_) & 1][e] * ut_; } }
#define SUB_8(b_, CTRL_) SUB_STEP(b_ + 0, CTRL_) SUB_STEP(b_ + 1, CTRL_) SUB_STEP(b_ + 2, CTRL_) SUB_STEP(b_ + 3, CTRL_) SUB_STEP(b_ + 4, CTRL_) SUB_STEP(b_ + 5, CTRL_) SUB_STEP(b_ + 6, CTRL_) SUB_STEP(b_ + 7, CTRL_)
            SUB_LOAD(0)
            SUB_8(0, 0x00) SUB_8(8, 0x55) SUB_8(16, 0xAA)
            SUB_STEP(24, 0xFF) SUB_STEP(25, 0xFF) SUB_STEP(26, 0xFF) SUB_STEP(27, 0xFF) SUB_STEP(28, 0xFF) SUB_STEP(29, 0xFF) SUB_STEP(30, 0xFF)
#undef SUB_8
#undef SUB_STEP
#undef SUB_LOAD
            u32x4 x; x.x = cvt_pk_bf16(u[0], u[1]); x.y = cvt_pk_bf16(u[2], u[3]); x.z = cvt_pk_bf16(u[4], u[5]); x.w = cvt_pk_bf16(u[6], u[7]);
            *(LAS u32x4*)(L + Q_UT + (i * 32 + 8 * l) * 2) = x;
        }
        __syncthreads();
        if (prep) { if (more) scan3_s3(Qn, LP, ptid, r_, km_, av_, bv_); }
        else {
            const int wc = w & 1;
            int nq7 = n; asm volatile("" : "+v"(nq7));
            const LAS unsigned char* ut = L + Q_UT + (32 * wc + nq7) * 64 + 16 * hh;
            const LAS unsigned char* vt = Qc + Q_VT + (32 * wc + nq7) * 64;
            const LAS float* PL = (const LAS float*)(Qc + Q_PL);
            if (w < 2) {
                f32x16 T0, yacc;
#pragma unroll
                for (int q = 0; q < 16; ++q) { T0[q] = TT[q * 64]; yacc[q] = YV[crow(q, hh) * 64 + 32 * wc + nq7]; }
#pragma unroll
                for (int st = 0; st < 2; ++st) {
                    const int rs_ = QT_ROFS(nq7, hh, st), ro = nq7 * 64 + rs_;
                    const bf16x8 ub = lds_frag16(ut + 32 * st), vb_ = lds_frag16(vt + rs_);
                    yacc = mfma32(lds_frag16(Qc + Q_MBR + nq7 * 64 + 16 * hh + 32 * st), ub, yacc);
                    T0 = mfma32(lds_frag16(Qc + Q_BK + ro), ub, T0); T0 = mfma32(lds_frag16(Qc + Q_KK + ro), vb_, T0);
                }
#pragma unroll
                for (int q = 0; q < 16; ++q) { const int kr = crow(q, hh); TT[q * 64] = T0[q] * PL[kr]; YV[kr * 64 + 32 * wc + nq7] = yacc[q]; }
            } else {
                f32x16 T1;
#pragma unroll
                for (int q = 0; q < 16; ++q) T1[q] = TT[(16 + q) * 64];
#pragma unroll
                for (int st = 0; st < 2; ++st) {
                    const int rs_ = QT_ROFS(nq7, hh, st), ro = nq7 * 64 + rs_;
                    const bf16x8 ub = lds_frag16(ut + 32 * st), vb_ = lds_frag16(vt + rs_);
                    T1 = mfma32(lds_frag16(Qc + Q_BK + 2048 + ro), ub, T1); T1 = mfma32(lds_frag16(Qc + Q_KK + 2048 + ro), vb_, T1);
                }
#pragma unroll
                for (int q = 0; q < 16; ++q) TT[(16 + q) * 64] = T1[q] * PL[32 + crow(q, hh)];
            }
        }
        __syncthreads();
        if (prep) { if (more) scan3_s4(Qn, w - 4, n, hh); }
        else scan3_s8(c, Qc, YV, b, h, chunk, ptid);
        __syncthreads();
    }
}


DI float pair_max(float x) { const u32x2 r = __builtin_amdgcn_permlane32_swap(__float_as_uint(x), __float_as_uint(x), false, false); return fmaxf(__uint_as_float(r.x), __uint_as_float(r.y)); }
DI float pair_sum(float x) { const u32x2 r = __builtin_amdgcn_permlane32_swap(__float_as_uint(x), __float_as_uint(x), false, false); return __uint_as_float(r.x) + __uint_as_float(r.y); }
DI float fexp2(float x) { return __builtin_amdgcn_exp2f(x); }
constexpr float M_FLOOR = -30000.0f, NEGBIG = -1e30f;
DI bf16x8 att_vf(const LAS unsigned char* vr, int g, int ksw) { const u32x2 lo_ = *(const LAS u32x2*)(vr + ((g ^ ksw) << 4)), hi_ = *(const LAS u32x2*)(vr + (((g + 1) ^ ksw) << 4)); return __builtin_bit_cast(bf16x8, (u32x4){lo_.x, lo_.y, hi_.x, hi_.y}); }
constexpr int ATT_RING_OFF = 16384, ATT_SLOT = 16384, ATT_IMP_OFF = 65536, ATT_QR_OFF = 100352;

template <int MODE, bool PRE0 = false>
DI void flash_lds(const Ctx& c, const bf16_t* Kb, const bf16_t* Vt, unsigned blkmask, const bf16x8 (&q)[4], int tq, int qb, unsigned selmask, int n, int hh, int half, float gate, f32x16 (&out)[2]) {
    LAS unsigned char* ring = c.lds + ATT_RING_OFF;
    const int row = c.tid >> 3, gsw = (c.tid & 7) ^ ((row >> 1) & 7);
    const bf16_t* ksrc = Kb + (size_t)row * 64 + gsw * 8;
    const bf16_t* vsrc = Vt + (size_t)row * SEQ + gsw * 8;
    const unsigned wofs = (unsigned)c.wave * 1024u;
#define ATT_ISSUE(j, slot) do { \
        __builtin_amdgcn_global_load_lds((const unsigned*)(ksrc + (size_t)(j) * 4096), (LAS unsigned*)(ring + (slot) * ATT_SLOT + wofs), 16, 0, 0); \
        __builtin_amdgcn_global_load_lds((const unsigned*)(vsrc + (size_t)(j) * 64), (LAS unsigned*)(ring + (slot) * ATT_SLOT + 8192 + wofs), 16, 0, 0); } while (0)
    unsigned m = blkmask; const int nb = __builtin_popcount(m);
    int j0 = -1, j1 = -1;
    if (nb > 0) { j0 = __builtin_ctz(m); m &= m - 1; if (!PRE0) ATT_ISSUE(j0, 0); }
    if (nb > 1) { j1 = __builtin_ctz(m); m &= m - 1; ATT_ISSUE(j1, PRE0 ? 0 : 1); }
    float lrun = 0.f; f32x16 o[2]; o[0] = zero16(); o[1] = zero16();
    const int ksw = (n >> 1) & 7;
    int slot = PRE0 ? 2 : 0;
#pragma unroll 1
    for (int i = 0; i < nb; ++i) {
        if (i + 1 < nb) asm volatile("s_waitcnt vmcnt(2)" ::: "memory"); else asm volatile("s_waitcnt vmcnt(0)" ::: "memory");
        __builtin_amdgcn_s_barrier();
        asm volatile("" ::: "memory");
        int j2 = -1;
        if (i + 2 < nb) { j2 = __builtin_ctz(m); m &= m - 1; const int s2 = slot >= 1 ? slot - 1 : 2; ATT_ISSUE(j2, s2); }
        const LAS unsigned char* kb = ring + slot * ATT_SLOT; const LAS unsigned char* vb = kb + 8192;
        const bool bit = (MODE == 0) ? ((selmask >> j0) & 1u) : true;
        if (__ballot(bit) != 0ull) {
            int cls0 = 1, cls1 = 1;
            if (j0 == qb) { cls0 = (0 < half) ? 1 : 2; cls1 = (1 == half) ? 2 : 0; }
            if (MODE == 1 && j0 == qb - 4) { cls0 = (0 == half) ? 3 : 0; cls1 = (1 > half) ? 1 : 3; }
            f32x16 s0 = zero16(), s1 = zero16();
            const LAS unsigned char* kr0 = kb + n * 128; const LAS unsigned char* kr1 = kr0 + 32 * 128;
            if (cls0 && cls1) {
#pragma unroll
                for (int s = 0; s < 4; ++s) { const bf16x8 ka = *(const LAS bf16x8*)(kr0 + (((2 * s + hh) ^ ksw) << 4)), kc = *(const LAS bf16x8*)(kr1 + (((2 * s + hh) ^ ksw) << 4)); s0 = mfma32(ka, q[s], s0); s1 = mfma32(kc, q[s], s1); }
            } else if (cls0) {
#pragma unroll
                for (int s = 0; s < 4; ++s) { const bf16x8 ka = *(const LAS bf16x8*)(kr0 + (((2 * s + hh) ^ ksw) << 4)); s0 = mfma32(ka, q[s], s0); }
            } else {
#pragma unroll
                for (int s = 0; s < 4; ++s) { const bf16x8 kc = *(const LAS bf16x8*)(kr1 + (((2 * s + hh) ^ ksw) << 4)); s1 = mfma32(kc, q[s], s1); }
            }
            const int tl = tq & 31;
            if (cls0 >= 2) {
#pragma unroll
                for (int r = 0; r < 16; ++r) { const int kl = crow(r, hh); const bool v = (cls0 == 2) ? (kl <= tl) : (kl > tl); s0[r] = v ? s0[r] : NEGBIG; }
            }
            if (cls1 >= 2) {
#pragma unroll
                for (int r = 0; r < 16; ++r) { const int kl = crow(r, hh); const bool v = (cls1 == 2) ? (kl <= tl) : (kl > tl); s1[r] = v ? s1[r] : NEGBIG; }
            }
            if (MODE == 0) {
#pragma unroll
                for (int r = 0; r < 16; ++r) { s0[r] = bit ? s0[r] : NEGBIG; s1[r] = bit ? s1[r] : NEGBIG; }
            }
            float psa = 0.f, psb = 0.f;
            if (cls0) {
#pragma unroll
                for (int r = 0; r < 16; ++r) { s0[r] = fexp2(s0[r]); psa += s0[r]; }
            }
            if (cls1) {
#pragma unroll
                for (int r = 0; r < 16; ++r) { s1[r] = fexp2(s1[r]); psb += s1[r]; }
            }
            const unsigned bitw = bit ? 0xffffffffu : 0u;
            lrun += psa + psb;
#define ATT_PK(x, h_) ({ u32x4 p_ = __builtin_bit_cast(u32x4, pack8(x, h_));  __builtin_bit_cast(bf16x8, p_); })
            const LAS unsigned char* vr0 = vb + n * 128 + 8 * hh; const LAS unsigned char* vr1 = vr0 + 32 * 128;
#define ATT_VF(vr, g) att_vf((vr), (g), ksw)
            if (cls0) {
                const bf16x8 pa = ATT_PK(s0, 0), pb = ATT_PK(s0, 1);
                o[0] = mfma32(ATT_VF(vr0, 0), pa, o[0]); o[1] = mfma32(ATT_VF(vr1, 0), pa, o[1]);
                o[0] = mfma32(ATT_VF(vr0, 2), pb, o[0]); o[1] = mfma32(ATT_VF(vr1, 2), pb, o[1]);
            }
            if (cls1) {
                const bf16x8 pa = ATT_PK(s1, 0), pb = ATT_PK(s1, 1);
                o[0] = mfma32(ATT_VF(vr0, 4), pa, o[0]); o[1] = mfma32(ATT_VF(vr1, 4), pa, o[1]);
                o[0] = mfma32(ATT_VF(vr0, 6), pb, o[0]); o[1] = mfma32(ATT_VF(vr1, 6), pb, o[1]);
            }
#undef ATT_VF
#undef ATT_PK
        }
        j0 = j1; j1 = j2; slot = slot == 2 ? 0 : slot + 1;
    }
    __builtin_amdgcn_s_barrier();
    asm volatile("" ::: "memory");
#undef ATT_ISSUE
    const float lt = pair_sum(lrun), sc = lt > 0.f ? gate / lt : 0.f;
#pragma unroll
    for (int r = 0; r < 16; ++r) { out[0][r] += o[0][r] * sc; out[1][r] += o[1][r] * sc; }
}

DI void load_q2(const Ctx& c, const bf16_t* qp, int pos, int hh, bf16x8 (&qn)[4], bf16x8 (&qr)[4]) {
    float y[4][8]; float ss = 0.f;
    u32x4 raw[4];
#pragma unroll
    for (int s = 0; s < 4; ++s) raw[s] = *(const u32x4*)(qp + 16 * s);
    const float* qg = c.in(I_QNG) + 8 * hh;
    const float* rp = c.rope() + (size_t)pos * 64 + 16 * hh;
#pragma unroll
    for (int s = 0; s < 4; ++s)
#pragma unroll
        for (int e = 0; e < 4; ++e) { y[s][2 * e] = bflo(raw[s][e]); y[s][2 * e + 1] = bfhi(raw[s][e]); ss += y[s][2 * e] * y[s][2 * e] + y[s][2 * e + 1] * y[s][2 * e + 1]; }
    ss += __shfl_xor(ss, 32);
    const float rs = rsqrtf(ss * (1.0f / 64.0f) + 1e-6f) * (0.125f * 1.4426950408889634f);
#pragma unroll
    for (int s = 0; s < 4; ++s)
#pragma unroll
        for (int e = 0; e < 8; ++e) y[s][e] *= rs * qg[16 * s + e];
#pragma unroll
    for (int s = 0; s < 4; ++s) { u32x4 p; for (int e = 0; e < 4; ++e) p[e] = cvt_pk_bf16(y[s][2 * e], y[s][2 * e + 1]); qn[s] = __builtin_bit_cast(bf16x8, p); }
#pragma unroll
    for (int s = 0; s < 2; ++s) {
        float lo[8], hi[8];
#pragma unroll
        for (int e = 0; e < 8; ++e) { const float cs = rp[32 * s + 2 * e], sn = rp[32 * s + 2 * e + 1]; lo[e] = y[s][e] * cs - y[s + 2][e] * sn; hi[e] = y[s + 2][e] * cs + y[s][e] * sn; }
        u32x4 pl, ph; for (int e = 0; e < 4; ++e) { pl[e] = cvt_pk_bf16(lo[2 * e], lo[2 * e + 1]); ph[e] = cvt_pk_bf16(hi[2 * e], hi[2 * e + 1]); }
        qr[s] = __builtin_bit_cast(bf16x8, pl); qr[s + 2] = __builtin_bit_cast(bf16x8, ph);
    }
}

DI void attn_item(const Ctx& c, int item) {
    const int rk = item >> 8, jq = (item + 4 * (rk & ~1)) & 31, qb = (rk & 1) ? 31 - jq : jq, kvh = (item >> 5) & 1, b = item >> 6;
    const int w = c.wave, g = w >> 1, head = kvh * 4 + g, n = c.lane & 31, hh = c.lane >> 5;
    const int tokw0 = qb * 64 + (w & 1) * 32, pos = tokw0 + n, tq = (w & 1) * 32 + n;
    LAS float* IMP4 = (LAS float*)(c.lds + ATT_IMP_OFF);
    LAS unsigned* SEL = (LAS unsigned*)(c.lds + 8192);
    LAS float* INV = (LAS float*)(c.lds + 8192 + 512);
    if (c.tid == 0) SEL[64] = 0u;
    const bf16_t* prow = c.proj() + ((size_t)b * SEQ + pos) * NPROJ;
    const bf16_t* qp = prow + C_Q + head * 64 + 8 * hh;
    float gate[3];
    { const bf16_t* gp = prow + C_GL + head * 3; for (int i = 0; i < 3; ++i) gate[i] = ((ABL >> (3 + i)) & 1) ? 0.f : sigmoidf_(bf2f(gp[i])); }
    f32x16 out[2]; out[0] = zero16(); out[1] = zero16();
    {
        LAS unsigned char* ring = c.lds + ATT_RING_OFF;
        {
            const int row = c.tid >> 3, gsw = (c.tid & 7) ^ ((row >> 1) & 7); const unsigned wofs = (unsigned)c.wave * 1024u;
            const bf16_t* kc = c.kcmp() + (size_t)(b * 2 + kvh) * 128 * 64 + (size_t)row * 64 + gsw * 8;
            const bf16_t* vc = c.vcmpt() + (size_t)(b * 2 + kvh) * 64 * 128 + (size_t)row * 128 + gsw * 8;
#pragma unroll
            for (int j = 0; j < 2; ++j) {
                __builtin_amdgcn_global_load_lds((const unsigned*)(kc + j * 4096), (LAS unsigned*)(ring + j * ATT_SLOT + wofs), 16, 0, 0);
                __builtin_amdgcn_global_load_lds((const unsigned*)(vc + j * 64), (LAS unsigned*)(ring + j * ATT_SLOT + 8192 + wofs), 16, 0, 0);
            }
            __builtin_amdgcn_global_load_lds((const unsigned*)(c.ksr() + (size_t)(b * 2 + kvh) * SEQ * 64 + (size_t)row * 64 + gsw * 8), (LAS unsigned*)(ring + 2 * ATT_SLOT + wofs), 16, 0, 0);
            __builtin_amdgcn_global_load_lds((const unsigned*)(c.vst() + (size_t)(b * 2 + kvh) * 64 * SEQ + (size_t)row * SEQ + gsw * 8), (LAS unsigned*)(ring + 2 * ATT_SLOT + 8192 + wofs), 16, 0, 0);
        }
        bf16x8 qn[4];
        {
            bf16x8 qr0[4]; load_q2(c, qp, pos, hh, qn, qr0);
#pragma unroll
            for (int s = 0; s < 4; ++s) *(LAS bf16x8*)(c.lds + ATT_QR_OFF + s * 8192 + c.tid * 16) = qr0[s];
        }
        asm volatile("s_waitcnt vmcnt(0)" ::: "memory");
        __syncthreads();
        const int ksw = (n >> 1) & 7;
        float lrun = 0.f;
        float carry = 0.f;
        LAS float* impw = IMP4 + g * (32 * 65) + tq;
#pragma unroll 1
        for (int t = 0; t < 4; ++t) {
            const LAS unsigned char* kr = ring + (t >> 1) * ATT_SLOT + (32 * (t & 1) + n) * 128;
            const LAS unsigned char* vb = ring + (t >> 1) * ATT_SLOT + 8192;
            const int tt = t & 1;
            f32x16 sc = zero16();
#pragma unroll
            for (int s = 0; s < 4; ++s) { const bf16x8 kf = *(const LAS bf16x8*)(kr + (((2 * s + hh) ^ ksw) << 4)); sc = mfma32(kf, qn[s], sc); }
            float ps = 0.f;
#pragma unroll
            for (int r = 0; r < 16; ++r) { const int key = t * 32 + crow(r, hh); const bool v = key <= 126 && key * 16 + 31 <= pos; sc[r] = v ? fexp2(sc[r]) : 0.f; ps += sc[r]; }
            lrun += ps;
            const bf16x8 pf0 = pack8(sc, 0), pf1 = pack8(sc, 1);
#pragma unroll
            for (int rb = 0; rb < 2; ++rb) {
                const LAS unsigned char* vr = vb + (32 * rb + n) * 128 + 8 * hh;
                const u32x2 l0 = *(const LAS u32x2*)(vr + (((4 * tt) ^ ksw) << 4)), h0 = *(const LAS u32x2*)(vr + (((4 * tt + 1) ^ ksw) << 4));
                const u32x2 l1 = *(const LAS u32x2*)(vr + (((4 * tt + 2) ^ ksw) << 4)), h1 = *(const LAS u32x2*)(vr + (((4 * tt + 3) ^ ksw) << 4));
                const bf16x8 v0 = __builtin_bit_cast(bf16x8, (u32x4){l0.x, l0.y, h0.x, h0.y}), v1 = __builtin_bit_cast(bf16x8, (u32x4){l1.x, l1.y, h1.x, h1.y});
                out[rb] = mfma32(v0, pf0, out[rb]); out[rb] = mfma32(v1, pf1, out[rb]);
            }
            float Ep[4];
#pragma unroll
            for (int q = 0; q < 4; ++q) Ep[q] = __shfl_xor(sc[4 * q + 3], 32);
#pragma unroll
            for (int q = 0; q < 4; ++q) {
                const float Gs = sc[4 * q] + sc[4 * q + 1] + sc[4 * q + 2] + sc[4 * q + 3];
                const float prev0 = q > 0 ? Ep[q - 1] : carry;
                const float add = hh ? Ep[q] : prev0;
                impw[(8 * t + 2 * q + hh) * 65] = Gs + add;
            }
            carry = Ep[3];
        }
        lrun = pair_sum(lrun);
        const float inv = lrun > 0.f ? 1.0f / lrun : 0.f;
        if (hh == 0) INV[g * 64 + tq] = inv;
        const float osc = gate[0] * inv;
#pragma unroll
        for (int r = 0; r < 16; ++r) { out[0][r] *= osc; out[1][r] *= osc; }
    }
    __syncthreads();
    {
        const int tkn = c.tid >> 3, sub = c.tid & 7;
        unsigned mask;
        if (qb < 8) mask = (1u << (qb + 1)) - 1u;
        else {
            mask = 1u | (1u << qb) | (1u << (qb - 1));
            float v[4];
            const float i0 = INV[tkn], i1 = INV[64 + tkn], i2 = INV[128 + tkn], i3 = INV[192 + tkn];
#pragma unroll
            for (int e = 0; e < 4; ++e) {
                const int j = sub * 4 + e; const LAS float* ip = IMP4 + j * 65 + tkn;
                const float iv = ip[0] * i0 + ip[32 * 65] * i1 + ip[2 * 32 * 65] * i2 + ip[3 * 32 * 65] * i3;
                v[e] = (j >= 1 && j <= qb - 2) ? iv : -1.0f;
            }
#pragma unroll 1
            for (int pick = 0; pick < 5; ++pick) {
                float bv = v[0]; int bj = sub * 4;
#pragma unroll
                for (int e = 1; e < 4; ++e) if (v[e] > bv) { bv = v[e]; bj = sub * 4 + e; }
#define TOPK_STEP(CTRL) { const float pv_ = dppmov<CTRL>(bv); const int pj_ = __builtin_amdgcn_update_dpp(0, bj, CTRL, 0xf, 0xf, true); const bool t_ = pv_ > bv || (pv_ == bv && pj_ < bj); bv = t_ ? pv_ : bv; bj = t_ ? pj_ : bj; }
                TOPK_STEP(0xB1) TOPK_STEP(0x4E) TOPK_STEP(0x141)
#undef TOPK_STEP
                if (bv < 0.f) break;
                mask |= 1u << bj;
#pragma unroll
                for (int e = 0; e < 4; ++e) if (sub * 4 + e == bj) v[e] = -1.0f;
            }
        }
        if (sub == 0) { SEL[tkn] = mask; __hip_atomic_fetch_or(SEL + 64, mask, __ATOMIC_RELAXED, __HIP_MEMORY_SCOPE_WORKGROUP); }
    }
    __syncthreads();
    const unsigned selmask = SEL[tq];
    const unsigned anysel = SEL[64] & ((2u << qb) - 1u);
    {
        bf16x8 qr[4];
#pragma unroll
        for (int s = 0; s < 4; ++s) qr[s] = *(const LAS bf16x8*)(c.lds + ATT_QR_OFF + s * 8192 + c.tid * 16);
        flash_lds<0, true>(c, c.ksr() + (size_t)(b * 2 + kvh) * SEQ * 64, c.vst() + (size_t)(b * 2 + kvh) * 64 * SEQ, anysel, qr, tq, qb, selmask, n, hh, w & 1, gate[1], out);
        const unsigned wmask = ((2u << qb) - 1u) & ~((qb >= 4) ? ((1u << (qb - 4)) - 1u) : 0u);
        flash_lds<1>(c, c.kwr() + (size_t)(b * 2 + kvh) * SEQ * 64, c.vwt() + (size_t)(b * 2 + kvh) * 64 * SEQ, wmask, qr, tq, qb, 0xffffffffu, n, hh, w & 1, gate[2], out);
    }
    {
        constexpr int OROW = 520;
        LAS unsigned char* ot = c.lds + ATT_RING_OFF + tq * OROW + g * 128 + 8 * hh;
#pragma unroll
        for (int rb = 0; rb < 2; ++rb)
#pragma unroll
            for (int q = 0; q < 4; ++q) { u32x2 wv; wv.x = cvt_pk_bf16(out[rb][4 * q], out[rb][4 * q + 1]); wv.y = cvt_pk_bf16(out[rb][4 * q + 2], out[rb][4 * q + 3]); if (ABL & 2) wv = (u32x2){0u, 0u}; *(LAS u32x2*)(ot + (32 * rb + 8 * q) * 2) = wv; }
        __syncthreads();
        bf16_t* yb = c.xn() + ((size_t)b * SEQ + qb * 64) * DM + 512 + kvh * 256;
#pragma unroll
        for (int pc = 0; pc < 4; ++pc) {
            const int piece = pc * NTHREADS + c.tid, tk = piece >> 5, c16 = piece & 31;
            const u32x2 lo = *(const LAS u32x2*)(c.lds + ATT_RING_OFF + tk * OROW + c16 * 16), hi = *(const LAS u32x2*)(c.lds + ATT_RING_OFF + tk * OROW + c16 * 16 + 8);
            *(u32x4*)(yb + (size_t)tk * DM + c16 * 8) = (u32x4){lo.x, lo.y, hi.x, hi.y};
        }
    }
    __syncthreads();
}

DI void p5_moe_weights(const Ctx& c) {
    const float* w1 = c.in(I_MW1); const float* w2 = c.in(I_MW2);
    for (int it = c.bid; it < 4096 + 2048; it += c.G) {
        if (it < 4096) {
            const int e = it >> 7, r = it & 127, ntile = r >> 4, kt = r & 15;
            tconv_big_fp8(c, w1 + (size_t)e * DM * 2048, 2048, c.w1t() + (size_t)e * 2048 * DM, DM, kt * 64, ntile * 256,
                          [](int nn) { const int half = nn >> 10, jn = nn & 1023; return (jn >> 7) * 256 + half * 128 + (jn & 127); }, 32.0f);
        } else {
            const int j = it - 4096, e = j >> 6, r = j & 63, ntile = r >> 4, kt = r & 15;
            tconv_big_fp8(c, w2 + (size_t)e * DFF * DM, DM, c.w2t() + (size_t)e * DM * DFF, DFF, kt * 64, ntile * 256, [](int nn) { return nn; }, 32.0f);
        }
    }
}

DI void p6_router(const Ctx& c, int dry) {
    LAS unsigned char* WH = c.lds;
    LAS float* LN2 = (LAS float*)(c.lds + 131072);
    LAS int* LCNT = (LAS int*)(c.lds + 135168); LAS int* LBASE = LCNT + 32;
    LAS unsigned char* XB = c.lds + 136192 + c.wave * 2048;
    {
        const bf16_t* wt = c.wrt();
        for (int i = c.tid; i < 8192; i += NTHREADS) {
            const int plane = i >> 12, m = (i >> 7) & 31, cch = i & 127;
            const u32x4 v = *(const u32x4*)(wt + (size_t)plane * NEXP * DM + (size_t)m * DM + cch * 8);
            *(LAS u32x4*)(WH + plane * 65536 + m * 2048 + ((cch ^ (m & 15)) << 4)) = v;
        }
    }
    for (int i = c.tid; i < DM; i += NTHREADS) LN2[i] = c.in(I_LN2)[i];
    if (c.tid < NEXP) LCNT[c.tid] = 0;
    __syncthreads();
    const bf16_t* x1 = (const bf16_t*)(c.ws + WS_X1B); unsigned char* hb = c.h8();
    int* cnt = c.ctl(); int* ids = c.ids(); float* rsl = c.rsl(); unsigned* tp = (unsigned*)(c.ws + WS_TP); float* tg = (float*)(c.ws + WS_TG);
    const int n = c.lane & 31, hh = c.lane >> 5;
    const float* br = c.in(I_MBR);
    for (int t0b = c.bid * 256; t0b < T_TOK; t0b += c.G * 256) {
        const int t0 = t0b + c.wave * 32; const bool live = t0 < T_TOK; const int tok = live ? t0 + n : n;
        const int tl = c.lane >> 2, kq = c.lane & 3;
        const int tokA = (live ? t0 : 0) + tl;
        const bf16_t* xpa = x1 + (size_t)tokA * DM + 8 * kq; const bf16_t* xpb = xpa + 16 * DM;
        unsigned char* hpa = hb + (size_t)tokA * DM + 8 * kq; unsigned char* hpb = hpa + 16 * DM;
        LAS unsigned char* xw = XB + (kq >> 1) * 1024 + (kq & 1) * 512 + tl * 16;
        const LAS unsigned char* xr = XB + hh * 512 + n * 16;
        const LAS unsigned char* wr_ = WH + n * 2048;
        f32x16 acc = zero16(); float ssa = 0.f, ssb = 0.f;
        u32x4 cur[8];
#pragma unroll
        for (int j = 0; j < 4; ++j) { cur[2 * j] = *(const u32x4*)(xpa + 32 * j); cur[2 * j + 1] = *(const u32x4*)(xpb + 32 * j); }
#pragma unroll 1
        for (int g4 = 0; g4 < 8; ++g4) {
            u32x4 nxt[8];
            const int gn = g4 < 7 ? g4 + 1 : 7;
#pragma unroll
            for (int j = 0; j < 4; ++j) { nxt[2 * j] = *(const u32x4*)(xpa + 128 * gn + 32 * j); nxt[2 * j + 1] = *(const u32x4*)(xpb + 128 * gn + 32 * j); }
#pragma unroll
            for (int j = 0; j < 4; ++j) {
                const int s2 = 4 * g4 + j;
                const f32x4 g0 = *(const LAS f32x4*)(LN2 + 32 * s2 + 8 * kq), g1 = *(const LAS f32x4*)(LN2 + 32 * s2 + 8 * kq + 4);
                const u32x4 xa = cur[2 * j], xb = cur[2 * j + 1];
                float va[8], vb[8];
#pragma unroll
                for (int e = 0; e < 4; ++e) {
                    const float a0 = bflo(xa[e]), a1 = bfhi(xa[e]), b0 = bflo(xb[e]), b1 = bfhi(xb[e]);
                    ssa += a0 * a0 + a1 * a1; ssb += b0 * b0 + b1 * b1;
                    const float gl = e < 2 ? g0[2 * e] : g1[2 * e - 4], gh = e < 2 ? g0[2 * e + 1] : g1[2 * e - 3];
                    va[2 * e] = a0 * gl; va[2 * e + 1] = a1 * gh; vb[2 * e] = b0 * gl; vb[2 * e + 1] = b1 * gh;
                }
                { u32x2 w8; w8.x = cvt4_fp8(va[0], va[1], va[2], va[3]); w8.y = cvt4_fp8(va[4], va[5], va[6], va[7]); *(u32x2*)(hpa + 32 * s2) = w8; }
                { u32x2 w8; w8.x = cvt4_fp8(vb[0], vb[1], vb[2], vb[3]); w8.y = cvt4_fp8(vb[4], vb[5], vb[6], vb[7]); *(u32x2*)(hpb + 32 * s2) = w8; }
                *(LAS u32x4*)(xw) = xa; *(LAS u32x4*)(xw + 256) = xb;
                asm volatile("" ::: "memory");
#pragma unroll
                for (int hw = 0; hw < 2; ++hw) {
                    const bf16x8 xf = *(const LAS bf16x8*)(xr + hw * 1024);
                    const int wc = ((2 * (2 * s2 + hw) + hh) ^ (n & 15)) << 4;
                    const bf16x8 whi = *(const LAS bf16x8*)(wr_ + wc), wlo = *(const LAS bf16x8*)(wr_ + 65536 + wc);
                    acc = mfma32(whi, xf, acc); acc = mfma32(wlo, xf, acc);
                }
                asm volatile("" ::: "memory");
            }
#pragma unroll
            for (int j = 0; j < 8; ++j) cur[j] = nxt[j];
        }
        ssa += dppmov<0xB1>(ssa); ssa += dppmov<0x4E>(ssa); ssb += dppmov<0xB1>(ssb); ssb += dppmov<0x4E>(ssb);
        const float sa_ = __shfl(ssa, (n & 15) * 4), sb_ = __shfl(ssb, (n & 15) * 4);
        float ss = (n >> 4) ? sb_ : sa_;
        const float rs = rsqrtf(ss * (1.0f / DM) + 1e-6f);
        float tv[4] = {-3.0e38f, -3.0e38f, -3.0e38f, -3.0e38f}; int te[4] = {0, 0, 0, 0};
#pragma unroll
        for (int r = 0; r < 16; ++r) {
            const int e = crow(r, hh); const float lg = acc[r] * rs + br[e];
            const bool b0 = lg > tv[0], b1 = lg > tv[1], b2 = lg > tv[2], b3 = lg > tv[3];
            tv[3] = b2 ? tv[2] : (b3 ? lg : tv[3]); te[3] = b2 ? te[2] : (b3 ? e : te[3]);
            tv[2] = b1 ? tv[1] : (b2 ? lg : tv[2]); te[2] = b1 ? te[1] : (b2 ? e : te[2]);
            tv[1] = b0 ? tv[0] : (b1 ? lg : tv[1]); te[1] = b0 ? te[0] : (b1 ? e : te[1]);
            tv[0] = b0 ? lg : tv[0]; te[0] = b0 ? e : te[0];
        }
        float pv[4]; int pe[4];
#pragma unroll
        for (int k = 0; k < 4; ++k) { pv[k] = __shfl_xor(tv[k], 32); pe[k] = __shfl_xor(te[k], 32); }
#pragma unroll
        for (int k = 0; k < 4; ++k) {
            const float lg = pv[k]; const int e = pe[k];
            const bool b0 = lg > tv[0] || (lg == tv[0] && e < te[0]), b1 = lg > tv[1] || (lg == tv[1] && e < te[1]), b2 = lg > tv[2] || (lg == tv[2] && e < te[2]), b3 = lg > tv[3] || (lg == tv[3] && e < te[3]);
            tv[3] = b2 ? tv[2] : (b3 ? lg : tv[3]); te[3] = b2 ? te[2] : (b3 ? e : te[3]);
            tv[2] = b1 ? tv[1] : (b2 ? lg : tv[2]); te[2] = b1 ? te[1] : (b2 ? e : te[2]);
            tv[1] = b0 ? tv[0] : (b1 ? lg : tv[1]); te[1] = b0 ? te[0] : (b1 ? e : te[1]);
            tv[0] = b0 ? lg : tv[0]; te[0] = b0 ? e : te[0];
        }
        const float e1 = __expf(tv[1] - tv[0]), e2 = __expf(tv[2] - tv[0]), e3 = __expf(tv[3] - tv[0]), inv = 1.0f / (1.0f + e1 + e2 + e3);
        int exs[2], lps[2]; float gvs[2];
#pragma unroll
        for (int kk = 0; kk < 2; ++kk) {
            exs[kk] = hh ? (kk ? te[3] : te[2]) : (kk ? te[1] : te[0]);
            gvs[kk] = (hh ? (kk ? e3 : e2) : (kk ? e1 : 1.0f)) * inv;
            lps[kk] = (live && !dry) ? __hip_atomic_fetch_add(LCNT + exs[kk], 1, __ATOMIC_RELAXED, __HIP_MEMORY_SCOPE_WORKGROUP) : 0;
        }
        __syncthreads();
        if (c.tid < NEXP) { const int nloc = LCNT[c.tid]; LBASE[c.tid] = nloc > 0 ? atomicAdd(cnt + c.tid, nloc) : 0; }
        __syncthreads();
        if (live && !dry) {
#pragma unroll
            for (int kk = 0; kk < 2; ++kk) {
                const int k = 2 * hh + kk, li = exs[kk], ps = LBASE[li] + lps[kk];
                ids[(size_t)li * T_TOK + ps] = tok; rsl[(size_t)li * T_TOK + ps] = rs;
                tp[(size_t)tok * 4 + k] = ((unsigned)li << 24) | (unsigned)ps; tg[(size_t)tok * 4 + k] = gvs[kk];
            }
        }
        __syncthreads();
        if (c.tid < NEXP) LCNT[c.tid] = 0;
        __syncthreads();
    }
    __syncthreads();
}

constexpr int DIR_OFF = STAGE_BYTES;
DI MoeDir moe_dir_build(const Ctx& c) {
    LAS int* pref = (LAS int*)(c.lds + DIR_OFF); LAS int* cn = pref + 160; LAS int* rpref = pref + 320;
    if (c.tid < NLIST) cn[c.tid] = c.ctl()[c.tid];
    __syncthreads();
    if (c.tid == 0) { int s = 0; for (int l = 0; l < NLIST; ++l) { pref[l] = s; s += (cn[l] + BM - 1) / BM; } pref[NLIST] = s; }
    __syncthreads();
    MoeDir d; d.pref = pref; d.cnt = cn; d.rpref = rpref; return d;
}

DI void p9_combine(const Ctx& c, const MoeDir& dir, float gmul) {
    const unsigned* tp = (const unsigned*)(c.ws + WS_TP); const float* tg = (const float*)(c.ws + WS_TG); const bf16_t* x1b = (const bf16_t*)(c.ws + WS_X1B);
    const int gw = c.bid * 8 + c.wave, nw = c.G * 8;
    u32x4 pvn = *(const u32x4*)(tp + (size_t)gw * 4); f32x4 gvn = *(const f32x4*)(tg + (size_t)gw * 4);
    for (int tok = gw; tok < T_TOK; tok += nw) {
        const u32x4 pv = pvn; const f32x4 gv = gvn;
        { const int tn = tok + nw < T_TOK ? tok + nw : tok; pvn = *(const u32x4*)(tp + (size_t)tn * 4); gvn = *(const f32x4*)(tg + (size_t)tn * 4); }
        const unsigned char* yr[4];
#pragma unroll
        for (int k = 0; k < 4; ++k) { const int li = pv[k] >> 24, ps = pv[k] & 0xffffff; yr[k] = c.ws + y8_row_off(dir.pref[li] * BM + ps); }
        float* op = c.out + (size_t)tok * DM;
#pragma unroll
        for (int i = 0; i < 2; ++i) {
            const int col = i * 512 + c.lane * 8;
            const u32x4 xb = __builtin_nontemporal_load((const u32x4*)(x1b + (size_t)tok * DM + col));
            f32x4 a0 = {bflo(xb.x), bfhi(xb.x), bflo(xb.y), bfhi(xb.y)}, a1 = {bflo(xb.z), bfhi(xb.z), bflo(xb.w), bfhi(xb.w)};
            u32x2 y[4];
#pragma unroll
            for (int k = 0; k < 4; ++k) y[k] = __builtin_nontemporal_load((const u32x2*)(yr[k] + col));
#pragma unroll
            for (int k = 0; k < 4; ++k) {
                const float g = gv[k] * gmul * (1.0f / YSCALE);
                const f32x2 p0 = __builtin_amdgcn_cvt_pk_f32_fp8((int)y[k].x, false), p1 = __builtin_amdgcn_cvt_pk_f32_fp8((int)y[k].x, true);
                const f32x2 p2 = __builtin_amdgcn_cvt_pk_f32_fp8((int)y[k].y, false), p3 = __builtin_amdgcn_cvt_pk_f32_fp8((int)y[k].y, true);
                a0[0] += g * p0[0]; a0[1] += g * p0[1]; a0[2] += g * p1[0]; a0[3] += g * p1[1];
                a1[0] += g * p2[0]; a1[1] += g * p2[1]; a1[2] += g * p3[0]; a1[3] += g * p3[1];
            }
            __builtin_nontemporal_store(a0, (f32x4*)(op + col)); __builtin_nontemporal_store(a1, (f32x4*)(op + col + 4));
        }
    }
}

#define XB_TMO      128
#define XB_XCNT(j)  (256  + 64 * (j))
#define XB_XSUB(j)  (1280 + 64 * (j))
#define XB_XGEN(j)  (2304 + 64 * (j))
#define XB_TOP      3328
#define XB_TOPGEN   3392
#define XCD_BAR_WORDS 3456
#define XB_SPIN_CAP (1u << 20)
DI unsigned xb_ld(unsigned* p) { return __hip_atomic_load(p, __ATOMIC_RELAXED, __HIP_MEMORY_SCOPE_AGENT); }
DI unsigned xb_add(unsigned* p, unsigned v) { return __hip_atomic_fetch_add(p, v, __ATOMIC_RELAXED, __HIP_MEMORY_SCOPE_AGENT); }
DI unsigned xb_xcc_id() { return (unsigned)__builtin_amdgcn_s_getreg((3 << 11) | 20) & 0xFu; }
#define XB_SPIN(cond, bar) do { unsigned _sp = 0; while (cond) { __builtin_amdgcn_s_sleep(1); \
    if ((++_sp & 255u) == 0u) { if (xb_ld(&(bar)[XB_TMO])) break; if (_sp > XB_SPIN_CAP) { atomicAdd(&(bar)[XB_TMO], 1u); break; } } } } while (0)
struct XcdBarrier { unsigned* bar; unsigned x; volatile LAS unsigned* st; };
DI XcdBarrier xcd_barrier_post(unsigned* bar, volatile LAS unsigned* st) {
    XcdBarrier b; b.bar = bar; b.x = xb_xcc_id(); b.st = st;
    if (threadIdx.x == 0) (void)xb_add(&bar[XB_XCNT(b.x)], 1u);
    return b;
}
DI void xcd_barrier_complete(unsigned* bar, unsigned x, unsigned& nloc, unsigned& nx) {
    const unsigned G = gridDim.x * gridDim.y * gridDim.z;
    unsigned sum, cnt, mine, sp = 0u;
    for (;;) {
        sum = 0u; cnt = 0u; mine = 0u;
#pragma unroll
        for (unsigned j = 0; j < 16; ++j) { const unsigned cc = xb_ld(&bar[XB_XCNT(j)]); sum += cc; cnt += (cc > 0u) ? 1u : 0u; mine = (j == x) ? cc : mine; }
        if (sum == G) break;
        __builtin_amdgcn_s_sleep(1);
        if ((++sp & 255u) == 0u) { if (xb_ld(&bar[XB_TMO])) break; if (sp > XB_SPIN_CAP) { atomicAdd(&bar[XB_TMO], 1u); break; } }
    }
    nloc = mine > 0u ? mine : 1u; nx = cnt > 0u ? cnt : 1u;
}
DI void xcd_barrier(const XcdBarrier& b) {
    asm volatile("s_waitcnt vmcnt(0)" ::: "memory");
    __syncthreads();
    if (threadIdx.x == 0) {
        unsigned* bar = b.bar;
        __builtin_amdgcn_s_waitcnt(0);
        unsigned nloc = b.st[0], nx = b.st[1];
        if (nloc == 0u) { xcd_barrier_complete(bar, b.x, nloc, nx); b.st[0] = nloc; b.st[1] = nx; }
        const unsigned old = xb_add(&bar[XB_XSUB(b.x)], 1u);
        const unsigned gen = old / nloc;
        if (old + 1u == (gen + 1u) * nloc) {
            __builtin_amdgcn_fence(__ATOMIC_RELEASE, "agent");
            asm volatile("s_waitcnt vmcnt(0)" ::: "memory");
            const unsigned og = xb_add(&bar[XB_TOP], 1u);
            const unsigned tg = og / nx;
            if (og + 1u == (tg + 1u) * nx) xb_add(&bar[XB_TOPGEN], 1u);
            else XB_SPIN(xb_ld(&bar[XB_TOPGEN]) == tg, bar);
            __builtin_amdgcn_fence(__ATOMIC_ACQUIRE, "agent");
            xb_add(&bar[XB_XGEN(b.x)], 1u);
            asm volatile("s_waitcnt vmcnt(0)" ::: "memory");
        } else {
            XB_SPIN(xb_ld(&bar[XB_XGEN(b.x)]) == gen, bar);
            __builtin_amdgcn_fence(__ATOMIC_ACQUIRE, "agent");
            asm volatile("s_waitcnt vmcnt(0)" ::: "memory");
        }
    }
    __syncthreads();
}

__global__ void __launch_bounds__(NTHREADS, 2) fwd_kernel(Args a) {
    extern __shared__ __attribute__((aligned(16))) unsigned char lds_raw[];
    Ctx c;
#if defined(__HIP_DEVICE_COMPILE__)
    c.kargs = __builtin_amdgcn_kernarg_segment_ptr();
#endif
    c.out = a.out; c.ws = a.ws; c.lds = (LAS unsigned char*)lds_raw;
    c.tid = threadIdx.x; c.lane = c.tid & 63; c.wave = __builtin_amdgcn_readfirstlane(c.tid >> 6); c.G = gridDim.x; c.bid = blockIdx.x;
    cg::grid_group grid = cg::this_grid();
    volatile LAS unsigned* xbst = (volatile LAS unsigned*)(c.lds + LDS_BYTES - 16);
    if (c.tid == 0) { xbst[0] = 0u; xbst[1] = 0u; }
    __syncthreads();
    XcdBarrier xbar; xbar.bar = (unsigned*)(c.ws + WS_BAR); xbar.x = 0; xbar.st = xbst;
    const int lo = a.ph_lo, hi = a.ph_hi;
#ifndef PH_MASK
#define PH_MASK 0x303ff
#endif
#define IN(k) (((PH_MASK >> (k)) & 1) && lo <= (k) && (k) < hi)
#define SEAM(k) do { if (a.coop && IN(k) && IN((k) + 1)) { if ((k) == 0) grid.sync(); else xcd_barrier(xbar); } } while (0)
    if (IN(0)) p0_prologue(c);
    SEAM(0);
    if (a.coop) xbar = xcd_barrier_post((unsigned*)(c.ws + WS_BAR), xbst);
    if (IN(1)) {
        DenseBf16<14, 0> g{}; g.nt = 16; g.kstepA = 128; g.ldb = DM; g.G = c.G; g.c = c.bid; g.n_rt = T_TOK / BM;
        g.A = c.xn(); g.lda = DM; g.Bt = c.wcat(); g.O = c.proj(); g.ldo = NPROJ; g.bias0 = nullptr; g.bias1 = nullptr; g.bsplit = 0; g.bend = 0;
        gemm_phase(c.lds, g);
    }
    SEAM(1);
    if (IN(2)) {
        if (c.bid >= 64 || c.G < 128) p2_prep(c, c.G < 128 ? c.bid : c.bid - 64, c.G < 128 ? c.G : c.G - 64);
        CmpGemm g{}; g.nt = 32; g.kstepA = NPROJ * 2; g.ldb = 2048; g.G = c.G; g.c = c.bid;
        g.proj = c.proj(); g.cw1t = c.cw1t(); g.hid = c.hid(); g.biasc = c.biasc();
        gemm_phase(c.lds, g);
    }
    SEAM(2);
    if (IN(3)) {
        DenseBf16<6, 0> g{}; g.nt = 4; g.kstepA = 128; g.ldb = 256; g.G = c.G; g.c = c.bid; g.n_rt = T_TOK / BM;
        g.A = c.lact(); g.lda = 256; g.Bt = c.wl2t(); g.O = c.lout(); g.ldo = 1536; g.bias0 = c.in(I_W0); g.bias1 = c.in(I_A0); g.bsplit = 512; g.bend = 1024;
        gemm_phase(c.lds, g);
        p3_cmp_finish(c);
    }
    SEAM(3);
    if (IN(4)) {
        for (int rep = 0; rep < 1 + ((REP >> 16) & 1); ++rep) if ((PH_MASK >> 16) & 1) for (int ch = c.bid; ch < NBATCH * 8; ch += c.G) { if (SCAN_V2 == 2) scan_chain3(c, ch); else if (SCAN_V2 == 1) scan_chain2(c, ch); else scan_chain(c, ch); }
        for (int rep = 0; rep < 1 + ((REP >> 17) & 1); ++rep) if ((PH_MASK >> 17) & 1) for (int it = c.bid; it < NBATCH * 2 * 32; it += c.G) attn_item(c, it);
    }
    SEAM(4);
    if (IN(5)) {
        p5_moe_weights(c);
        OutProj g{}; g.nt = 16; g.kstepA = 128; g.ldb = DM; g.G = c.G; g.c = c.bid; g.A = c.xn(); g.Bt = c.woutt(); g.x = c.in(I_X); g.x1b = (bf16_t*)(c.ws + WS_X1B);
        gemm_phase(c.lds, g);
    }
    if (IN(5) && IN(6)) { asm volatile("s_waitcnt vmcnt(0)" ::: "memory"); __syncthreads(); __builtin_amdgcn_fence(__ATOMIC_ACQUIRE, "agent"); }
    if (IN(6)) p6_router(c, a.dry);
    SEAM(6);
    if (IN(7)) {
        Moe1 g{}; g.nt = 8; g.kstepA = 128; g.ldb = DM / 2; g.G = c.G; g.c = c.bid; g.dir = moe_dir_build(c);
        g.h = c.h8(); g.w1t = c.w1t(); g.b1 = c.in(I_MB1); g.ids = c.ids(); g.rsl = c.rsl(); g.act = c.act();
        gemm_phase_gather(c.lds, g);
    }
    SEAM(7);
    if (IN(8)) {
        Moe2 g{}; g.nt = 8; g.kstepA = 128; g.ldb = DFF / 2; g.G = c.G; g.c = c.bid; g.dir = moe_dir_build(c);
        g.act = c.act(); g.w2t = c.w2t(); g.b2 = c.in(I_MB2); g.ws = c.ws;
        gemm_phase(c.lds, g);
    }
    SEAM(8);
    if (IN(9)) { const MoeDir d = moe_dir_build(c); p9_combine(c, d, (a.dry || (ABL & 4)) ? 0.f : 1.f); }
#undef IN
#undef SEAM
}

#ifndef HOST_SEQ
#define HOST_SEQ 0,1,2,3,4,5,6,7,8,9
#endif
#ifndef MK_MULTI
#define MK_MULTI 0
#endif
#ifndef HOST_REP
#define HOST_REP 0x8
#endif
constexpr int N_PHASES = 10;
extern "C" void kernel_launch(void* const* d_in, const int* in_sizes, int n_in, void* d_out, int out_size, void* d_ws, size_t ws_size, hipStream_t stream) {
    static int grid = 0;
    if (grid == 0) {
        if (n_in != 31 || out_size != T_TOK * DM || ws_size < WS_END) { fprintf(stderr, "kernel_launch: unexpected shapes: n_in %d out %d ws %zu (need %zu)\n", n_in, out_size, ws_size, (size_t)WS_END); grid = -1; return; }
        int dev = 0, cus = 0, per_cu = 0;
        (void)hipGetDevice(&dev); (void)hipDeviceGetAttribute(&cus, hipDeviceAttributeMultiprocessorCount, dev);
        if (hipFuncSetAttribute((const void*)fwd_kernel, hipFuncAttributeMaxDynamicSharedMemorySize, LDS_BYTES) != hipSuccess) { fprintf(stderr, "kernel_launch: hipFuncSetAttribute failed\n"); grid = -1; return; }
        if (hipOccupancyMaxActiveBlocksPerMultiprocessor(&per_cu, (const void*)fwd_kernel, NTHREADS, LDS_BYTES) != hipSuccess || per_cu < 1) { fprintf(stderr, "kernel_launch: occupancy query says %d blocks per CU\n", per_cu); grid = -1; return; }
        grid = cus * 1;
        fprintf(stderr, "kernel_launch: cus %d per_cu %d grid %d\n", cus, per_cu, grid);
    }
    if (grid < 0) return;
    Args a{};
    for (int i = 0; i < 31; ++i) a.in[i] = (const float*)d_in[i];
    a.out = (float*)d_out; a.ws = (unsigned char*)d_ws; a.dry = 0;
#if MK_MULTI
    static const int seq[] = {HOST_SEQ};
    for (unsigned i = 0; i < sizeof(seq) / sizeof(seq[0]); ++i) { const int p = seq[i] % 100; a.ph_lo = p; a.ph_hi = p + 1; a.coop = 0; a.dry = seq[i] >= 100; hipLaunchKernelGGL(fwd_kernel, dim3(grid), dim3(NTHREADS), LDS_BYTES, stream, a); }
#else
    a.ph_lo = 0; a.ph_hi = N_PHASES; a.coop = 1;
    void* args[] = {&a};
    hipError_t e = hipLaunchCooperativeKernel((const void*)fwd_kernel, dim3(grid), dim3(NTHREADS), args, LDS_BYTES, stream);
    if (e != hipSuccess) fprintf(stderr, "kernel_launch: cooperative launch failed: %s (grid %d)\n", hipGetErrorString(e), grid);
#endif
}
```
